# Optimizing an MI355X kernel written in HIP

```python
import math
import jax, jax.numpy as jnp
from jax import lax
import numpy as np

D_MODEL = 1024
BATCH = 16
SEQ = 2048
DEPTH = 4

GRID_W = 64
CTX_LEN = 256
ATTN_HEADS = 4
ATTN_HEAD_DIM = 64
ATTN_V_DIM = 2 * ATTN_HEAD_DIM
ATTN_WIDTH = ATTN_HEADS * ATTN_V_DIM
CONV_WIDTH = D_MODEL // 4
CONV_K = 3
POOL_WIDTH = D_MODEL // 4
POOL_WINDOWS = (2, 4, 8, 16)
POOL_GROUPS = len(POOL_WINDOWS)
POOL_GROUP_DIM = POOL_WIDTH // POOL_GROUPS
MIX_WIDTH = ATTN_WIDTH + CONV_WIDTH + POOL_WIDTH
D_FF = 2816
ROPE_BASE = 10000.0
Q_BLOCK = 128
N_MOD = 9
EPS = 1e-6
COL_SIZES = (ATTN_WIDTH, ATTN_WIDTH, ATTN_WIDTH, CONV_WIDTH, CONV_WIDTH, CONV_WIDTH, POOL_WIDTH)
COL_SPLITS = tuple(int(v) for v in np.cumsum(COL_SIZES)[:-1])
IN_COLS = sum(COL_SIZES)

kernel_name = "hymba_diffattn_conv_pool_macaron_dit"


def _rms(x, w):
    x32 = x.astype(jnp.float32)
    y = x32 * lax.rsqrt(jnp.mean(x32 * x32, axis=-1, keepdims=True) + EPS)
    return (y * w.astype(jnp.float32)).astype(x.dtype)


def _modulate(x, shift, scale):
    return x * (1 + scale[:, None, :]) + shift[:, None, :]


def _swiglu(x, w_gu, w_down):
    g, u = jnp.split(x @ w_gu, 2, axis=-1)
    return (jax.nn.silu(g) * u) @ w_down


def _axial_rope_tables(n_tokens):
    rows = n_tokens // GRID_W
    row = jnp.repeat(jnp.arange(rows), GRID_W).astype(jnp.float32)
    col = jnp.tile(jnp.arange(GRID_W), rows).astype(jnp.float32)
    nfreq = ATTN_HEAD_DIM // 4
    inv = ROPE_BASE ** (-jnp.arange(nfreq, dtype=jnp.float32) / nfreq)
    ang = jnp.stack([row[:, None] * inv, col[:, None] * inv], axis=1)
    return jnp.cos(ang), jnp.sin(ang)


def _apply_rope(x, cos, sin):
    xs = x.reshape(x.shape[:-1] + (2, 2, -1))
    x1, x2 = xs[..., 0, :], xs[..., 1, :]
    c = cos[None, :, None, None].astype(x.dtype)
    s = sin[None, :, None, None].astype(x.dtype)
    out = jnp.stack([x1 * c - x2 * s, x1 * s + x2 * c], axis=-2)
    return out.reshape(x.shape)


def _diff_attn(q, k, v, lam):
    s = jnp.einsum('bqhid,bkhid->bhiqk', q, k, preferred_element_type=jnp.float32)
    p = jax.nn.softmax(s * (ATTN_HEAD_DIM ** -0.5), axis=-1)
    a = p[:, :, 0] - lam * p[:, :, 1]
    return jnp.einsum('bhqk,bkhe->bqhe', a.astype(v.dtype), v)


def _diff_attn_blocked(q, k, v, lam):
    B, S = q.shape[:2]
    nb = S // Q_BLOCK
    qb = q.reshape((B, nb, Q_BLOCK) + q.shape[2:]).transpose(1, 0, 2, 3, 4, 5)
    out = lax.map(lambda qq: _diff_attn(qq, k, v, lam), qb)
    return out.transpose(1, 0, 2, 3, 4).reshape(B, S, ATTN_HEADS, ATTN_V_DIM)


def _attn_post(o, subln_w, lam_init):
    B, L = o.shape[:2]
    return (_rms(o, subln_w) * (1.0 - lam_init)).reshape(B, L, ATTN_WIDTH)


def _gated_conv(b, cg, xin, w):
    u = cg * xin
    L = u.shape[1]
    up = jnp.pad(u, ((0, 0), (1, 1), (0, 0)))
    return b * (up[:, :L] * w[0] + up[:, 1:L + 1] * w[1] + up[:, 2:] * w[2])


def _multiscale_pool(u, w_grp, scale):
    B, L, _ = u.shape
    ug = u.reshape(B, L, POOL_GROUPS, POOL_GROUP_DIM).astype(jnp.float32)
    csum = jnp.pad(jnp.cumsum(ug, axis=1), ((0, 0), (1, 0), (0, 0), (0, 0)))
    t = jnp.arange(L)
    outs = []
    for g, win in enumerate(POOL_WINDOWS):
        lo = jnp.clip(t - win // 2, 0, L)
        hi = jnp.clip(t + win // 2, 0, L)
        ssum = csum[:, hi, g] - csum[:, lo, g]
        cnt = (hi - lo).astype(jnp.float32)[None, :, None]
        outs.append(ssum / cnt - ug[:, :, g])
    pooled = jnp.stack(outs, axis=2).astype(u.dtype)
    y = jnp.einsum('blgc,gcd->blgd', pooled, w_grp).reshape(B, L, POOL_WIDTH)
    return y * scale


def _hybrid_mixer(u, uc, ctx_out, w_in, w_out, q_norm_w, k_norm_w, lam, lam_init,
                  subln_w, conv_w, pool_w, pool_scale, cos, sin):
    B, S, _ = u.shape
    Lc = uc.shape[1]
    H, dh = ATTN_HEADS, ATTN_HEAD_DIM
    if ctx_out:
        qc, kc, vc, cbc, ccc, cxc, puc = jnp.split(uc @ w_in, COL_SPLITS, axis=-1)
    else:
        kc, vc = jnp.split(uc @ w_in[:, ATTN_WIDTH:3 * ATTN_WIDTH], 2, axis=-1)
    kc = _rms(kc.reshape(B, Lc, H, 2, dh), k_norm_w)
    vc = vc.reshape(B, Lc, H, ATTN_V_DIM)
    q, k, v, cb, cc, cx, pu = jnp.split(u @ w_in, COL_SPLITS, axis=-1)
    q = _apply_rope(_rms(q.reshape(B, S, H, 2, dh), q_norm_w), cos, sin)
    k = _apply_rope(_rms(k.reshape(B, S, H, 2, dh), k_norm_w), cos, sin)
    k_all = jnp.concatenate([k, kc], axis=1)
    v_all = jnp.concatenate([v.reshape(B, S, H, ATTN_V_DIM), vc], axis=1)
    attn = _diff_attn_blocked(q, k_all, v_all, lam)
    y = jnp.concatenate([_attn_post(attn, subln_w, lam_init),
                         _gated_conv(cb, cc, cx, conv_w),
                         _multiscale_pool(pu, pool_w, pool_scale)], axis=-1) @ w_out
    if not ctx_out:
        return y, None
    qc = _rms(qc.reshape(B, Lc, H, 2, dh), q_norm_w)
    attn_c = _diff_attn(qc, kc, vc, lam)
    yc = jnp.concatenate([_attn_post(attn_c, subln_w, lam_init),
                          _gated_conv(cbc, ccc, cxc, conv_w),
                          _multiscale_pool(puc, pool_w, pool_scale)], axis=-1) @ w_out
    return y, yc


def setup_inputs(seed: int = 0) -> dict:
    key = jax.random.key(seed)
    ks = jax.random.split(key, 20)

    def n(k, shape, s):
        return jax.random.normal(k, shape, jnp.float32) * s

    return {
        "x": n(ks[0], (BATCH, SEQ, D_MODEL), 1.0),
        "c": n(ks[1], (BATCH, D_MODEL), 1.0),
        "ctx": n(ks[2], (BATCH, CTX_LEN, D_MODEL), 1.0),
        "c_ctx": n(ks[3], (D_MODEL,), 1.0),
        "norm_w": 1.0 + n(ks[4], (DEPTH, 3, D_MODEL), 0.1),
        "w_mod": n(ks[5], (DEPTH, D_MODEL, N_MOD * D_MODEL), 0.5 * D_MODEL ** -0.5),
        "b_mod": n(ks[6], (DEPTH, N_MOD * D_MODEL), 0.02),
        "ffn1_w_gu": n(ks[7], (DEPTH, D_MODEL, 2 * D_FF), D_MODEL ** -0.5),
        "ffn1_w_down": n(ks[8], (DEPTH, D_FF, D_MODEL), D_FF ** -0.5),
        "ffn2_w_gu": n(ks[9], (DEPTH, D_MODEL, 2 * D_FF), D_MODEL ** -0.5),
        "ffn2_w_down": n(ks[10], (DEPTH, D_FF, D_MODEL), D_FF ** -0.5),
        "w_in": n(ks[11], (DEPTH, D_MODEL, IN_COLS), D_MODEL ** -0.5),
        "w_out": n(ks[12], (DEPTH, MIX_WIDTH, D_MODEL), MIX_WIDTH ** -0.5),
        "q_norm_w": 1.0 + n(ks[13], (DEPTH, ATTN_HEAD_DIM), 0.1),
        "k_norm_w": 1.0 + n(ks[14], (DEPTH, ATTN_HEAD_DIM), 0.1),
        "lambda_qk": n(ks[15], (DEPTH, 4, ATTN_HEAD_DIM), 0.1),
        "subln_w": 1.0 + n(ks[16], (DEPTH, ATTN_V_DIM), 0.1),
        "conv_w": n(ks[17], (DEPTH, CONV_K, CONV_WIDTH), CONV_K ** -0.5),
        "pool_w": n(ks[18], (DEPTH, POOL_GROUPS, POOL_GROUP_DIM, POOL_GROUP_DIM), POOL_GROUP_DIM ** -0.5),
        "pool_scale": 1.0 + n(ks[19], (DEPTH, POOL_WIDTH), 0.1),
    }


def reference(x, c, ctx, c_ctx, norm_w, w_mod, b_mod, ffn1_w_gu, ffn1_w_down,
              ffn2_w_gu, ffn2_w_down, w_in, w_out, q_norm_w, k_norm_w, lambda_qk,
              subln_w, conv_w, pool_w, pool_scale):
    B, S, _ = x.shape
    cos, sin = _axial_rope_tables(S)
    silu_c = jax.nn.silu(c)
    silu_cc = jax.nn.silu(c_ctx)[None]
    h, hc = x, ctx
    for l in range(DEPTH):
        ctx_out = l < DEPTH - 1
        lam_init = 0.8 - 0.6 * math.exp(-0.3 * l)
        mod = (silu_c @ w_mod[l] + b_mod[l]).reshape(B, N_MOD, D_MODEL)
        mod_c = (silu_cc @ w_mod[l] + b_mod[l]).reshape(1, N_MOD, D_MODEL)
        m = [mod[:, i] for i in range(N_MOD)]
        mc = [mod_c[:, i] for i in range(N_MOD)]
        h = h + 0.5 * m[2][:, None] * _swiglu(_modulate(_rms(h, norm_w[l, 0]), m[0], m[1]),
                                              ffn1_w_gu[l], ffn1_w_down[l])
        hc = hc + 0.5 * mc[2][:, None] * _swiglu(_modulate(_rms(hc, norm_w[l, 0]), mc[0], mc[1]),
                                                 ffn1_w_gu[l], ffn1_w_down[l])
        lq = lambda_qk[l].astype(jnp.float32)
        lam = jnp.exp(jnp.sum(lq[0] * lq[1])) - jnp.exp(jnp.sum(lq[2] * lq[3])) + lam_init
        u = _modulate(_rms(h, norm_w[l, 1]), m[3], m[4])
        uc = _modulate(_rms(hc, norm_w[l, 1]), mc[3], mc[4])
        y, yc = _hybrid_mixer(u, uc, ctx_out, w_in[l], w_out[l], q_norm_w[l], k_norm_w[l],
                              lam, lam_init, subln_w[l], conv_w[l], pool_w[l], pool_scale[l],
                              cos, sin)
        h = h + m[5][:, None] * y
        h = h + 0.5 * m[8][:, None] * _swiglu(_modulate(_rms(h, norm_w[l, 2]), m[6], m[7]),
                                              ffn2_w_gu[l], ffn2_w_down[l])
        if ctx_out:
            hc = hc + mc[5][:, None] * yc
            hc = hc + 0.5 * mc[8][:, None] * _swiglu(_modulate(_rms(hc, norm_w[l, 2]), mc[6], mc[7]),
                                                     ffn2_w_gu[l], ffn2_w_down[l])
    return h
```

```cpp
#include <hip/hip_runtime.h>
#include <hip/hip_cooperative_groups.h>
#include <cstdio>
namespace cg = cooperative_groups;

#define LAS __attribute__((address_space(3)))
typedef unsigned short bf16_t;
typedef short bf16x8 __attribute__((ext_vector_type(8)));
typedef float f32x4 __attribute__((ext_vector_type(4)));
typedef float f32x16 __attribute__((ext_vector_type(16)));
typedef unsigned u32x4 __attribute__((ext_vector_type(4)));
typedef unsigned u32x2 __attribute__((ext_vector_type(2)));

constexpr int D = 1024, NB = 16, SEQ = 2048, LCTX = 256, NLAT = NB * SEQ, NCTX = NB * LCTX, NROWS = NLAT + NCTX;
constexpr int DFF = 2816, NGU = 2 * DFF, INC = 2560, NKEYS = SEQ + LCTX, DEPTH = 4, NMODC = 9 * D;
constexpr int LDS_BYTES = 131072;
constexpr float LOG2E = 1.4426950408889634f;

constexpr size_t OFF_WGU = 0;
constexpr size_t OFF_WDN = OFF_WGU + (size_t)8 * NGU * D * 2;
constexpr size_t OFF_WIN = OFF_WDN + (size_t)8 * D * DFF * 2;
constexpr size_t OFF_WOUT = OFF_WIN + (size_t)4 * INC * D * 2;
constexpr size_t OFF_MOD = OFF_WOUT + (size_t)4 * D * D * 2;
constexpr size_t OFF_ROPE = OFF_MOD + (size_t)4 * 17 * NMODC * 4;
constexpr size_t OFF_HC = OFF_ROPE + 8192;
constexpr size_t OFF_A = OFF_HC + (size_t)NCTX * D * 4;
constexpr size_t OFF_HID = OFF_A + (size_t)NROWS * D * 2;
constexpr size_t OFF_Q = OFF_HID;
constexpr size_t OFF_KB = OFF_Q + (size_t)NROWS * 512 * 2;
constexpr size_t OFF_VT = OFF_KB + (size_t)NROWS * 512 * 2;
constexpr size_t OFF_EW = OFF_VT + (size_t)NROWS * 512 * 2;
constexpr size_t WS_END = OFF_HID + (size_t)NROWS * DFF * 2;
static_assert(OFF_EW + (size_t)NROWS * 1024 * 2 <= WS_END, "alias region");

struct Params {
    const float *x, *c, *ctx, *c_ctx, *norm_w, *w_mod, *b_mod, *w_gu1, *w_dn1, *w_gu2, *w_dn2, *w_in, *w_out, *q_norm_w, *k_norm_w, *lambda_qk, *subln_w, *conv_w, *pool_w, *pool_scale;
    float* out; unsigned char* ws;
};

typedef const Params __attribute__((address_space(4)))* KArgP;
__device__ __forceinline__ KArgP kargs() { KArgP q = (KArgP)__builtin_amdgcn_kernarg_segment_ptr(); asm volatile("" : "+s"(q)); return q; }
__device__ __forceinline__ unsigned cvt_pk_bf16(float lo, float hi) { unsigned r; asm volatile("v_cvt_pk_bf16_f32 %0, %1, %2" : "=v"(r) : "v"(lo), "v"(hi)); return r; }
__device__ __forceinline__ int fresh_tid() { int t = threadIdx.x; asm volatile("" : "+v"(t)); return t; }
__device__ __forceinline__ float bf_lo(unsigned w) { return __uint_as_float(w << 16); }
__device__ __forceinline__ float bf_hi(unsigned w) { return __uint_as_float(w & 0xffff0000u); }
__device__ __forceinline__ float shx(float v, int mask, int lane) { return __int_as_float(__builtin_amdgcn_ds_bpermute((lane ^ mask) << 2, __float_as_int(v))); }
__device__ __forceinline__ float wave_sum(float v, int lane) {
#pragma unroll
    for (int o = 32; o >= 1; o >>= 1) v += shx(v, o, lane);
    return v;
}
__device__ __forceinline__ float wave_max(float v, int lane) {
#pragma unroll
    for (int o = 32; o >= 1; o >>= 1) v = fmaxf(v, shx(v, o, lane));
    return v;
}

constexpr int BM = 256, BK = 64, HALF = 128, HTB = HALF * BK * 2;
__device__ __forceinline__ int lds_byte(int r, int c) { const int st = (r >> 4) * 2 + (c >> 5), rr = r & 15, cc = c & 31, ob = rr * 64 + cc * 2; return st * 1024 + (ob ^ (((ob >> 9) & 1) << 5)); }
__device__ __forceinline__ void stage_rc(int b, int& R, int& C) { const int st = b / 1024, sb = b % 1024, swz = sb ^ (((sb >> 9) & 1) << 5); R = (st >> 1) * 16 + swz / 64; C = (st & 1) * 32 + (swz % 64) / 2; }

struct GUnit { int pm, pn, kind; const char* a; const char* b; };

__device__ __forceinline__ void tile_of(int L, int nM, int nN, int& pm, int& pn) {
    const int nwg = nM * nN; int wgid = L;
    { const int q = nwg / 8, r = nwg % 8, xcd = wgid % 8, off = wgid / 8; wgid = (xcd < r ? xcd * (q + 1) : r * (q + 1) + (xcd - r) * q) + off; }
    const int nig = 8 * nN, gid = wgid / nig, fm = gid * 8, gsz = (nM - fm) < 8 ? (nM - fm) : 8;
    pm = fm + ((wgid % nig) % gsz); pn = (wgid % nig) / gsz;
}

struct Sched1 {
    int nM, nN, G, c; const char* A; const char* Bt; size_t tstep;
    __device__ __forceinline__ bool next(int i, GUnit& u) const {
        const int L = i * G + c; if (L >= nM * nN) return false;
        tile_of(L, nM, nN, u.pm, u.pn); u.kind = 0; u.a = A + (size_t)u.pm * tstep; u.b = Bt + (size_t)u.pn * tstep; return true;
    }
};
struct SchedIn {
    int G, c; const char* A; const char* Win; size_t tstep;
    __device__ __forceinline__ bool next(int i, GUnit& u) const {
        const int L = i * G + c;
        if (L < 1152) { tile_of(L, 144, 8, u.pm, u.pn); u.kind = 0; u.a = A + (size_t)u.pm * tstep; u.b = Win + (size_t)u.pn * tstep; return true; }
        if (L < 1440) { tile_of(L - 1152, 2, 144, u.pm, u.pn); u.kind = 1; u.a = Win + (size_t)(8 + u.pm) * tstep; u.b = A + (size_t)u.pn * tstep; return true; }
        return false;
    }
};

struct EpiSwiGLU {
    bf16_t* hid;
    __device__ __forceinline__ void operator()(const f32x4 (&acc)[2][2][4][2], const GUnit& u, int wr, int wc, int fr, int fq) const {
        const int row0 = u.pm * BM + wr * 64 + fr;
        const int col0 = u.pn * 128 + wc * 32 + 8 * fq;
#pragma unroll
        for (int ai = 0; ai < 2; ++ai)
#pragma unroll
            for (int m = 0; m < 4; ++m) {
                float v[8];
#pragma unroll
                for (int n = 0; n < 2; ++n)
#pragma unroll
                    for (int j = 0; j < 4; ++j) {
                        const float g = acc[ai][0][m][n][j], uu = acc[ai][1][m][n][j];
                        const float sg = g * __builtin_amdgcn_rcpf(1.0f + __builtin_amdgcn_exp2f(-g * LOG2E));
                        v[n * 4 + j] = sg * uu;
                    }
                u32x4 w; w.x = cvt_pk_bf16(v[0], v[1]); w.y = cvt_pk_bf16(v[2], v[3]); w.z = cvt_pk_bf16(v[4], v[5]); w.w = cvt_pk_bf16(v[6], v[7]);
                *(u32x4*)(hid + (size_t)(row0 + ai * HALF + m * 16) * DFF + col0) = w;
            }
    }
};
struct EpiResid {
    const float* src_lat; const float* src_ctx; float* dst_lat; float* dst_ctx; const float* gate; float coef;
    __device__ __forceinline__ void operator()(const f32x4 (&acc)[2][2][4][2], const GUnit& u, int wr, int wc, int fr, int fq) const {
        const int pm = u.pm; const bool lat = pm < 128;
        const float* sp = lat ? src_lat + (size_t)pm * 256 * D : src_ctx + (size_t)(pm - 128) * 256 * D;
        float* dp = lat ? dst_lat + (size_t)pm * 256 * D : dst_ctx + (size_t)(pm - 128) * 256 * D;
        const int modrow = lat ? (pm >> 3) : 16;
        const int col0 = u.pn * BM + wc * 32 + 4 * fq;
        f32x4 gv[2][2];
#pragma unroll
        for (int bj = 0; bj < 2; ++bj)
#pragma unroll
            for (int n = 0; n < 2; ++n) gv[bj][n] = *(const f32x4*)(gate + (size_t)modrow * NMODC + col0 + bj * HALF + n * 16) * coef;
#pragma unroll
        for (int ai = 0; ai < 2; ++ai)
#pragma unroll
            for (int m = 0; m < 4; ++m) {
                const size_t ro = (size_t)(wr * 64 + fr + ai * HALF + m * 16) * D + col0;
#pragma unroll
                for (int bj = 0; bj < 2; ++bj)
#pragma unroll
                    for (int n = 0; n < 2; ++n) {
                        const size_t off = ro + bj * HALF + n * 16;
                        *(f32x4*)(dp + off) = *(const f32x4*)(sp + off) + gv[bj][n] * acc[ai][bj][m][n];
                    }
            }
    }
};
struct EpiIn {
    bf16_t *Q, *KB, *VT, *EW; const float *qw, *kw, *cosT, *sinT;
    __device__ __forceinline__ void operator()(const f32x4 (&acc)[2][2][4][2], const GUnit& u, int wr, int wc, int fr, int fq) const {
        const int pm = u.pm, pn = u.pn;
        if (u.kind == 1) {
            int b, key0; if (pn < 128) { b = pn >> 3; key0 = (pn & 7) * 256; } else { b = pn - 128; key0 = SEQ; }
#pragma unroll
            for (int ai = 0; ai < 2; ++ai)
#pragma unroll
                for (int m = 0; m < 4; ++m) {
                    const int vcol = pm * 256 + ai * HALF + wr * 64 + m * 16 + fr;
                    bf16_t* rowp = VT + (size_t)(b * 512 + vcol) * NKEYS + key0 + wc * 32 + 4 * fq;
#pragma unroll
                    for (int bj = 0; bj < 2; ++bj)
#pragma unroll
                        for (int n = 0; n < 2; ++n) {
                            const f32x4 a = acc[ai][bj][m][n]; u32x2 w; w.x = cvt_pk_bf16(a[0], a[1]); w.y = cvt_pk_bf16(a[2], a[3]);
                            *(u32x2*)(rowp + bj * HALF + n * 16) = w;
                        }
                }
            return;
        }
        const bool lat = pm < 128;
        const int rl0 = wr * 64 + fr;
        if (pn >= 4) {
#pragma unroll
            for (int ai = 0; ai < 2; ++ai)
#pragma unroll
                for (int m = 0; m < 4; ++m) {
                    bf16_t* rowp = EW + (size_t)(pm * 256 + rl0 + ai * HALF + m * 16) * 1024 + (pn - 4) * 256 + wc * 64 + 4 * fq;
#pragma unroll
                    for (int bj = 0; bj < 2; ++bj)
#pragma unroll
                        for (int n = 0; n < 2; ++n) {
                            const f32x4 a = acc[ai][bj][m][n]; u32x2 w; w.x = cvt_pk_bf16(a[0], a[1]); w.y = cvt_pk_bf16(a[2], a[3]);
                            *(u32x2*)(rowp + bj * 32 + n * 16) = w;
                        }
                }
            return;
        }
        const bool isq = pn < 2;
        const float* w = isq ? qw : kw;
        f32x4 wv[2][2];
#pragma unroll
        for (int bj = 0; bj < 2; ++bj)
#pragma unroll
            for (int n = 0; n < 2; ++n) wv[bj][n] = *(const f32x4*)(w + bj * 32 + n * 16 + 4 * fq);
        const float osc = isq ? 0.125f * LOG2E : 1.0f;
        bf16_t* dst; size_t drow0;
        if (isq) { dst = Q; drow0 = (size_t)pm * 256; }
        else { dst = KB; drow0 = lat ? (size_t)(pm >> 3) * NKEYS + (size_t)(pm & 7) * 256 : (size_t)(pm - 128) * NKEYS + SEQ; }
        const int colb = (pn & 1) * 256 + wc * 64 + 4 * fq;
#pragma unroll
        for (int ai = 0; ai < 2; ++ai)
#pragma unroll
            for (int m = 0; m < 4; ++m) {
                const int rl = rl0 + ai * HALF + m * 16;
                float ss = 0.f;
#pragma unroll
                for (int bj = 0; bj < 2; ++bj)
#pragma unroll
                    for (int n = 0; n < 2; ++n) { const f32x4 a = acc[ai][bj][m][n]; ss += a[0] * a[0] + a[1] * a[1] + a[2] * a[2] + a[3] * a[3]; }
                ss += shx(ss, 16, fq * 16 + fr); ss += shx(ss, 32, fq * 16 + fr);
                const float rs = rsqrtf(ss * (1.0f / 64.0f) + 1e-6f) * osc;
                f32x4 y[2][2];
#pragma unroll
                for (int bj = 0; bj < 2; ++bj)
#pragma unroll
                    for (int n = 0; n < 2; ++n) y[bj][n] = acc[ai][bj][m][n] * rs * wv[bj][n];
                if (lat) {
                    const int s = (pm & 7) * 256 + rl;
#pragma unroll
                    for (int bj = 0; bj < 2; ++bj) {
                        const int pos = bj ? (s & 63) : (s >> 6);
                        const f32x4 c4 = *(const f32x4*)(cosT + pos * 16 + 4 * fq), s4 = *(const f32x4*)(sinT + pos * 16 + 4 * fq);
                        const f32x4 x1 = y[bj][0], x2 = y[bj][1];
                        y[bj][0] = x1 * c4 - x2 * s4; y[bj][1] = x1 * s4 + x2 * c4;
                    }
                }
                bf16_t* rowp = dst + (drow0 + rl) * 512 + colb;
#pragma unroll
                for (int bj = 0; bj < 2; ++bj)
#pragma unroll
                    for (int n = 0; n < 2; ++n) {
                        const f32x4 a = y[bj][n]; u32x2 ww; ww.x = cvt_pk_bf16(a[0], a[1]); ww.y = cvt_pk_bf16(a[2], a[3]);
                        *(u32x2*)(rowp + bj * 32 + n * 16) = ww;
                    }
            }
    }
};

template <class Sched, class Epi>
__device__ __forceinline__ void gemm_phase(LAS unsigned char* lds, const int K, const Sched& S, const Epi& E) {
    const int tid = fresh_tid(), wid = __builtin_amdgcn_readfirstlane(tid >> 6), lane = tid & 63, wr = wid >> 2, wc = wid & 3, fr = lane & 15, fq = lane >> 4;
    const int nt = K / BK;
    unsigned voff[2];
#pragma unroll
    for (int i = 0; i < 2; ++i) { int R, C; stage_rc(tid * 16 + i * 8192, R, C); voff[i] = (unsigned)(R * K + C) * 2u; }
    const size_t kstep = (size_t)(BK * 2);
    const size_t hstep = (size_t)HALF * K * 2;
    const unsigned ldsw = (unsigned)wid * 1024u;
    const int aoff = lds_byte(wr * 64 + fr, fq * 8), boff = lds_byte(wc * 32 + fr, fq * 8);
#define PG8_SA(b, h) (((b) * 2 + (h)) * HTB)
#define PG8_SB(b, h) ((4 + (b) * 2 + (h)) * HTB)
#define PG8_STAGE(bufoff, gbase) do { _Pragma("unroll") for (int _i = 0; _i < 2; ++_i) \
        __builtin_amdgcn_global_load_lds((const unsigned*)((const char*)(gbase) + voff[_i]), (LAS unsigned*)(lds + (bufoff) + ldsw + _i * 8192), 16, 0, 0); } while (0)
#define PG8_LDA(dst, b, h) do { _Pragma("unroll") for (int m = 0; m < 4; ++m) _Pragma("unroll") for (int k = 0; k < 2; ++k) dst[m][k] = *(const LAS bf16x8*)(lds + PG8_SA(b, h) + aoff + m * 2048 + k * 1024); } while (0)
#define PG8_LDB(dst, b, h) do { _Pragma("unroll") for (int n = 0; n < 2; ++n) _Pragma("unroll") for (int k = 0; k < 2; ++k) dst[n][k] = *(const LAS bf16x8*)(lds + PG8_SB(b, h) + boff + n * 2048 + k * 1024); } while (0)
#define PG8_MMA(ai, bj, At, Bt) do { __builtin_amdgcn_s_setprio(1); _Pragma("unroll") for (int m = 0; m < 4; ++m) _Pragma("unroll") for (int n = 0; n < 2; ++n) _Pragma("unroll") for (int k = 0; k < 2; ++k) \
        acc[ai][bj][m][n] = __builtin_amdgcn_mfma_f32_16x16x32_bf16(Bt[n][k], At[m][k], acc[ai][bj][m][n], 0, 0, 0); __builtin_amdgcn_s_setprio(0); } while (0)
#define PG8_WAIT_V(n) asm volatile("s_waitcnt vmcnt(" #n ")" ::: "memory")
#define PG8_WAIT_L(n) asm volatile("s_waitcnt lgkmcnt(" #n ")" ::: "memory")
#define PG8_BAR __builtin_amdgcn_s_barrier()
#define PG8_SCHED __builtin_amdgcn_sched_barrier(0)
    GUnit cur, nxt; int ui = 0;
    if (!S.next(0, cur)) return;
    f32x4 acc[2][2][4][2];
#pragma unroll
    for (int a = 0; a < 2; ++a)
#pragma unroll
        for (int b = 0; b < 2; ++b)
#pragma unroll
            for (int m = 0; m < 4; ++m)
#pragma unroll
                for (int n = 0; n < 2; ++n) acc[a][b][m][n] = (f32x4){0.f, 0.f, 0.f, 0.f};
    bf16x8 At[4][2], B0[2][2], B1[2][2];
    const char* cA = cur.a; const char* cB = cur.b;
    PG8_STAGE(PG8_SB(0, 0), cB); PG8_STAGE(PG8_SA(0, 0), cA); PG8_STAGE(PG8_SB(0, 1), cB + hstep); PG8_STAGE(PG8_SA(0, 1), cA + hstep);
    if (wr == 1) PG8_BAR;
    PG8_WAIT_V(4); PG8_BAR;
    PG8_STAGE(PG8_SB(1, 0), cB + kstep); PG8_STAGE(PG8_SA(1, 0), cA + kstep); PG8_STAGE(PG8_SB(1, 1), cB + hstep + kstep);
    PG8_WAIT_V(6); PG8_BAR;
    for (;;) {
        const bool has_next = S.next(ui + 1, nxt);
        const char* nA = has_next ? nxt.a : cA; const char* nB = has_next ? nxt.b : cB;
        for (int t = 0; t < nt; t += 2) {
            const bool last = (t == nt - 2);
            const char* a1 = cA + (size_t)(t + 1) * kstep;
            const char* a2 = last ? nA : cA + (size_t)(t + 2) * kstep; const char* b2 = last ? nB : cB + (size_t)(t + 2) * kstep;
            const char* a3 = a2 + kstep; const char* b3 = b2 + kstep;
            PG8_LDB(B0, 0, 0); PG8_SCHED; PG8_LDA(At, 0, 0); PG8_STAGE(PG8_SA(1, 1), a1 + hstep);
            PG8_WAIT_L(8); PG8_BAR; PG8_WAIT_L(0); PG8_MMA(0, 0, At, B0); PG8_BAR; PG8_SCHED;
            PG8_LDB(B1, 0, 1); PG8_STAGE(PG8_SB(0, 0), b2);
            PG8_BAR; PG8_WAIT_L(0); PG8_MMA(0, 1, At, B1); PG8_BAR;
            PG8_LDA(At, 0, 1); PG8_STAGE(PG8_SA(0, 0), a2);
            PG8_BAR; PG8_WAIT_L(0); PG8_MMA(1, 0, At, B0); PG8_BAR; PG8_SCHED;
            PG8_STAGE(PG8_SB(0, 1), b2 + hstep);
            PG8_WAIT_V(6); PG8_BAR; PG8_MMA(1, 1, At, B1); PG8_BAR;
            PG8_LDB(B0, 1, 0); PG8_SCHED; PG8_LDA(At, 1, 0); PG8_STAGE(PG8_SA(0, 1), a2 + hstep);
            PG8_WAIT_L(8); PG8_BAR; PG8_WAIT_L(0); PG8_MMA(0, 0, At, B0); PG8_BAR; PG8_SCHED;
            PG8_LDB(B1, 1, 1); PG8_STAGE(PG8_SB(1, 0), b3);
            PG8_BAR; PG8_WAIT_L(0); PG8_MMA(0, 1, At, B1); PG8_BAR;
            PG8_LDA(At, 1, 1); PG8_STAGE(PG8_SA(1, 0), a3);
            PG8_BAR; PG8_WAIT_L(0); PG8_MMA(1, 0, At, B0); PG8_BAR; PG8_SCHED;
            PG8_STAGE(PG8_SB(1, 1), b3 + hstep);
            PG8_WAIT_V(6); PG8_BAR; PG8_MMA(1, 1, At, B1); PG8_BAR;
        }
        E(acc, cur, wr, wc, fr, fq);
        if (!has_next) break;
#pragma unroll
        for (int a = 0; a < 2; ++a)
#pragma unroll
            for (int b = 0; b < 2; ++b)
#pragma unroll
                for (int m = 0; m < 4; ++m)
#pragma unroll
                    for (int n = 0; n < 2; ++n) acc[a][b][m][n] = (f32x4){0.f, 0.f, 0.f, 0.f};
        cur = nxt; cA = nA; cB = nB; ++ui;
    }
    PG8_WAIT_V(0);
    if (wr == 0) PG8_BAR;
    PG8_BAR;
#undef PG8_SA
#undef PG8_SB
#undef PG8_STAGE
#undef PG8_LDA
#undef PG8_LDB
#undef PG8_MMA
#undef PG8_WAIT_V
#undef PG8_WAIT_L
#undef PG8_BAR
#undef PG8_SCHED
}

__device__ __forceinline__ void mod_item(LAS unsigned char* lds, int item) {
    const KArgP pp = kargs(); const float* p_c = pp->c; const float* p_cctx = pp->c_ctx; const float* p_wmod = pp->w_mod; const float* p_bmod = pp->b_mod; unsigned char* p_ws = pp->ws;
    const int tid = fresh_tid(), lane = tid & 63, wave = tid >> 6;
    const int l = item / 72, n0 = (item % 72) * 128;
    LAS float* sil = (LAS float*)lds;
    __syncthreads();
    for (int idx = tid; idx < 17 * 1024; idx += 512) {
        const int r = idx >> 10, k = idx & 1023;
        const float v = (r < 16) ? p_c[r * 1024 + k] : p_cctx[k];
        sil[k * 20 + r] = v / (1.0f + __expf(-v));
    }
    __syncthreads();
    const int cgp = tid & 31, ksl = tid >> 5;
    f32x4 acc[17];
#pragma unroll
    for (int r = 0; r < 17; ++r) acc[r] = (f32x4){0.f, 0.f, 0.f, 0.f};
    const float* wp = p_wmod + ((size_t)l * 1024 + (size_t)ksl * 64) * NMODC + n0 + 4 * cgp;
#pragma unroll 4
    for (int kk = 0; kk < 64; ++kk) {
        const f32x4 w = *(const f32x4*)(wp + (size_t)kk * NMODC);
        const LAS float* sp = sil + (ksl * 64 + kk) * 20;
        const f32x4 s0 = *(const LAS f32x4*)(sp), s1 = *(const LAS f32x4*)(sp + 4), s2 = *(const LAS f32x4*)(sp + 8), s3 = *(const LAS f32x4*)(sp + 12);
        const float s16 = sp[16];
#pragma unroll
        for (int j = 0; j < 4; ++j) { acc[j] += w * s0[j]; acc[4 + j] += w * s1[j]; acc[8 + j] += w * s2[j]; acc[12 + j] += w * s3[j]; }
        acc[16] += w * s16;
    }
#pragma unroll
    for (int r = 0; r < 17; ++r)
#pragma unroll
        for (int j = 0; j < 4; ++j) acc[r][j] += shx(acc[r][j], 32, lane);
    __syncthreads();
    LAS float* red = (LAS float*)lds;
    if (lane < 32) {
#pragma unroll
        for (int r = 0; r < 17; ++r) *(LAS f32x4*)(red + (wave * 17 + r) * 128 + 4 * cgp) = acc[r];
    }
    __syncthreads();
    float* modp = (float*)(p_ws + OFF_MOD);
    for (int o = tid; o < 17 * 128; o += 512) {
        const int r = o >> 7, cc = o & 127;
        float s = p_bmod[l * NMODC + n0 + cc];
#pragma unroll
        for (int w = 0; w < 8; ++w) s += red[(w * 17 + r) * 128 + cc];
        modp[((size_t)l * 17 + r) * NMODC + n0 + cc] = s;
    }
    __syncthreads();
}

__device__ __forceinline__ void conv_tile(LAS unsigned char* lds, int idx) {
    const KArgP p = kargs();
    const int tid = fresh_tid();
    const float* src; bf16_t* dst; int Nsrc, K, ntile, kt, type, l;
    if (idx < 11264) { const int mat = idx / 1408, rem = idx % 1408; ntile = rem >> 4; kt = rem & 15; l = mat >> 1; type = 0;
        src = ((mat & 1) ? p->w_gu2 : p->w_gu1) + (size_t)l * D * NGU; Nsrc = NGU; K = D; dst = (bf16_t*)(p->ws + OFF_WGU) + (size_t)mat * NGU * D; }
    else if (idx < 11264 + 5632) { const int i2 = idx - 11264; const int mat = i2 / 704, rem = i2 % 704; ntile = rem / 44; kt = rem % 44; l = mat >> 1; type = 1;
        src = ((mat & 1) ? p->w_dn2 : p->w_dn1) + (size_t)l * DFF * D; Nsrc = D; K = DFF; dst = (bf16_t*)(p->ws + OFF_WDN) + (size_t)mat * D * DFF; }
    else if (idx < 11264 + 5632 + 2560) { const int i2 = idx - 16896; l = i2 / 640; const int rem = i2 % 640; ntile = rem >> 4; kt = rem & 15; type = 2;
        src = p->w_in + (size_t)l * D * INC; Nsrc = INC; K = D; dst = (bf16_t*)(p->ws + OFF_WIN) + (size_t)l * INC * D; }
    else { const int i2 = idx - 19456; l = i2 >> 8; const int rem = i2 & 255; ntile = rem >> 4; kt = rem & 15; type = 3;
        src = p->w_out + (size_t)l * D * D; Nsrc = D; K = D; dst = (bf16_t*)(p->ws + OFF_WOUT) + (size_t)l * D * D; }
    const int n0 = ntile * 64, k0 = kt * 64;
    LAS float* tile = (LAS float*)lds;
    const int c4 = tid & 15, kk = tid >> 4;
    const int np = n0 + 4 * c4;
    int fcol;
    if (type == 0) { const int s = np & 255; fcol = (s >> 7) * DFF + 128 * (np >> 8) + 32 * ((s >> 5) & 3) + 8 * ((s >> 2) & 3) + 4 * ((s >> 4) & 1); }
    else if (type == 2) {
        if (np < 2048) { const int t8 = np >> 8, s = np & 255, R = s & 127; const int colbase = (t8 < 4) ? t8 * 256 : 1536 + (t8 - 4) * 256; fcol = colbase + 64 * (R >> 5) + 32 * (s >> 7) + (R & 31); }
        else fcol = 1024 + (np - 2048);
    } else fcol = np;
    __syncthreads();
#pragma unroll
    for (int hlf = 0; hlf < 2; ++hlf) {
        const int k = kk + 32 * hlf;
        f32x4 v;
        if (type == 3 && k0 >= 768) {
            const int g = (k0 - 768) >> 6;
            const float* pw = p->pool_w + ((size_t)(l * 4 + g) * 64 + k) * 64;
            const float* sc = p->pool_scale + l * 256 + g * 64;
            const float* ws = src + (size_t)(768 + g * 64) * D + fcol;
            v = (f32x4){0.f, 0.f, 0.f, 0.f};
            for (int d = 0; d < 64; ++d) v += *(const f32x4*)(ws + (size_t)d * D) * (pw[d] * sc[d]);
        } else v = *(const f32x4*)(src + (size_t)(k0 + k) * Nsrc + fcol);
        LAS float* tp = tile + k * 65 + 4 * c4;
        tp[0] = v[0]; tp[1] = v[1]; tp[2] = v[2]; tp[3] = v[3];
    }
    __syncthreads();
    const int n = tid >> 3, kseg = (tid & 7) * 8;
    float f[8];
#pragma unroll
    for (int i = 0; i < 8; ++i) f[i] = tile[(kseg + i) * 65 + n];
    u32x4 w; w.x = cvt_pk_bf16(f[0], f[1]); w.y = cvt_pk_bf16(f[2], f[3]); w.z = cvt_pk_bf16(f[4], f[5]); w.w = cvt_pk_bf16(f[6], f[7]);
    *(u32x4*)(dst + (size_t)(n0 + n) * K + k0 + kseg) = w;
}

__device__ __forceinline__ void rope_item() {
    float* cosT = (float*)(kargs()->ws + OFF_ROPE); float* sinT = cosT + 1024;
    for (int idx = threadIdx.x; idx < 1024; idx += 512) {
        const int pos = idx >> 4, f = idx & 15, fm = f & 3, fqd = f >> 2;
        double inv = (fm == 0) ? 1.0 : (fm == 1) ? 0.5623413251903491 : (fm == 2) ? 0.31622776601683794 : 0.1778279410038923;
        inv *= (fqd == 0) ? 1.0 : (fqd == 1) ? 0.1 : (fqd == 2) ? 0.01 : 0.001;
        const double a = (double)((float)pos * (float)inv);
        const double twopi = 6.283185307179586476925;
        const double nrev = __builtin_rint(a / twopi);
        const double x = a - nrev * twopi, x2 = x * x;
        double sn = 0.0, cs = 0.0, ts = x, tc = 1.0;
#pragma unroll 1
        for (int i = 0; i < 16; ++i) { cs += tc; sn += ts; tc = -tc * x2 / (double)((2 * i + 1) * (2 * i + 2)); ts = -ts * x2 / (double)((2 * i + 2) * (2 * i + 3)); }
        cosT[idx] = (float)cs; sinT[idx] = (float)sn;
    }
}

__device__ __forceinline__ void prep_phase(const float* src_lat, const float* src_ctx, bf16_t* A, const float* nw, const float* modl, int shift_i, int scale_i, int nrows) {
    const int tid = fresh_tid();
    const int lane = tid & 63, gw = blockIdx.x * 8 + (tid >> 6), nwaves = gridDim.x * 8;
    const int rpw = (nrows + nwaves - 1) / nwaves;
    const int r0 = gw * rpw, r1 = (r0 + rpw < nrows) ? r0 + rpw : nrows;
    f32x4 nwv[4], sc[4], sh[4];
#pragma unroll
    for (int q = 0; q < 4; ++q) nwv[q] = *(const f32x4*)(nw + 4 * lane + 256 * q);
    int cur = -1;
    for (int row = r0; row < r1; ++row) {
        const bool lat = row < NLAT;
        const int mr = lat ? (row >> 11) : 16;
        if (mr != cur) {
            cur = mr;
#pragma unroll
            for (int q = 0; q < 4; ++q) {
                sc[q] = *(const f32x4*)(modl + (size_t)mr * NMODC + scale_i * 1024 + 4 * lane + 256 * q) + 1.0f;
                sh[q] = *(const f32x4*)(modl + (size_t)mr * NMODC + shift_i * 1024 + 4 * lane + 256 * q);
            }
        }
        const float* xp = lat ? src_lat + (size_t)row * D : src_ctx + (size_t)(row - NLAT) * D;
        f32x4 x[4]; float ss = 0.f;
#pragma unroll
        for (int q = 0; q < 4; ++q) { x[q] = *(const f32x4*)(xp + 4 * lane + 256 * q); ss += x[q][0] * x[q][0] + x[q][1] * x[q][1] + x[q][2] * x[q][2] + x[q][3] * x[q][3]; }
        ss = wave_sum(ss, lane);
        const float rstd = rsqrtf(ss * (1.0f / 1024.0f) + 1e-6f);
#pragma unroll
        for (int q = 0; q < 4; ++q) {
            const f32x4 y = (x[q] * rstd * nwv[q]) * sc[q] + sh[q];
            u32x2 w; w.x = cvt_pk_bf16(y[0], y[1]); w.y = cvt_pk_bf16(y[2], y[3]);
            *(u32x2*)(A + (size_t)row * D + 4 * lane + 256 * q) = w;
        }
    }
}

__device__ __forceinline__ void attn_item(LAS unsigned char* lds, const bf16_t* Q, const bf16_t* KB, const bf16_t* VT, bf16_t* MIX,
                                          int b, int h, int qrow0, int key0, int nkeys, float lam, float negM, const float* subw, float post_scale) {
    const int tid = fresh_tid(), lane = tid & 63, wave = tid >> 6, r = lane & 31, h2 = lane >> 5;
    f32x16 O[2][4];
#pragma unroll
    for (int i = 0; i < 2; ++i)
#pragma unroll
        for (int et = 0; et < 4; ++et)
#pragma unroll
            for (int j = 0; j < 16; ++j) O[i][et][j] = 0.f;
    float ls0 = 0.f, ls1 = 0.f;
    const char* kg = (const char*)(KB + ((size_t)(b * NKEYS + key0)) * 512 + h * 128);
    const char* vg = (const char*)(VT + ((size_t)(b * 512 + h * 128)) * NKEYS + key0);
    const int wu = __builtin_amdgcn_readfirstlane(wave);
    unsigned kgo[2], vgo[2];
#pragma unroll
    for (int i = 0; i < 2; ++i) {
        const int pc = wu + 8 * i;
        const int key = pc * 4 + (lane >> 4), c = (lane & 15) ^ (key & 15); kgo[i] = (unsigned)(key * 1024 + c * 16);
        const int e = pc * 8 + (lane >> 3), cv = (lane & 7) ^ ((e >> 1) & 7); vgo[i] = (unsigned)(e * (NKEYS * 2) + cv * 16);
    }
    const int nt = nkeys >> 6;
#define ATT_STAGE(t_, bufo_) do { _Pragma("unroll") for (int _i = 0; _i < 2; ++_i) { \
        __builtin_amdgcn_global_load_lds((const unsigned*)(kg + (size_t)(t_) * 65536 + kgo[_i]), (LAS unsigned*)(lds + (bufo_) + (wu + 8 * _i) * 1024), 16, 0, 0); \
        __builtin_amdgcn_global_load_lds((const unsigned*)(vg + (size_t)(t_) * 128 + vgo[_i]), (LAS unsigned*)(lds + (bufo_) + 16384 + (wu + 8 * _i) * 1024), 16, 0, 0); } } while (0)
    __syncthreads();
    {
        const char* qg = (const char*)(Q + (size_t)qrow0 * 512 + h * 128);
#pragma unroll
        for (int i = 0; i < 8; ++i) {
            const int pq = wu * 8 + i, row = pq * 4 + (lane >> 4), c = (lane & 15) ^ (row & 15);
            __builtin_amdgcn_global_load_lds((const unsigned*)(qg + (size_t)row * 1024 + c * 16), (LAS unsigned*)(lds + 65536 + pq * 1024), 16, 0, 0);
        }
    }
    ATT_STAGE(0, 0);
    asm volatile("s_waitcnt vmcnt(0)" ::: "memory");
    __syncthreads();
    const int rs = (r & 0x13) | ((r & 4) << 1) | ((r & 8) >> 1);
    const int qrow = wave * 32 + r, qx = qrow & 15;
    for (int t = 0; t < nt; ++t) {
        const bool more = (t + 1 < nt);
        if (more) ATT_STAGE(t + 1, ((t + 1) & 1) * 32768);
        const LAS unsigned char* Kb = lds + (t & 1) * 32768;
        const LAS unsigned char* Vb = Kb + 16384;
#pragma unroll 1
        for (int kb = 0; kb < 2; ++kb) {
            const int krow = kb * 32 + rs, kx = krow & 15;
            bf16x8 pf[2][2];
#pragma unroll
            for (int i = 0; i < 2; ++i) {
                f32x16 Sv;
#pragma unroll
                for (int j = 0; j < 16; ++j) Sv[j] = negM;
#pragma unroll
                for (int ks = 0; ks < 4; ++ks) {
                    const bf16x8 kf = *(const LAS bf16x8*)(Kb + krow * 256 + (((i * 8 + ks * 2 + h2) ^ kx) << 4));
                    const bf16x8 qf = *(const LAS bf16x8*)(lds + 65536 + qrow * 256 + (((i * 8 + ks * 2 + h2) ^ qx) << 4));
                    Sv = __builtin_amdgcn_mfma_f32_32x32x16_bf16(kf, qf, Sv, 0, 0, 0);
                }
                float psum = 0.f;
#pragma unroll
                for (int j = 0; j < 16; ++j) { Sv[j] = __builtin_amdgcn_exp2f(Sv[j]); psum += Sv[j]; }
                if (i == 0) ls0 += psum; else ls1 += psum;
#pragma unroll
                for (int s = 0; s < 2; ++s) {
                    u32x4 w; w.x = cvt_pk_bf16(Sv[8 * s + 0], Sv[8 * s + 1]); w.y = cvt_pk_bf16(Sv[8 * s + 2], Sv[8 * s + 3]);
                    w.z = cvt_pk_bf16(Sv[8 * s + 4], Sv[8 * s + 5]); w.w = cvt_pk_bf16(Sv[8 * s + 6], Sv[8 * s + 7]);
                    pf[i][s] = __builtin_bit_cast(bf16x8, w);
                }
            }
#pragma unroll
            for (int et = 0; et < 4; ++et) {
                const int e = et * 32 + r, ex = (e >> 1) & 7;
#pragma unroll
                for (int s = 0; s < 2; ++s) {
                    const bf16x8 vf = *(const LAS bf16x8*)(Vb + e * 128 + (((kb * 4 + s * 2 + h2) ^ ex) << 4));
                    O[0][et] = __builtin_amdgcn_mfma_f32_32x32x16_bf16(vf, pf[0][s], O[0][et], 0, 0, 0);
                    O[1][et] = __builtin_amdgcn_mfma_f32_32x32x16_bf16(vf, pf[1][s], O[1][et], 0, 0, 0);
                }
            }
        }
        asm volatile("s_waitcnt vmcnt(0)" ::: "memory");
        __syncthreads();
    }
    ls0 += shx(ls0, 32, lane); ls1 += shx(ls1, 32, lane);
    const float inv1 = 1.0f / ls0, inv2 = lam / ls1;
    float ss = 0.f;
#pragma unroll
    for (int et = 0; et < 4; ++et)
#pragma unroll
        for (int j = 0; j < 16; ++j) { const float o = O[0][et][j] * inv1 - O[1][et][j] * inv2; O[0][et][j] = o; ss += o * o; }
    ss += shx(ss, 32, lane);
    const float rstd = rsqrtf(ss * (1.0f / 128.0f) + 1e-6f) * post_scale;
    bf16_t* op = MIX + (size_t)(qrow0 + wave * 32 + r) * 1024 + h * 128 + 4 * h2;
#pragma unroll
    for (int et = 0; et < 4; ++et)
#pragma unroll
        for (int g4 = 0; g4 < 4; ++g4) {
            const int e0 = 32 * et + 8 * g4;
            const f32x4 w4 = *(const f32x4*)(subw + e0 + 4 * h2);
            u32x2 w; w.x = cvt_pk_bf16(O[0][et][4 * g4 + 0] * rstd * w4[0], O[0][et][4 * g4 + 1] * rstd * w4[1]);
            w.y = cvt_pk_bf16(O[0][et][4 * g4 + 2] * rstd * w4[2], O[0][et][4 * g4 + 3] * rstd * w4[3]);
            *(u32x2*)(op + e0) = w;
        }
}

__device__ __forceinline__ void ew_item(const bf16_t* EW, bf16_t* MIX, const float* convw, int row0, int row_limit) {
    for (int task = fresh_tid(); task < 192 * 64; task += 512) {
        const int row = row0 + (task >> 6), slot = task & 63;
        if (row >= row_limit) continue;
        int t, L; if (row < NLAT) { t = row & (SEQ - 1); L = SEQ; } else { t = (row - NLAT) & (LCTX - 1); L = LCTX; }
        const bf16_t* er = EW + (size_t)row * 1024;
        if (slot < 32) {
            const int c0 = slot * 8;
            float accv[8];
#pragma unroll
            for (int j = 0; j < 8; ++j) accv[j] = 0.f;
#pragma unroll
            for (int dt = -1; dt <= 1; ++dt) {
                if (t + dt < 0 || t + dt >= L) continue;
                const bf16_t* rp = er + dt * 1024;
                const u32x4 cc = *(const u32x4*)(rp + 256 + c0), cx = *(const u32x4*)(rp + 512 + c0);
                const float* wp = convw + (dt + 1) * 256 + c0;
                const f32x4 wa = *(const f32x4*)(wp), wb = *(const f32x4*)(wp + 4);
                accv[0] += bf_lo(cc.x) * bf_lo(cx.x) * wa[0]; accv[1] += bf_hi(cc.x) * bf_hi(cx.x) * wa[1];
                accv[2] += bf_lo(cc.y) * bf_lo(cx.y) * wa[2]; accv[3] += bf_hi(cc.y) * bf_hi(cx.y) * wa[3];
                accv[4] += bf_lo(cc.z) * bf_lo(cx.z) * wb[0]; accv[5] += bf_hi(cc.z) * bf_hi(cx.z) * wb[1];
                accv[6] += bf_lo(cc.w) * bf_lo(cx.w) * wb[2]; accv[7] += bf_hi(cc.w) * bf_hi(cx.w) * wb[3];
            }
            const u32x4 cb = *(const u32x4*)(er + c0);
            u32x4 w;
            w.x = cvt_pk_bf16(bf_lo(cb.x) * accv[0], bf_hi(cb.x) * accv[1]); w.y = cvt_pk_bf16(bf_lo(cb.y) * accv[2], bf_hi(cb.y) * accv[3]);
            w.z = cvt_pk_bf16(bf_lo(cb.z) * accv[4], bf_hi(cb.z) * accv[5]); w.w = cvt_pk_bf16(bf_lo(cb.w) * accv[6], bf_hi(cb.w) * accv[7]);
            *(u32x4*)(MIX + (size_t)row * 1024 + 512 + c0) = w;
        } else {
            const int ps = slot - 32, c0 = ps * 8, g = ps >> 3, half = 1 << g;
            const int lo = (t - half > 0) ? t - half : 0, hi = (t + half < L) ? t + half : L;
            float sm[8];
#pragma unroll
            for (int j = 0; j < 8; ++j) sm[j] = 0.f;
            const bf16_t* bp = er + 768 + c0 - (size_t)t * 1024;
            for (int jj = lo; jj < hi; ++jj) {
                const u32x4 v = *(const u32x4*)(bp + (size_t)jj * 1024);
                sm[0] += bf_lo(v.x); sm[1] += bf_hi(v.x); sm[2] += bf_lo(v.y); sm[3] += bf_hi(v.y);
                sm[4] += bf_lo(v.z); sm[5] += bf_hi(v.z); sm[6] += bf_lo(v.w); sm[7] += bf_hi(v.w);
            }
            const float ic = 1.0f / (float)(hi - lo);
            const u32x4 sv = *(const u32x4*)(er + 768 + c0);
            u32x4 w;
            w.x = cvt_pk_bf16(sm[0] * ic - bf_lo(sv.x), sm[1] * ic - bf_hi(sv.x)); w.y = cvt_pk_bf16(sm[2] * ic - bf_lo(sv.y), sm[3] * ic - bf_hi(sv.y));
            w.z = cvt_pk_bf16(sm[4] * ic - bf_lo(sv.z), sm[5] * ic - bf_hi(sv.z)); w.w = cvt_pk_bf16(sm[6] * ic - bf_lo(sv.w), sm[7] * ic - bf_hi(sv.w));
            *(u32x4*)(MIX + (size_t)row * 1024 + 768 + c0) = w;
        }
    }
}

__global__ void __launch_bounds__(512, 2) hymba_mega(Params p_unused) {
    extern __shared__ __attribute__((aligned(16))) unsigned char lds_raw[];
    LAS unsigned char* lds = (LAS unsigned char*)lds_raw;
    cg::grid_group grid = cg::this_grid();
    const int G = gridDim.x, bid = blockIdx.x;
#define WSP(T, off) ((T*)(q->ws + (off)))

    for (int item = bid; item < 288 + 20480 + 1; item += G) {
        if (item < 288) mod_item(lds, item);
        else if (item < 288 + 20480) conv_tile(lds, item - 288);
        else rope_item();
    }
    grid.sync();

#pragma unroll 1
    for (int l = 0; l < DEPTH; ++l) {
        const bool lastl = (l == DEPTH - 1);
        { const KArgP q = kargs();
          prep_phase((l == 0) ? q->x : q->out, (l == 0) ? q->ctx : WSP(float, OFF_HC), WSP(bf16_t, OFF_A), q->norm_w + (l * 3 + 0) * D, WSP(float, OFF_MOD) + (size_t)l * 17 * NMODC, 0, 1, NROWS); }
        grid.sync();
        { const KArgP q = kargs();
          Sched1 S{144, 22, G, bid, (const char*)WSP(bf16_t, OFF_A), (const char*)(WSP(bf16_t, OFF_WGU) + (size_t)(l * 2 + 0) * NGU * D), (size_t)256 * D * 2}; EpiSwiGLU E{WSP(bf16_t, OFF_HID)};
          gemm_phase(lds, D, S, E); }
        grid.sync();
        { const KArgP q = kargs();
          Sched1 S{144, 4, G, bid, (const char*)WSP(bf16_t, OFF_HID), (const char*)(WSP(bf16_t, OFF_WDN) + (size_t)(l * 2 + 0) * D * DFF), (size_t)256 * DFF * 2};
          EpiResid E{(l == 0) ? q->x : q->out, (l == 0) ? q->ctx : WSP(float, OFF_HC), q->out, WSP(float, OFF_HC), WSP(float, OFF_MOD) + (size_t)l * 17 * NMODC + 2 * D, 0.5f};
          gemm_phase(lds, DFF, S, E); }
        grid.sync();
        { const KArgP q = kargs();
          prep_phase(q->out, WSP(float, OFF_HC), WSP(bf16_t, OFF_A), q->norm_w + (l * 3 + 1) * D, WSP(float, OFF_MOD) + (size_t)l * 17 * NMODC, 3, 4, NROWS); }
        grid.sync();
        { const KArgP q = kargs();
          SchedIn S{G, bid, (const char*)WSP(bf16_t, OFF_A), (const char*)(WSP(bf16_t, OFF_WIN) + (size_t)l * INC * D), (size_t)256 * D * 2};
          EpiIn E{WSP(bf16_t, OFF_Q), WSP(bf16_t, OFF_KB), WSP(bf16_t, OFF_VT), WSP(bf16_t, OFF_EW), q->q_norm_w + l * 64, q->k_norm_w + l * 64, WSP(float, OFF_ROPE), WSP(float, OFF_ROPE) + 1024};
          gemm_phase(lds, D, S, E); }
        grid.sync();
        {
            const KArgP q = kargs();
            const float lam_init = 0.8f - 0.6f * __expf(-0.3f * (float)l);
            const float* lq = q->lambda_qk + l * 256; const int lane = fresh_tid() & 63;
            const float sa = wave_sum(lq[lane] * lq[64 + lane], lane), sb = wave_sum(lq[128 + lane] * lq[192 + lane], lane);
            const float lam = __expf(sa) - __expf(sb) + lam_init;
            const float mq = wave_max(fabsf(q->q_norm_w[l * 64 + lane]), lane), mk = wave_max(fabsf(q->k_norm_w[l * 64 + lane]), lane);
            const float negM = -(8.0f * LOG2E * mq * mk);
            const int n_ctx = lastl ? 0 : 64;
            const int n_items = 512 + n_ctx + 192;
            for (int item = bid; item < n_items; item += G) {
                if (item < 512 + n_ctx) {
                    int b, h, qrow0, key0, nkeys;
                    if (item < 512) { b = item >> 5; h = (item >> 3) & 3; qrow0 = b * SEQ + (item & 7) * 256; key0 = 0; nkeys = NKEYS; }
                    else { const int it = item - 512; b = it >> 2; h = it & 3; qrow0 = NLAT + b * LCTX; key0 = SEQ; nkeys = LCTX; }
                    attn_item(lds, WSP(bf16_t, OFF_Q), WSP(bf16_t, OFF_KB), WSP(bf16_t, OFF_VT), WSP(bf16_t, OFF_A), b, h, qrow0, key0, nkeys, lam, negM, q->subln_w + l * 128, 1.0f - lam_init);
                } else { const int ch = item - 512 - n_ctx; ew_item(WSP(bf16_t, OFF_EW), WSP(bf16_t, OFF_A), q->conv_w + l * 768, ch * 192, lastl ? NLAT : NROWS); }
            }
        }
        grid.sync();
        const int nMr = lastl ? 128 : 144;
        { const KArgP q = kargs();
          Sched1 S{nMr, 4, G, bid, (const char*)WSP(bf16_t, OFF_A), (const char*)(WSP(bf16_t, OFF_WOUT) + (size_t)l * D * D), (size_t)256 * D * 2};
          EpiResid E{q->out, WSP(float, OFF_HC), q->out, WSP(float, OFF_HC), WSP(float, OFF_MOD) + (size_t)l * 17 * NMODC + 5 * D, 1.0f};
          gemm_phase(lds, D, S, E); }
        grid.sync();
        { const KArgP q = kargs();
          prep_phase(q->out, WSP(float, OFF_HC), WSP(bf16_t, OFF_A), q->norm_w + (l * 3 + 2) * D, WSP(float, OFF_MOD) + (size_t)l * 17 * NMODC, 6, 7, nMr * 256); }
        grid.sync();
        { const KArgP q = kargs();
          Sched1 S{nMr, 22, G, bid, (const char*)WSP(bf16_t, OFF_A), (const char*)(WSP(bf16_t, OFF_WGU) + (size_t)(l * 2 + 1) * NGU * D), (size_t)256 * D * 2}; EpiSwiGLU E{WSP(bf16_t, OFF_HID)};
          gemm_phase(lds, D, S, E); }
        grid.sync();
        { const KArgP q = kargs();
          Sched1 S{nMr, 4, G, bid, (const char*)WSP(bf16_t, OFF_HID), (const char*)(WSP(bf16_t, OFF_WDN) + (size_t)(l * 2 + 1) * D * DFF), (size_t)256 * DFF * 2};
          EpiResid E{q->out, WSP(float, OFF_HC), q->out, WSP(float, OFF_HC), WSP(float, OFF_MOD) + (size_t)l * 17 * NMODC + 8 * D, 0.5f};
          gemm_phase(lds, DFF, S, E); }
        if (!lastl) grid.sync();
    }
#undef WSP
}

extern "C" void kernel_launch(void* const* d_in, const int* in_sizes, int n_in, void* d_out, int out_size, void* d_ws, size_t ws_size, hipStream_t stream) {
    static int grid_blocks = 0;
    if (!grid_blocks) {
        int dev = 0, cus = 0, per_cu = 0;
        hipGetDevice(&dev);
        hipDeviceGetAttribute(&cus, hipDeviceAttributeMultiprocessorCount, dev);
        hipFuncSetAttribute((const void*)hymba_mega, hipFuncAttributeMaxDynamicSharedMemorySize, LDS_BYTES);
        hipOccupancyMaxActiveBlocksPerMultiprocessor(&per_cu, (const void*)hymba_mega, 512, LDS_BYTES);
        if (per_cu < 1) per_cu = 1;
        if (per_cu > 1) per_cu = 1;
        grid_blocks = cus * per_cu;
        if (ws_size < WS_END) fprintf(stderr, "kernel_launch: workspace too small: %zu < %zu\n", ws_size, (size_t)WS_END);
    }
    Params p{};
    p.x = (const float*)d_in[0]; p.c = (const float*)d_in[1]; p.ctx = (const float*)d_in[2]; p.c_ctx = (const float*)d_in[3];
    p.norm_w = (const float*)d_in[4]; p.w_mod = (const float*)d_in[5]; p.b_mod = (const float*)d_in[6];
    p.w_gu1 = (const float*)d_in[7]; p.w_dn1 = (const float*)d_in[8]; p.w_gu2 = (const float*)d_in[9]; p.w_dn2 = (const float*)d_in[10];
    p.w_in = (const float*)d_in[11]; p.w_out = (const float*)d_in[12]; p.q_norm_w = (const float*)d_in[13]; p.k_norm_w = (const float*)d_in[14];
    p.lambda_qk = (const float*)d_in[15]; p.subln_w = (const float*)d_in[16]; p.conv_w = (const float*)d_in[17]; p.pool_w = (const float*)d_in[18]; p.pool_scale = (const float*)d_in[19];
    p.out = (float*)d_out; p.ws = (unsigned char*)d_ws;
    void* args[] = {&p};
    hipError_t e = hipLaunchCooperativeKernel((const void*)hymba_mega, dim3(grid_blocks), dim3(512), args, LDS_BYTES, stream);
    if (e != hipSuccess) fprintf(stderr, "cooperative launch failed: %s (grid %d)\n", hipGetErrorString(e), grid_blocks);
}
```

```cpp
#include <hip/hip_runtime.h>
#include <hip/hip_cooperative_groups.h>
#include <cstdio>
namespace cg = cooperative_groups;

#define LAS __attribute__((address_space(3)))
typedef unsigned short bf16_t;
typedef short bf16x8 __attribute__((ext_vector_type(8)));
typedef float f32x4 __attribute__((ext_vector_type(4)));
typedef float f32x16 __attribute__((ext_vector_type(16)));
typedef unsigned u32x4 __attribute__((ext_vector_type(4)));
typedef unsigned u32x2 __attribute__((ext_vector_type(2)));

constexpr int D = 1024, NB = 16, SEQ = 2048, LCTX = 256, NLAT = NB * SEQ, NCTX = NB * LCTX, NROWS = NLAT + NCTX;
constexpr int DFF = 2816, NGU = 2 * DFF, INC = 2560, NKEYS = SEQ + LCTX, DEPTH = 4, NMODC = 9 * D;
constexpr int LDS_BYTES = 131072 + 8192;
constexpr float LOG2E = 1.4426950408889634f;

constexpr size_t OFF_WGU = 0;
constexpr size_t OFF_WDN = OFF_WGU + (size_t)8 * NGU * D * 2;
constexpr size_t OFF_WIN = OFF_WDN + (size_t)8 * D * DFF * 2;
constexpr size_t OFF_WOUT = OFF_WIN + (size_t)4 * INC * D * 2;
constexpr size_t OFF_MOD = OFF_WOUT + (size_t)4 * D * D * 2;
constexpr size_t OFF_ROPE = OFF_MOD + (size_t)4 * 17 * NMODC * 4;
constexpr size_t OFF_HC = OFF_ROPE + 8192;
constexpr size_t OFF_A = OFF_HC + (size_t)NCTX * D * 4;
constexpr size_t OFF_HID = OFF_A + (size_t)NROWS * D * 2;
constexpr size_t OFF_Q = OFF_HID;
constexpr size_t OFF_KB = OFF_Q + (size_t)NROWS * 512 * 2;
constexpr size_t OFF_VT = OFF_KB + (size_t)NROWS * 512 * 2;
constexpr size_t OFF_EW = OFF_VT + (size_t)NROWS * 512 * 2;
constexpr size_t WS_END = OFF_HID + (size_t)NROWS * DFF * 2;
static_assert(OFF_EW + (size_t)NROWS * 1024 * 2 <= WS_END, "alias region");

struct Params {
    const float *x, *c, *ctx, *c_ctx, *norm_w, *w_mod, *b_mod, *w_gu1, *w_dn1, *w_gu2, *w_dn2, *w_in, *w_out, *q_norm_w, *k_norm_w, *lambda_qk, *subln_w, *conv_w, *pool_w, *pool_scale;
    float* out; unsigned char* ws;
};

typedef const Params __attribute__((address_space(4)))* KArgP;
__device__ __forceinline__ KArgP kargs() { KArgP q = (KArgP)__builtin_amdgcn_kernarg_segment_ptr(); asm volatile("" : "+s"(q)); return q; }
__device__ __forceinline__ unsigned cvt_pk_bf16(float lo, float hi) { unsigned r; asm volatile("v_cvt_pk_bf16_f32 %0, %1, %2" : "=v"(r) : "v"(lo), "v"(hi)); return r; }
__device__ __forceinline__ int fresh_tid() { int t = threadIdx.x; asm volatile("" : "+v"(t)); return t; }
__device__ __forceinline__ float bf_lo(unsigned w) { return __uint_as_float(w << 16); }
__device__ __forceinline__ float bf_hi(unsigned w) { return __uint_as_float(w & 0xffff0000u); }
__device__ __forceinline__ float shx(float v, int mask, int lane) { return __int_as_float(__builtin_amdgcn_ds_bpermute((lane ^ mask) << 2, __float_as_int(v))); }
__device__ __forceinline__ float wave_sum(float v, int lane) {
#pragma unroll
    for (int o = 32; o >= 1; o >>= 1) v += shx(v, o, lane);
    return v;
}
__device__ __forceinline__ float wave_max(float v, int lane) {
#pragma unroll
    for (int o = 32; o >= 1; o >>= 1) v = fmaxf(v, shx(v, o, lane));
    return v;
}

constexpr int BM = 256, BK = 64, HALF = 128, HTB = HALF * BK * 2;
__device__ __forceinline__ int lds_byte(int r, int c) { const int st = (r >> 4) * 2 + (c >> 5), rr = r & 15, cc = c & 31, ob = rr * 64 + cc * 2; return st * 1024 + (ob ^ (((ob >> 9) & 1) << 5)); }
__device__ __forceinline__ void stage_rc(int b, int& R, int& C) { const int st = b / 1024, sb = b % 1024, swz = sb ^ (((sb >> 9) & 1) << 5); R = (st >> 1) * 16 + swz / 64; C = (st & 1) * 32 + (swz % 64) / 2; }

struct GUnit { int pm, pn, kind; const char* a; const char* b; };

__device__ __forceinline__ void tile_of(int L, int nM, int nN, int& pm, int& pn) {
    const int nwg = nM * nN; int wgid = L;
    { const int q = nwg / 8, r = nwg % 8, xcd = wgid % 8, off = wgid / 8; wgid = (xcd < r ? xcd * (q + 1) : r * (q + 1) + (xcd - r) * q) + off; }
    const int nig = 8 * nN, gid = wgid / nig, fm = gid * 8, gsz = (nM - fm) < 8 ? (nM - fm) : 8;
    pm = fm + ((wgid % nig) % gsz); pn = (wgid % nig) / gsz;
}

struct Sched1 {
    int nM, nN, G, c; const char* A; const char* Bt; size_t tstep;
    __device__ __forceinline__ bool next(int i, GUnit& u) const {
        const int L = i * G + c; if (L >= nM * nN) return false;
        tile_of(L, nM, nN, u.pm, u.pn); u.kind = 0; u.a = A + (size_t)u.pm * tstep; u.b = Bt + (size_t)u.pn * tstep; return true;
    }
};
struct SchedIn {
    int G, c; const char* A; const char* Win; size_t tstep;
    __device__ __forceinline__ bool next(int i, GUnit& u) const {
        const int L = i * G + c;
        if (L < 1152) { tile_of(L, 144, 8, u.pm, u.pn); u.kind = 0; u.a = A + (size_t)u.pm * tstep; u.b = Win + (size_t)u.pn * tstep; return true; }
        if (L < 1440) { tile_of(L - 1152, 2, 144, u.pm, u.pn); u.kind = 1; u.a = Win + (size_t)(8 + u.pm) * tstep; u.b = A + (size_t)u.pn * tstep; return true; }
        return false;
    }
};

struct EpiSwiGLU {
    bf16_t* hid;
    __device__ __forceinline__ void operator()(const f32x4 (&acc)[2][2][4][2], const GUnit& u, int wr, int wc, int fr, int fq) const {
        const int row0 = u.pm * BM + wr * 64 + fr;
        const int col0 = u.pn * 128 + wc * 32 + 8 * fq;
#pragma unroll
        for (int ai = 0; ai < 2; ++ai)
#pragma unroll
            for (int m = 0; m < 4; ++m) {
                float v[8];
#pragma unroll
                for (int n = 0; n < 2; ++n)
#pragma unroll
                    for (int j = 0; j < 4; ++j) {
                        const float g = acc[ai][0][m][n][j], uu = acc[ai][1][m][n][j];
                        const float sg = g * __builtin_amdgcn_rcpf(1.0f + __builtin_amdgcn_exp2f(-g * LOG2E));
                        v[n * 4 + j] = sg * uu;
                    }
                u32x4 w; w.x = cvt_pk_bf16(v[0], v[1]); w.y = cvt_pk_bf16(v[2], v[3]); w.z = cvt_pk_bf16(v[4], v[5]); w.w = cvt_pk_bf16(v[6], v[7]);
                *(u32x4*)(hid + (size_t)(row0 + ai * HALF + m * 16) * DFF + col0) = w;
            }
    }
};
struct EpiResid {
    const float* src_lat; const float* src_ctx; float* dst_lat; float* dst_ctx; const float* gate; float coef;
    __device__ __forceinline__ void operator()(const f32x4 (&acc)[2][2][4][2], const GUnit& u, int wr, int wc, int fr, int fq) const {
        const int pm = u.pm; const bool lat = pm < 128;
        const float* sp = lat ? src_lat + (size_t)pm * 256 * D : src_ctx + (size_t)(pm - 128) * 256 * D;
        float* dp = lat ? dst_lat + (size_t)pm * 256 * D : dst_ctx + (size_t)(pm - 128) * 256 * D;
        const int modrow = lat ? (pm >> 3) : 16;
        const int col0 = u.pn * BM + wc * 32 + 4 * fq;
        f32x4 gv[2][2];
#pragma unroll
        for (int bj = 0; bj < 2; ++bj)
#pragma unroll
            for (int n = 0; n < 2; ++n) gv[bj][n] = *(const f32x4*)(gate + (size_t)modrow * NMODC + col0 + bj * HALF + n * 16) * coef;
#pragma unroll
        for (int ai = 0; ai < 2; ++ai)
#pragma unroll
            for (int mp = 0; mp < 2; ++mp) {
                f32x4 rv[2][2][2];
#pragma unroll
                for (int mm = 0; mm < 2; ++mm)
#pragma unroll
                    for (int bj = 0; bj < 2; ++bj)
#pragma unroll
                        for (int n = 0; n < 2; ++n)
                            rv[mm][bj][n] = *(const f32x4*)(sp + (size_t)(wr * 64 + fr + ai * HALF + (mp * 2 + mm) * 16) * D + col0 + bj * HALF + n * 16);
#pragma unroll
                for (int mm = 0; mm < 2; ++mm)
#pragma unroll
                    for (int bj = 0; bj < 2; ++bj)
#pragma unroll
                        for (int n = 0; n < 2; ++n)
                            *(f32x4*)(dp + (size_t)(wr * 64 + fr + ai * HALF + (mp * 2 + mm) * 16) * D + col0 + bj * HALF + n * 16) = rv[mm][bj][n] + gv[bj][n] * acc[ai][bj][mp * 2 + mm][n];
            }
    }
};
struct EpiIn {
    bf16_t *Q, *KB, *VT, *EW; const float *qw, *kw; const LAS float* ropeL;
    __device__ __forceinline__ void operator()(const f32x4 (&acc)[2][2][4][2], const GUnit& u, int wr, int wc, int fr, int fq) const {
        const int pm = u.pm, pn = u.pn;
        if (u.kind == 1) {
            int b, key0; if (pn < 128) { b = pn >> 3; key0 = (pn & 7) * 256; } else { b = pn - 128; key0 = SEQ; }
#pragma unroll
            for (int ai = 0; ai < 2; ++ai)
#pragma unroll
                for (int m = 0; m < 4; ++m) {
                    const int vcol = pm * 256 + ai * HALF + wr * 64 + m * 16 + fr;
                    bf16_t* rowp = VT + (size_t)(b * 512 + vcol) * NKEYS + key0 + wc * 32 + 4 * fq;
#pragma unroll
                    for (int bj = 0; bj < 2; ++bj)
#pragma unroll
                        for (int n = 0; n < 2; ++n) {
                            const f32x4 a = acc[ai][bj][m][n]; u32x2 w; w.x = cvt_pk_bf16(a[0], a[1]); w.y = cvt_pk_bf16(a[2], a[3]);
                            *(u32x2*)(rowp + bj * HALF + n * 16) = w;
                        }
                }
            return;
        }
        const bool lat = pm < 128;
        const int rl0 = wr * 64 + fr;
        if (pn >= 4) {
#pragma unroll
            for (int ai = 0; ai < 2; ++ai)
#pragma unroll
                for (int m = 0; m < 4; ++m) {
                    bf16_t* rowp = EW + (size_t)(pm * 256 + rl0 + ai * HALF + m * 16) * 1024 + (pn - 4) * 256 + wc * 64 + 4 * fq;
#pragma unroll
                    for (int bj = 0; bj < 2; ++bj)
#pragma unroll
                        for (int n = 0; n < 2; ++n) {
                            const f32x4 a = acc[ai][bj][m][n]; u32x2 w; w.x = cvt_pk_bf16(a[0], a[1]); w.y = cvt_pk_bf16(a[2], a[3]);
                            *(u32x2*)(rowp + bj * 32 + n * 16) = w;
                        }
                }
            return;
        }
        const bool isq = pn < 2;
        const float* w = isq ? qw : kw;
        f32x4 wv[2][2];
#pragma unroll
        for (int bj = 0; bj < 2; ++bj)
#pragma unroll
            for (int n = 0; n < 2; ++n) wv[bj][n] = *(const f32x4*)(w + bj * 32 + n * 16 + 4 * fq);
        const float osc = isq ? 0.125f * LOG2E : 1.0f;
        bf16_t* dst; size_t drow0;
        if (isq) { dst = Q; drow0 = (size_t)pm * 256; }
        else { dst = KB; drow0 = lat ? (size_t)(pm >> 3) * NKEYS + (size_t)(pm & 7) * 256 : (size_t)(pm - 128) * NKEYS + SEQ; }
        const int colb = (pn & 1) * 256 + wc * 64 + 4 * fq;
#pragma unroll
        for (int ai = 0; ai < 2; ++ai)
#pragma unroll
            for (int m = 0; m < 4; ++m) {
                const int rl = rl0 + ai * HALF + m * 16;
                float ss = 0.f;
#pragma unroll
                for (int bj = 0; bj < 2; ++bj)
#pragma unroll
                    for (int n = 0; n < 2; ++n) { const f32x4 a = acc[ai][bj][m][n]; ss += a[0] * a[0] + a[1] * a[1] + a[2] * a[2] + a[3] * a[3]; }
                ss += shx(ss, 16, fq * 16 + fr); ss += shx(ss, 32, fq * 16 + fr);
                const float rs = rsqrtf(ss * (1.0f / 64.0f) + 1e-6f) * osc;
                f32x4 y[2][2];
#pragma unroll
                for (int bj = 0; bj < 2; ++bj)
#pragma unroll
                    for (int n = 0; n < 2; ++n) y[bj][n] = acc[ai][bj][m][n] * rs * wv[bj][n];
                if (lat) {
                    const int s = (pm & 7) * 256 + rl;
#pragma unroll
                    for (int bj = 0; bj < 2; ++bj) {
                        const int pos = bj ? (s & 63) : (s >> 6);
                        const f32x4 c4 = *(const LAS f32x4*)(ropeL + pos * 16 + 4 * fq), s4 = *(const LAS f32x4*)(ropeL + 1024 + pos * 16 + 4 * fq);
                        const f32x4 x1 = y[bj][0], x2 = y[bj][1];
                        y[bj][0] = x1 * c4 - x2 * s4; y[bj][1] = x1 * s4 + x2 * c4;
                    }
                }
                bf16_t* rowp = dst + (drow0 + rl) * 512 + colb;
#pragma unroll
                for (int bj = 0; bj < 2; ++bj)
#pragma unroll
                    for (int n = 0; n < 2; ++n) {
                        const f32x4 a = y[bj][n]; u32x2 ww; ww.x = cvt_pk_bf16(a[0], a[1]); ww.y = cvt_pk_bf16(a[2], a[3]);
                        *(u32x2*)(rowp + bj * 32 + n * 16) = ww;
                    }
            }
    }
};

template <class Sched, class Epi>
__device__ __forceinline__ void gemm_phase(LAS unsigned char* lds, const int K, const Sched& S, const Epi& E) {
    const int tid = fresh_tid(), wid = __builtin_amdgcn_readfirstlane(tid >> 6), lane = tid & 63, wr = wid >> 2, wc = wid & 3, fr = lane & 15, fq = lane >> 4;
    const int nt = K / BK;
    unsigned voff[2];
#pragma unroll
    for (int i = 0; i < 2; ++i) { int R, C; stage_rc(tid * 16 + i * 8192, R, C); voff[i] = (unsigned)(R * K + C) * 2u; }
    const size_t kstep = (size_t)(BK * 2);
    const size_t hstep = (size_t)HALF * K * 2;
    const unsigned ldsw = (unsigned)wid * 1024u;
    const int aoff = lds_byte(wr * 64 + fr, fq * 8), boff = lds_byte(wc * 32 + fr, fq * 8);
#define PG8_SA(b, h) (((b) * 2 + (h)) * HTB)
#define PG8_SB(b, h) ((4 + (b) * 2 + (h)) * HTB)
#define PG8_STAGE(bufoff, gbase) do { _Pragma("unroll") for (int _i = 0; _i < 2; ++_i) \
        __builtin_amdgcn_global_load_lds((const unsigned*)((const char*)(gbase) + voff[_i]), (LAS unsigned*)(lds + (bufoff) + ldsw + _i * 8192), 16, 0, 0); } while (0)
#define PG8_LDA(dst, b, h) do { _Pragma("unroll") for (int m = 0; m < 4; ++m) _Pragma("unroll") for (int k = 0; k < 2; ++k) dst[m][k] = *(const LAS bf16x8*)(lds + PG8_SA(b, h) + aoff + m * 2048 + k * 1024); } while (0)
#define PG8_LDB(dst, b, h) do { _Pragma("unroll") for (int n = 0; n < 2; ++n) _Pragma("unroll") for (int k = 0; k < 2; ++k) dst[n][k] = *(const LAS bf16x8*)(lds + PG8_SB(b, h) + boff + n * 2048 + k * 1024); } while (0)
#define PG8_MMA(ai, bj, At, Bt) do { __builtin_amdgcn_s_setprio(1); _Pragma("unroll") for (int m = 0; m < 4; ++m) _Pragma("unroll") for (int n = 0; n < 2; ++n) _Pragma("unroll") for (int k = 0; k < 2; ++k) \
        acc[ai][bj][m][n] = __builtin_amdgcn_mfma_f32_16x16x32_bf16(Bt[n][k], At[m][k], acc[ai][bj][m][n], 0, 0, 0); __builtin_amdgcn_s_setprio(0); } while (0)
#define PG8_WAIT_V(n) asm volatile("s_waitcnt vmcnt(" #n ")" ::: "memory")
#define PG8_WAIT_L(n) asm volatile("s_waitcnt lgkmcnt(" #n ")" ::: "memory")
#define PG8_BAR __builtin_amdgcn_s_barrier()
#define PG8_SCHED __builtin_amdgcn_sched_barrier(0)
    GUnit cur, nxt; int ui = 0;
    if (!S.next(0, cur)) return;
    f32x4 acc[2][2][4][2];
#pragma unroll
    for (int a = 0; a < 2; ++a)
#pragma unroll
        for (int b = 0; b < 2; ++b)
#pragma unroll
            for (int m = 0; m < 4; ++m)
#pragma unroll
                for (int n = 0; n < 2; ++n) acc[a][b][m][n] = (f32x4){0.f, 0.f, 0.f, 0.f};
    bf16x8 At[4][2], B0[2][2], B1[2][2];
    const char* cA = cur.a; const char* cB = cur.b;
    PG8_STAGE(PG8_SB(0, 0), cB); PG8_STAGE(PG8_SA(0, 0), cA); PG8_STAGE(PG8_SB(0, 1), cB + hstep); PG8_STAGE(PG8_SA(0, 1), cA + hstep);
    if (wr == 1) PG8_BAR;
    PG8_WAIT_V(4); PG8_BAR;
    PG8_STAGE(PG8_SB(1, 0), cB + kstep); PG8_STAGE(PG8_SA(1, 0), cA + kstep); PG8_STAGE(PG8_SB(1, 1), cB + hstep + kstep);
    PG8_WAIT_V(6); PG8_BAR;
    for (;;) {
        const bool has_next = S.next(ui + 1, nxt);
        const char* nA = has_next ? nxt.a : cA; const char* nB = has_next ? nxt.b : cB;
        for (int t = 0; t < nt; t += 2) {
            const bool last = (t == nt - 2);
            const char* a1 = cA + (size_t)(t + 1) * kstep;
            const char* a2 = last ? nA : cA + (size_t)(t + 2) * kstep; const char* b2 = last ? nB : cB + (size_t)(t + 2) * kstep;
            const char* a3 = a2 + kstep; const char* b3 = b2 + kstep;
            PG8_LDB(B0, 0, 0); PG8_SCHED; PG8_LDA(At, 0, 0); PG8_STAGE(PG8_SA(1, 1), a1 + hstep);
            PG8_WAIT_L(8); PG8_BAR; PG8_WAIT_L(0); PG8_MMA(0, 0, At, B0); PG8_BAR; PG8_SCHED;
            PG8_LDB(B1, 0, 1); PG8_STAGE(PG8_SB(0, 0), b2);
            PG8_BAR; PG8_WAIT_L(0); PG8_MMA(0, 1, At, B1); PG8_BAR;
            PG8_LDA(At, 0, 1); PG8_STAGE(PG8_SA(0, 0), a2);
            PG8_BAR; PG8_WAIT_L(0); PG8_MMA(1, 0, At, B0); PG8_BAR; PG8_SCHED;
            PG8_STAGE(PG8_SB(0, 1), b2 + hstep);
            PG8_WAIT_V(6); PG8_BAR; PG8_MMA(1, 1, At, B1); PG8_BAR;
            PG8_LDB(B0, 1, 0); PG8_SCHED; PG8_LDA(At, 1, 0); PG8_STAGE(PG8_SA(0, 1), a2 + hstep);
            PG8_WAIT_L(8); PG8_BAR; PG8_WAIT_L(0); PG8_MMA(0, 0, At, B0); PG8_BAR; PG8_SCHED;
            PG8_LDB(B1, 1, 1); PG8_STAGE(PG8_SB(1, 0), b3);
            PG8_BAR; PG8_WAIT_L(0); PG8_MMA(0, 1, At, B1); PG8_BAR;
            PG8_LDA(At, 1, 1); PG8_STAGE(PG8_SA(1, 0), a3);
            PG8_BAR; PG8_WAIT_L(0); PG8_MMA(1, 0, At, B0); PG8_BAR; PG8_SCHED;
            PG8_STAGE(PG8_SB(1, 1), b3 + hstep);
            PG8_WAIT_V(6); PG8_BAR; PG8_MMA(1, 1, At, B1); PG8_BAR;
        }
        E(acc, cur, wr, wc, fr, fq);
        if (!has_next) break;
#pragma unroll
        for (int a = 0; a < 2; ++a)
#pragma unroll
            for (int b = 0; b < 2; ++b)
#pragma unroll
                for (int m = 0; m < 4; ++m)
#pragma unroll
                    for (int n = 0; n < 2; ++n) acc[a][b][m][n] = (f32x4){0.f, 0.f, 0.f, 0.f};
        cur = nxt; cA = nA; cB = nB; ++ui;
    }
    PG8_WAIT_V(0);
    if (wr == 0) PG8_BAR;
    PG8_BAR;
#undef PG8_SA
#undef PG8_SB
#undef PG8_STAGE
#undef PG8_LDA
#undef PG8_LDB
#undef PG8_MMA
#undef PG8_WAIT_V
#undef PG8_WAIT_L
#undef PG8_BAR
#undef PG8_SCHED
}

__device__ __forceinline__ void mod_item(LAS unsigned char* lds, int item) {
    const KArgP pp = kargs(); const float* p_c = pp->c; const float* p_cctx = pp->c_ctx; const float* p_wmod = pp->w_mod; const float* p_bmod = pp->b_mod; unsigned char* p_ws = pp->ws;
    const int tid = fresh_tid(), lane = tid & 63, wave = tid >> 6;
    const int l = item / 72, n0 = (item % 72) * 128;
    LAS float* sil = (LAS float*)lds;
    __syncthreads();
    for (int idx = tid; idx < 17 * 1024; idx += 512) {
        const int r = idx >> 10, k = idx & 1023;
        const float v = (r < 16) ? p_c[r * 1024 + k] : p_cctx[k];
        sil[k * 20 + r] = v / (1.0f + __expf(-v));
    }
    __syncthreads();
    const int cgp = tid & 31, ksl = tid >> 5;
    f32x4 acc[17];
#pragma unroll
    for (int r = 0; r < 17; ++r) acc[r] = (f32x4){0.f, 0.f, 0.f, 0.f};
    const float* wp = p_wmod + ((size_t)l * 1024 + (size_t)ksl * 64) * NMODC + n0 + 4 * cgp;
#pragma unroll 4
    for (int kk = 0; kk < 64; ++kk) {
        const f32x4 w = *(const f32x4*)(wp + (size_t)kk * NMODC);
        const LAS float* sp = sil + (ksl * 64 + kk) * 20;
        const f32x4 s0 = *(const LAS f32x4*)(sp), s1 = *(const LAS f32x4*)(sp + 4), s2 = *(const LAS f32x4*)(sp + 8), s3 = *(const LAS f32x4*)(sp + 12);
        const float s16 = sp[16];
#pragma unroll
        for (int j = 0; j < 4; ++j) { acc[j] += w * s0[j]; acc[4 + j] += w * s1[j]; acc[8 + j] += w * s2[j]; acc[12 + j] += w * s3[j]; }
        acc[16] += w * s16;
    }
#pragma unroll
    for (int r = 0; r < 17; ++r)
#pragma unroll
        for (int j = 0; j < 4; ++j) acc[r][j] += shx(acc[r][j], 32, lane);
    __syncthreads();
    LAS float* red = (LAS float*)lds;
    if (lane < 32) {
#pragma unroll
        for (int r = 0; r < 17; ++r) *(LAS f32x4*)(red + (wave * 17 + r) * 128 + 4 * cgp) = acc[r];
    }
    __syncthreads();
    float* modp = (float*)(p_ws + OFF_MOD);
    for (int o = tid; o < 17 * 128; o += 512) {
        const int r = o >> 7, cc = o & 127;
        float s = p_bmod[l * NMODC + n0 + cc];
#pragma unroll
        for (int w = 0; w < 8; ++w) s += red[(w * 17 + r) * 128 + cc];
        modp[((size_t)l * 17 + r) * NMODC + n0 + cc] = s;
    }
    __syncthreads();
}

__device__ __forceinline__ void conv_tile(LAS unsigned char* lds, int idx) {
    const KArgP p = kargs();
    const int tid = fresh_tid();
    const float* src; bf16_t* dst; int Nsrc, K, ntile, kt, type, l;
    if (idx < 11264) { const int mat = idx / 1408, rem = idx % 1408; ntile = rem >> 4; kt = rem & 15; l = mat >> 1; type = 0;
        src = ((mat & 1) ? p->w_gu2 : p->w_gu1) + (size_t)l * D * NGU; Nsrc = NGU; K = D; dst = (bf16_t*)(p->ws + OFF_WGU) + (size_t)mat * NGU * D; }
    else if (idx < 11264 + 5632) { const int i2 = idx - 11264; const int mat = i2 / 704, rem = i2 % 704; ntile = rem / 44; kt = rem % 44; l = mat >> 1; type = 1;
        src = ((mat & 1) ? p->w_dn2 : p->w_dn1) + (size_t)l * DFF * D; Nsrc = D; K = DFF; dst = (bf16_t*)(p->ws + OFF_WDN) + (size_t)mat * D * DFF; }
    else if (idx < 11264 + 5632 + 2560) { const int i2 = idx - 16896; l = i2 / 640; const int rem = i2 % 640; ntile = rem >> 4; kt = rem & 15; type = 2;
        src = p->w_in + (size_t)l * D * INC; Nsrc = INC; K = D; dst = (bf16_t*)(p->ws + OFF_WIN) + (size_t)l * INC * D; }
    else { const int i2 = idx - 19456; l = i2 >> 8; const int rem = i2 & 255; ntile = rem >> 4; kt = rem & 15; type = 3;
        src = p->w_out + (size_t)l * D * D; Nsrc = D; K = D; dst = (bf16_t*)(p->ws + OFF_WOUT) + (size_t)l * D * D; }
    const int n0 = ntile * 64, k0 = kt * 64;
    LAS float* tile = (LAS float*)lds;
    const int c4 = tid & 15, kk = tid >> 4;
    const int np = n0 + 4 * c4;
    int fcol;
    if (type == 0) { const int s = np & 255; fcol = (s >> 7) * DFF + 128 * (np >> 8) + 32 * ((s >> 5) & 3) + 8 * ((s >> 2) & 3) + 4 * ((s >> 4) & 1); }
    else if (type == 2) {
        if (np < 2048) { const int t8 = np >> 8, s = np & 255, R = s & 127; const int colbase = (t8 < 4) ? t8 * 256 : 1536 + (t8 - 4) * 256; fcol = colbase + 64 * (R >> 5) + 32 * (s >> 7) + (R & 31); }
        else fcol = 1024 + (np - 2048);
    } else fcol = np;
    __syncthreads();
#pragma unroll
    for (int hlf = 0; hlf < 2; ++hlf) {
        const int k = kk + 32 * hlf;
        f32x4 v;
        if (type == 3 && k0 >= 768) {
            const int g = (k0 - 768) >> 6;
            const float* pw = p->pool_w + ((size_t)(l * 4 + g) * 64 + k) * 64;
            const float* sc = p->pool_scale + l * 256 + g * 64;
            const float* ws = src + (size_t)(768 + g * 64) * D + fcol;
            v = (f32x4){0.f, 0.f, 0.f, 0.f};
            for (int d = 0; d < 64; ++d) v += *(const f32x4*)(ws + (size_t)d * D) * (pw[d] * sc[d]);
        } else v = *(const f32x4*)(src + (size_t)(k0 + k) * Nsrc + fcol);
        LAS float* tp = tile + k * 65 + 4 * c4;
        tp[0] = v[0]; tp[1] = v[1]; tp[2] = v[2]; tp[3] = v[3];
    }
    __syncthreads();
    const int n = tid >> 3, kseg = (tid & 7) * 8;
    float f[8];
#pragma unroll
    for (int i = 0; i < 8; ++i) f[i] = tile[(kseg + i) * 65 + n];
    u32x4 w; w.x = cvt_pk_bf16(f[0], f[1]); w.y = cvt_pk_bf16(f[2], f[3]); w.z = cvt_pk_bf16(f[4], f[5]); w.w = cvt_pk_bf16(f[6], f[7]);
    *(u32x4*)(dst + (size_t)(n0 + n) * K + k0 + kseg) = w;
}

__device__ __forceinline__ void rope_item() {
    float* cosT = (float*)(kargs()->ws + OFF_ROPE); float* sinT = cosT + 1024;
    for (int idx = threadIdx.x; idx < 1024; idx += 512) {
        const int pos = idx >> 4, f = idx & 15, fm = f & 3, fqd = f >> 2;
        double inv = (fm == 0) ? 1.0 : (fm == 1) ? 0.5623413251903491 : (fm == 2) ? 0.31622776601683794 : 0.1778279410038923;
        inv *= (fqd == 0) ? 1.0 : (fqd == 1) ? 0.1 : (fqd == 2) ? 0.01 : 0.001;
        const double a = (double)((float)pos * (float)inv);
        const double twopi = 6.283185307179586476925;
        const double nrev = __builtin_rint(a / twopi);
        const double x = a - nrev * twopi, x2 = x * x;
        double sn = 0.0, cs = 0.0, ts = x, tc = 1.0;
#pragma unroll 1
        for (int i = 0; i < 16; ++i) { cs += tc; sn += ts; tc = -tc * x2 / (double)((2 * i + 1) * (2 * i + 2)); ts = -ts * x2 / (double)((2 * i + 2) * (2 * i + 3)); }
        cosT[idx] = (float)cs; sinT[idx] = (float)sn;
    }
}

__device__ __forceinline__ void prep_phase(const float* src_lat, const float* src_ctx, bf16_t* A, const float* nw, const float* modl, int shift_i, int scale_i, int nrows) {
    const int tid = fresh_tid();
    const int lane = tid & 63, gw = blockIdx.x * 8 + (tid >> 6), nwaves = gridDim.x * 8;
    const int rpw = (nrows + nwaves - 1) / nwaves;
    const int r0 = gw * rpw, r1 = (r0 + rpw < nrows) ? r0 + rpw : nrows;
    f32x4 nwv[4], sc[4], sh[4];
#pragma unroll
    for (int q = 0; q < 4; ++q) nwv[q] = *(const f32x4*)(nw + 4 * lane + 256 * q);
    int cur = -1;
    for (int row = r0; row < r1; ++row) {
        const bool lat = row < NLAT;
        const int mr = lat ? (row >> 11) : 16;
        if (mr != cur) {
            cur = mr;
#pragma unroll
            for (int q = 0; q < 4; ++q) {
                sc[q] = *(const f32x4*)(modl + (size_t)mr * NMODC + scale_i * 1024 + 4 * lane + 256 * q) + 1.0f;
                sh[q] = *(const f32x4*)(modl + (size_t)mr * NMODC + shift_i * 1024 + 4 * lane + 256 * q);
            }
        }
        const float* xp = lat ? src_lat + (size_t)row * D : src_ctx + (size_t)(row - NLAT) * D;
        f32x4 x[4]; float ss = 0.f;
#pragma unroll
        for (int q = 0; q < 4; ++q) { x[q] = *(const f32x4*)(xp + 4 * lane + 256 * q); ss += x[q][0] * x[q][0] + x[q][1] * x[q][1] + x[q][2] * x[q][2] + x[q][3] * x[q][3]; }
        ss = wave_sum(ss, lane);
        const float rstd = rsqrtf(ss * (1.0f / 1024.0f) + 1e-6f);
#pragma unroll
        for (int q = 0; q < 4; ++q) {
            const f32x4 y = (x[q] * rstd * nwv[q]) * sc[q] + sh[q];
            u32x2 w; w.x = cvt_pk_bf16(y[0], y[1]); w.y = cvt_pk_bf16(y[2], y[3]);
            *(u32x2*)(A + (size_t)row * D + 4 * lane + 256 * q) = w;
        }
    }
}

__device__ __forceinline__ void attn_item(LAS unsigned char* lds, const bf16_t* Q, const bf16_t* KB, const bf16_t* VT, bf16_t* MIX,
                                          int b, int h, int qrow0, int key0, int nkeys, float lam, float negM, const float* subw, float post_scale) {
    const int tid = fresh_tid(), lane = tid & 63, wave = tid >> 6, r = lane & 31, h2 = lane >> 5;
    f32x16 O[2][4];
#pragma unroll
    for (int i = 0; i < 2; ++i)
#pragma unroll
        for (int et = 0; et < 4; ++et)
#pragma unroll
            for (int j = 0; j < 16; ++j) O[i][et][j] = 0.f;
    float ls0 = 0.f, ls1 = 0.f;
    const char* kg = (const char*)(KB + ((size_t)(b * NKEYS + key0)) * 512 + h * 128);
    const char* vg = (const char*)(VT + ((size_t)(b * 512 + h * 128)) * NKEYS + key0);
    const int wu = __builtin_amdgcn_readfirstlane(wave);
    unsigned kgo[2], vgo[2];
#pragma unroll
    for (int i = 0; i < 2; ++i) {
        const int pc = wu + 8 * i;
        const int key = pc * 4 + (lane >> 4), c = (lane & 15) ^ (key & 15); kgo[i] = (unsigned)(key * 1024 + c * 16);
        const int e = pc * 8 + (lane >> 3), cv = (lane & 7) ^ ((e >> 1) & 7); vgo[i] = (unsigned)(e * (NKEYS * 2) + cv * 16);
    }
    const int nt = nkeys >> 6;
#define ATT_STAGE(t_, bufo_) do { _Pragma("unroll") for (int _i = 0; _i < 2; ++_i) { \
        __builtin_amdgcn_global_load_lds((const unsigned*)(kg + (size_t)(t_) * 65536 + kgo[_i]), (LAS unsigned*)(lds + (bufo_) + (wu + 8 * _i) * 1024), 16, 0, 0); \
        __builtin_amdgcn_global_load_lds((const unsigned*)(vg + (size_t)(t_) * 128 + vgo[_i]), (LAS unsigned*)(lds + (bufo_) + 16384 + (wu + 8 * _i) * 1024), 16, 0, 0); } } while (0)
    __syncthreads();
    {
        const char* qg = (const char*)(Q + (size_t)qrow0 * 512 + h * 128);
#pragma unroll
        for (int i = 0; i < 8; ++i) {
            const int pq = wu * 8 + i, row = pq * 4 + (lane >> 4), c = (lane & 15) ^ (row & 15);
            __builtin_amdgcn_global_load_lds((const unsigned*)(qg + (size_t)row * 1024 + c * 16), (LAS unsigned*)(lds + 65536 + pq * 1024), 16, 0, 0);
        }
    }
    ATT_STAGE(0, 0);
    asm volatile("s_waitcnt vmcnt(0)" ::: "memory");
    __syncthreads();
    const int rs = (r & 0x13) | ((r & 4) << 1) | ((r & 8) >> 1);
    const int qrow = wave * 32 + r, qx = qrow & 15;
    for (int t = 0; t < nt; ++t) {
        const bool more = (t + 1 < nt);
        if (more) ATT_STAGE(t + 1, ((t + 1) & 1) * 32768);
        const LAS unsigned char* Kb = lds + (t & 1) * 32768;
        const LAS unsigned char* Vb = Kb + 16384;
#pragma unroll 1
        for (int kb = 0; kb < 2; ++kb) {
            const int krow = kb * 32 + rs, kx = krow & 15;
            bf16x8 pf[2][2];
#pragma unroll
            for (int i = 0; i < 2; ++i) {
                f32x16 Sv;
#pragma unroll
                for (int j = 0; j < 16; ++j) Sv[j] = negM;
#pragma unroll
                for (int ks = 0; ks < 4; ++ks) {
                    const bf16x8 kf = *(const LAS bf16x8*)(Kb + krow * 256 + (((i * 8 + ks * 2 + h2) ^ kx) << 4));
                    const bf16x8 qf = *(const LAS bf16x8*)(lds + 65536 + qrow * 256 + (((i * 8 + ks * 2 + h2) ^ qx) << 4));
                    Sv = __builtin_amdgcn_mfma_f32_32x32x16_bf16(kf, qf, Sv, 0, 0, 0);
                }
                float psum = 0.f;
#pragma unroll
                for (int j = 0; j < 16; ++j) { Sv[j] = __builtin_amdgcn_exp2f(Sv[j]); psum += Sv[j]; }
                if (i == 0) ls0 += psum; else ls1 += psum;
#pragma unroll
                for (int s = 0; s < 2; ++s) {
                    u32x4 w; w.x = cvt_pk_bf16(Sv[8 * s + 0], Sv[8 * s + 1]); w.y = cvt_pk_bf16(Sv[8 * s + 2], Sv[8 * s + 3]);
                    w.z = cvt_pk_bf16(Sv[8 * s + 4], Sv[8 * s + 5]); w.w = cvt_pk_bf16(Sv[8 * s + 6], Sv[8 * s + 7]);
                    pf[i][s] = __builtin_bit_cast(bf16x8, w);
                }
            }
#pragma unroll
            for (int et = 0; et < 4; ++et) {
                const int e = et * 32 + r, ex = (e >> 1) & 7;
#pragma unroll
                for (int s = 0; s < 2; ++s) {
                    const bf16x8 vf = *(const LAS bf16x8*)(Vb + e * 128 + (((kb * 4 + s * 2 + h2) ^ ex) << 4));
                    O[0][et] = __builtin_amdgcn_mfma_f32_32x32x16_bf16(vf, pf[0][s], O[0][et], 0, 0, 0);
                    O[1][et] = __builtin_amdgcn_mfma_f32_32x32x16_bf16(vf, pf[1][s], O[1][et], 0, 0, 0);
                }
            }
        }
        asm volatile("s_waitcnt vmcnt(0)" ::: "memory");
        __syncthreads();
    }
    ls0 += shx(ls0, 32, lane); ls1 += shx(ls1, 32, lane);
    const float inv1 = 1.0f / ls0, inv2 = lam / ls1;
    float ss = 0.f;
#pragma unroll
    for (int et = 0; et < 4; ++et)
#pragma unroll
        for (int j = 0; j < 16; ++j) { const float o = O[0][et][j] * inv1 - O[1][et][j] * inv2; O[0][et][j] = o; ss += o * o; }
    ss += shx(ss, 32, lane);
    const float rstd = rsqrtf(ss * (1.0f / 128.0f) + 1e-6f) * post_scale;
    bf16_t* op = MIX + (size_t)(qrow0 + wave * 32 + r) * 1024 + h * 128 + 4 * h2;
#pragma unroll
    for (int et = 0; et < 4; ++et)
#pragma unroll
        for (int g4 = 0; g4 < 4; ++g4) {
            const int e0 = 32 * et + 8 * g4;
            const f32x4 w4 = *(const f32x4*)(subw + e0 + 4 * h2);
            u32x2 w; w.x = cvt_pk_bf16(O[0][et][4 * g4 + 0] * rstd * w4[0], O[0][et][4 * g4 + 1] * rstd * w4[1]);
            w.y = cvt_pk_bf16(O[0][et][4 * g4 + 2] * rstd * w4[2], O[0][et][4 * g4 + 3] * rstd * w4[3]);
            *(u32x2*)(op + e0) = w;
        }
}

__device__ __forceinline__ void ew_item(const bf16_t* EW, bf16_t* MIX, const float* convw, int row0, int row_limit) {
    for (int task = fresh_tid(); task < 192 * 64; task += 512) {
        const int row = row0 + (task >> 6), slot = task & 63;
        if (row >= row_limit) continue;
        int t, L; if (row < NLAT) { t = row & (SEQ - 1); L = SEQ; } else { t = (row - NLAT) & (LCTX - 1); L = LCTX; }
        const bf16_t* er = EW + (size_t)row * 1024;
        if (slot < 32) {
            const int c0 = slot * 8;
            float accv[8];
#pragma unroll
            for (int j = 0; j < 8; ++j) accv[j] = 0.f;
#pragma unroll
            for (int dt = -1; dt <= 1; ++dt) {
                if (t + dt < 0 || t + dt >= L) continue;
                const bf16_t* rp = er + dt * 1024;
                const u32x4 cc = *(const u32x4*)(rp + 256 + c0), cx = *(const u32x4*)(rp + 512 + c0);
                const float* wp = convw + (dt + 1) * 256 + c0;
                const f32x4 wa = *(const f32x4*)(wp), wb = *(const f32x4*)(wp + 4);
                accv[0] += bf_lo(cc.x) * bf_lo(cx.x) * wa[0]; accv[1] += bf_hi(cc.x) * bf_hi(cx.x) * wa[1];
                accv[2] += bf_lo(cc.y) * bf_lo(cx.y) * wa[2]; accv[3] += bf_hi(cc.y) * bf_hi(cx.y) * wa[3];
                accv[4] += bf_lo(cc.z) * bf_lo(cx.z) * wb[0]; accv[5] += bf_hi(cc.z) * bf_hi(cx.z) * wb[1];
                accv[6] += bf_lo(cc.w) * bf_lo(cx.w) * wb[2]; accv[7] += bf_hi(cc.w) * bf_hi(cx.w) * wb[3];
            }
            const u32x4 cb = *(const u32x4*)(er + c0);
            u32x4 w;
            w.x = cvt_pk_bf16(bf_lo(cb.x) * accv[0], bf_hi(cb.x) * accv[1]); w.y = cvt_pk_bf16(bf_lo(cb.y) * accv[2], bf_hi(cb.y) * accv[3]);
            w.z = cvt_pk_bf16(bf_lo(cb.z) * accv[4], bf_hi(cb.z) * accv[5]); w.w = cvt_pk_bf16(bf_lo(cb.w) * accv[6], bf_hi(cb.w) * accv[7]);
            *(u32x4*)(MIX + (size_t)row * 1024 + 512 + c0) = w;
        } else {
            const int ps = slot - 32, c0 = ps * 8, g = ps >> 3, half = 1 << g;
            const int lo = (t - half > 0) ? t - half : 0, hi = (t + half < L) ? t + half : L;
            float sm[8];
#pragma unroll
            for (int j = 0; j < 8; ++j) sm[j] = 0.f;
            const bf16_t* bp = er + 768 + c0 - (size_t)t * 1024;
            for (int jj = lo; jj < hi; ++jj) {
                const u32x4 v = *(const u32x4*)(bp + (size_t)jj * 1024);
                sm[0] += bf_lo(v.x); sm[1] += bf_hi(v.x); sm[2] += bf_lo(v.y); sm[3] += bf_hi(v.y);
                sm[4] += bf_lo(v.z); sm[5] += bf_hi(v.z); sm[6] += bf_lo(v.w); sm[7] += bf_hi(v.w);
            }
            const float ic = 1.0f / (float)(hi - lo);
            const u32x4 sv = *(const u32x4*)(er + 768 + c0);
            u32x4 w;
            w.x = cvt_pk_bf16(sm[0] * ic - bf_lo(sv.x), sm[1] * ic - bf_hi(sv.x)); w.y = cvt_pk_bf16(sm[2] * ic - bf_lo(sv.y), sm[3] * ic - bf_hi(sv.y));
            w.z = cvt_pk_bf16(sm[4] * ic - bf_lo(sv.z), sm[5] * ic - bf_hi(sv.z)); w.w = cvt_pk_bf16(sm[6] * ic - bf_lo(sv.w), sm[7] * ic - bf_hi(sv.w));
            *(u32x4*)(MIX + (size_t)row * 1024 + 768 + c0) = w;
        }
    }
}

__global__ void __launch_bounds__(512, 2) hymba_mega(Params p_unused) {
    extern __shared__ __attribute__((aligned(16))) unsigned char lds_raw[];
    LAS unsigned char* lds = (LAS unsigned char*)lds_raw;
    cg::grid_group grid = cg::this_grid();
    const int G = gridDim.x, bid = blockIdx.x;
#define WSP(T, off) ((T*)(q->ws + (off)))

    for (int item = bid; item < 288 + 20480 + 1; item += G) {
        if (item < 288) mod_item(lds, item);
        else if (item < 288 + 20480) conv_tile(lds, item - 288);
        else rope_item();
    }
    grid.sync();

#pragma unroll 1
    for (int l = 0; l < DEPTH; ++l) {
        const bool lastl = (l == DEPTH - 1);
        { const KArgP q = kargs();
          prep_phase((l == 0) ? q->x : q->out, (l == 0) ? q->ctx : WSP(float, OFF_HC), WSP(bf16_t, OFF_A), q->norm_w + (l * 3 + 0) * D, WSP(float, OFF_MOD) + (size_t)l * 17 * NMODC, 0, 1, NROWS); }
        grid.sync();
        { const KArgP q = kargs();
          Sched1 S{144, 22, G, bid, (const char*)WSP(bf16_t, OFF_A), (const char*)(WSP(bf16_t, OFF_WGU) + (size_t)(l * 2 + 0) * NGU * D), (size_t)256 * D * 2}; EpiSwiGLU E{WSP(bf16_t, OFF_HID)};
          gemm_phase(lds, D, S, E); }
        grid.sync();
        { const KArgP q = kargs();
          Sched1 S{144, 4, G, bid, (const char*)WSP(bf16_t, OFF_HID), (const char*)(WSP(bf16_t, OFF_WDN) + (size_t)(l * 2 + 0) * D * DFF), (size_t)256 * DFF * 2};
          EpiResid E{(l == 0) ? q->x : q->out, (l == 0) ? q->ctx : WSP(float, OFF_HC), q->out, WSP(float, OFF_HC), WSP(float, OFF_MOD) + (size_t)l * 17 * NMODC + 2 * D, 0.5f};
          gemm_phase(lds, DFF, S, E); }
        grid.sync();
        { const KArgP q = kargs();
          prep_phase(q->out, WSP(float, OFF_HC), WSP(bf16_t, OFF_A), q->norm_w + (l * 3 + 1) * D, WSP(float, OFF_MOD) + (size_t)l * 17 * NMODC, 3, 4, NROWS); }
        grid.sync();
        { const KArgP q = kargs();
          SchedIn S{G, bid, (const char*)WSP(bf16_t, OFF_A), (const char*)(WSP(bf16_t, OFF_WIN) + (size_t)l * INC * D), (size_t)256 * D * 2};
          { const int t = fresh_tid(); *(LAS f32x4*)(lds + 131072 + t * 16) = *(const f32x4*)(WSP(float, OFF_ROPE) + t * 4); __syncthreads(); }
          EpiIn E{WSP(bf16_t, OFF_Q), WSP(bf16_t, OFF_KB), WSP(bf16_t, OFF_VT), WSP(bf16_t, OFF_EW), q->q_norm_w + l * 64, q->k_norm_w + l * 64, (const LAS float*)(lds + 131072)};
          gemm_phase(lds, D, S, E); }
        grid.sync();
        {
            const KArgP q = kargs();
            const float lam_init = 0.8f - 0.6f * __expf(-0.3f * (float)l);
            const float* lq = q->lambda_qk + l * 256; const int lane = fresh_tid() & 63;
            const float sa = wave_sum(lq[lane] * lq[64 + lane], lane), sb = wave_sum(lq[128 + lane] * lq[192 + lane], lane);
            const float lam = __expf(sa) - __expf(sb) + lam_init;
            const float mq = wave_max(fabsf(q->q_norm_w[l * 64 + lane]), lane), mk = wave_max(fabsf(q->k_norm_w[l * 64 + lane]), lane);
            const float negM = -(8.0f * LOG2E * mq * mk);
            const int n_ctx = lastl ? 0 : 64;
            const int n_items = 512 + n_ctx + 192;
            for (int item = bid; item < n_items; item += G) {
                if (item < 512 + n_ctx) {
                    int b, h, qrow0, key0, nkeys;
                    if (item < 512) { b = item >> 5; h = (item >> 3) & 3; qrow0 = b * SEQ + (item & 7) * 256; key0 = 0; nkeys = NKEYS; }
                    else { const int it = item - 512; b = it >> 2; h = it & 3; qrow0 = NLAT + b * LCTX; key0 = SEQ; nkeys = LCTX; }
                    attn_item(lds, WSP(bf16_t, OFF_Q), WSP(bf16_t, OFF_KB), WSP(bf16_t, OFF_VT), WSP(bf16_t, OFF_A), b, h, qrow0, key0, nkeys, lam, negM, q->subln_w + l * 128, 1.0f - lam_init);
                } else { const int ch = item - 512 - n_ctx; ew_item(WSP(bf16_t, OFF_EW), WSP(bf16_t, OFF_A), q->conv_w + l * 768, ch * 192, lastl ? NLAT : NROWS); }
            }
        }
        grid.sync();
        const int nMr = lastl ? 128 : 144;
        { const KArgP q = kargs();
          Sched1 S{nMr, 4, G, bid, (const char*)WSP(bf16_t, OFF_A), (const char*)(WSP(bf16_t, OFF_WOUT) + (size_t)l * D * D), (size_t)256 * D * 2};
          EpiResid E{q->out, WSP(float, OFF_HC), q->out, WSP(float, OFF_HC), WSP(float, OFF_MOD) + (size_t)l * 17 * NMODC + 5 * D, 1.0f};
          gemm_phase(lds, D, S, E); }
        grid.sync();
        { const KArgP q = kargs();
          prep_phase(q->out, WSP(float, OFF_HC), WSP(bf16_t, OFF_A), q->norm_w + (l * 3 + 2) * D, WSP(float, OFF_MOD) + (size_t)l * 17 * NMODC, 6, 7, nMr * 256); }
        grid.sync();
        { const KArgP q = kargs();
          Sched1 S{nMr, 22, G, bid, (const char*)WSP(bf16_t, OFF_A), (const char*)(WSP(bf16_t, OFF_WGU) + (size_t)(l * 2 + 1) * NGU * D), (size_t)256 * D * 2}; EpiSwiGLU E{WSP(bf16_t, OFF_HID)};
          gemm_phase(lds, D, S, E); }
        grid.sync();
        { const KArgP q = kargs();
          Sched1 S{nMr, 4, G, bid, (const char*)WSP(bf16_t, OFF_HID), (const char*)(WSP(bf16_t, OFF_WDN) + (size_t)(l * 2 + 1) * D * DFF), (size_t)256 * DFF * 2};
          EpiResid E{q->out, WSP(float, OFF_HC), q->out, WSP(float, OFF_HC), WSP(float, OFF_MOD) + (size_t)l * 17 * NMODC + 8 * D, 0.5f};
          gemm_phase(lds, DFF, S, E); }
        if (!lastl) grid.sync();
    }
#undef WSP
}

extern "C" void kernel_launch(void* const* d_in, const int* in_sizes, int n_in, void* d_out, int out_size, void* d_ws, size_t ws_size, hipStream_t stream) {
    static int grid_blocks = 0;
    if (!grid_blocks) {
        int dev = 0, cus = 0, per_cu = 0;
        hipGetDevice(&dev);
        hipDeviceGetAttribute(&cus, hipDeviceAttributeMultiprocessorCount, dev);
        hipFuncSetAttribute((const void*)hymba_mega, hipFuncAttributeMaxDynamicSharedMemorySize, LDS_BYTES);
        hipOccupancyMaxActiveBlocksPerMultiprocessor(&per_cu, (const void*)hymba_mega, 512, LDS_BYTES);
        if (per_cu < 1) per_cu = 1;
        if (per_cu > 1) per_cu = 1;
        grid_blocks = cus * per_cu;
        if (ws_size < WS_END) fprintf(stderr, "kernel_launch: workspace too small: %zu < %zu\n", ws_size, (size_t)WS_END);
    }
    Params p{};
    p.x = (const float*)d_in[0]; p.c = (const float*)d_in[1]; p.ctx = (const float*)d_in[2]; p.c_ctx = (const float*)d_in[3];
    p.norm_w = (const float*)d_in[4]; p.w_mod = (const float*)d_in[5]; p.b_mod = (const float*)d_in[6];
    p.w_gu1 = (const float*)d_in[7]; p.w_dn1 = (const float*)d_in[8]; p.w_gu2 = (const float*)d_in[9]; p.w_dn2 = (const float*)d_in[10];
    p.w_in = (const float*)d_in[11]; p.w_out = (const float*)d_in[12]; p.q_norm_w = (const float*)d_in[13]; p.k_norm_w = (const float*)d_in[14];
    p.lambda_qk = (const float*)d_in[15]; p.subln_w = (const float*)d_in[16]; p.conv_w = (const float*)d_in[17]; p.pool_w = (const float*)d_in[18]; p.pool_scale = (const float*)d_in[19];
    p.out = (float*)d_out; p.ws = (unsigned char*)d_ws;
    void* args[] = {&p};
    hipError_t e = hipLaunchCooperativeKernel((const void*)hymba_mega, dim3(grid_blocks), dim3(512), args, LDS_BYTES, stream);
    if (e != hipSuccess) fprintf(stderr, "cooperative launch failed: %s (grid %d)\n", hipGetErrorString(e), grid_blocks);
}
```

```cpp
#include <hip/hip_runtime.h>
#include <hip/hip_cooperative_groups.h>
#include <cstdio>
namespace cg = cooperative_groups;

#define LAS __attribute__((address_space(3)))
typedef unsigned short bf16_t;
typedef short bf16x8 __attribute__((ext_vector_type(8)));
typedef float f32x4 __attribute__((ext_vector_type(4)));
typedef float f32x16 __attribute__((ext_vector_type(16)));
typedef unsigned u32x4 __attribute__((ext_vector_type(4)));
typedef unsigned u32x2 __attribute__((ext_vector_type(2)));

constexpr int D = 1024, NB = 16, SEQ = 2048, LCTX = 256, NLAT = NB * SEQ, NCTX = NB * LCTX, NROWS = NLAT + NCTX;
constexpr int DFF = 2816, NGU = 2 * DFF, INC = 2560, NKEYS = SEQ + LCTX, DEPTH = 4, NMODC = 9 * D;
constexpr int LDS_BYTES = 131072 + 8192 + 16;
constexpr float LOG2E = 1.4426950408889634f;
#ifndef REP_SYNC
#define REP_SYNC 1
#endif
#ifndef REP_PREP
#define REP_PREP 1
#endif
#ifndef REP_MIX
#define REP_MIX 1
#endif
#ifndef REP_P0
#define REP_P0 1
#endif
#define GRID_SYNC() do { for (int _r = 0; _r < REP_SYNC; ++_r) xcd_barrier(xbar); } while (0)

constexpr size_t OFF_WGU = 0;
constexpr size_t OFF_WDN = OFF_WGU + (size_t)8 * NGU * D * 2;
constexpr size_t OFF_WIN = OFF_WDN + (size_t)8 * D * DFF * 2;
constexpr size_t OFF_WOUT = OFF_WIN + (size_t)4 * INC * D * 2;
constexpr size_t OFF_MOD = OFF_WOUT + (size_t)4 * D * D * 2;
constexpr size_t OFF_ROPE = OFF_MOD + (size_t)4 * 17 * NMODC * 4;
constexpr size_t OFF_HC = OFF_ROPE + 8192;
constexpr size_t OFF_A = OFF_HC + (size_t)NCTX * D * 4;
constexpr size_t OFF_HID = OFF_A + (size_t)NROWS * D * 2;
constexpr size_t OFF_Q = OFF_HID;
constexpr size_t OFF_KB = OFF_Q + (size_t)NROWS * 512 * 2;
constexpr size_t OFF_VT = OFF_KB + (size_t)NROWS * 512 * 2;
constexpr size_t OFF_EW = OFF_VT + (size_t)NROWS * 512 * 2;
constexpr size_t OFF_BAR = OFF_HID + (size_t)NROWS * DFF * 2;
constexpr size_t WS_END = OFF_BAR + 16384;
static_assert(OFF_EW + (size_t)NROWS * 1024 * 2 <= OFF_BAR, "alias region");

struct Params {
    const float *x, *c, *ctx, *c_ctx, *norm_w, *w_mod, *b_mod, *w_gu1, *w_dn1, *w_gu2, *w_dn2, *w_in, *w_out, *q_norm_w, *k_norm_w, *lambda_qk, *subln_w, *conv_w, *pool_w, *pool_scale;
    float* out; unsigned char* ws;
};

typedef const Params __attribute__((address_space(4)))* KArgP;
__device__ __forceinline__ KArgP kargs() { KArgP q = (KArgP)__builtin_amdgcn_kernarg_segment_ptr(); asm volatile("" : "+s"(q)); return q; }
__device__ __forceinline__ unsigned cvt_pk_bf16(float lo, float hi) { unsigned r; asm volatile("v_cvt_pk_bf16_f32 %0, %1, %2" : "=v"(r) : "v"(lo), "v"(hi)); return r; }
__device__ __forceinline__ int fresh_tid() { int t = threadIdx.x; asm volatile("" : "+v"(t)); return t; }
__device__ __forceinline__ float bf_lo(unsigned w) { return __uint_as_float(w << 16); }
__device__ __forceinline__ float bf_hi(unsigned w) { return __uint_as_float(w & 0xffff0000u); }
__device__ __forceinline__ float shx(float v, int mask, int lane) { return __int_as_float(__builtin_amdgcn_ds_bpermute((lane ^ mask) << 2, __float_as_int(v))); }
__device__ __forceinline__ float wave_sum(float v, int lane) {
#pragma unroll
    for (int o = 32; o >= 1; o >>= 1) v += shx(v, o, lane);
    return v;
}
__device__ __forceinline__ float wave_max(float v, int lane) {
#pragma unroll
    for (int o = 32; o >= 1; o >>= 1) v = fmaxf(v, shx(v, o, lane));
    return v;
}

constexpr int BM = 256, BK = 64, HALF = 128, HTB = HALF * BK * 2;
__device__ __forceinline__ int lds_byte(int r, int c) { const int st = (r >> 4) * 2 + (c >> 5), rr = r & 15, cc = c & 31, ob = rr * 64 + cc * 2; return st * 1024 + (ob ^ (((ob >> 9) & 1) << 5)); }
__device__ __forceinline__ void stage_rc(int b, int& R, int& C) { const int st = b / 1024, sb = b % 1024, swz = sb ^ (((sb >> 9) & 1) << 5); R = (st >> 1) * 16 + swz / 64; C = (st & 1) * 32 + (swz % 64) / 2; }

struct GUnit { int pm, pn, kind; const char* a; const char* b; };

__device__ __forceinline__ void tile_of(int L, int nM, int nN, int& pm, int& pn) {
    const int nwg = nM * nN; int wgid = L;
    { const int q = nwg / 8, r = nwg % 8, xcd = wgid % 8, off = wgid / 8; wgid = (xcd < r ? xcd * (q + 1) : r * (q + 1) + (xcd - r) * q) + off; }
    const int nig = 8 * nN, gid = wgid / nig, fm = gid * 8, gsz = (nM - fm) < 8 ? (nM - fm) : 8;
    pm = fm + ((wgid % nig) % gsz); pn = (wgid % nig) / gsz;
}

struct Sched1 {
    int nM, nN, G, c; const char* A; const char* Bt; size_t tstep;
    __device__ __forceinline__ bool next(int i, GUnit& u) const {
        const int L = i * G + c; if (L >= nM * nN) return false;
        tile_of(L, nM, nN, u.pm, u.pn); u.kind = 0; u.a = A + (size_t)u.pm * tstep; u.b = Bt + (size_t)u.pn * tstep; return true;
    }
};
struct SchedIn {
    int G, c; const char* A; const char* Win; size_t tstep;
    __device__ __forceinline__ bool next(int i, GUnit& u) const {
        const int L = i * G + c;
        if (L < 1152) { tile_of(L, 144, 8, u.pm, u.pn); u.kind = 0; u.a = A + (size_t)u.pm * tstep; u.b = Win + (size_t)u.pn * tstep; return true; }
        if (L < 1440) { tile_of(L - 1152, 2, 144, u.pm, u.pn); u.kind = 1; u.a = Win + (size_t)(8 + u.pm) * tstep; u.b = A + (size_t)u.pn * tstep; return true; }
        return false;
    }
};

struct EpiSwiGLU {
    bf16_t* hid;
    __device__ __forceinline__ void operator()(const f32x4 (&acc)[2][2][4][2], const GUnit& u, int wr, int wc, int fr, int fq) const {
        const int row0 = u.pm * BM + wr * 64 + fr;
        const int col0 = u.pn * 128 + wc * 32 + 8 * fq;
#pragma unroll
        for (int ai = 0; ai < 2; ++ai)
#pragma unroll
            for (int m = 0; m < 4; ++m) {
                float v[8];
#pragma unroll
                for (int n = 0; n < 2; ++n)
#pragma unroll
                    for (int j = 0; j < 4; ++j) {
                        const float g = acc[ai][0][m][n][j], uu = acc[ai][1][m][n][j];
                        const float sg = g * __builtin_amdgcn_rcpf(1.0f + __builtin_amdgcn_exp2f(-g * LOG2E));
                        v[n * 4 + j] = sg * uu;
                    }
                u32x4 w; w.x = cvt_pk_bf16(v[0], v[1]); w.y = cvt_pk_bf16(v[2], v[3]); w.z = cvt_pk_bf16(v[4], v[5]); w.w = cvt_pk_bf16(v[6], v[7]);
                *(u32x4*)(hid + (size_t)(row0 + ai * HALF + m * 16) * DFF + col0) = w;
            }
    }
};
struct EpiResid {
    const float* src_lat; const float* src_ctx; float* dst_lat; float* dst_ctx; const float* gate; float coef;
    __device__ __forceinline__ void operator()(const f32x4 (&acc)[2][2][4][2], const GUnit& u, int wr, int wc, int fr, int fq) const {
        const int pm = u.pm; const bool lat = pm < 128;
        const float* sp = lat ? src_lat + (size_t)pm * 256 * D : src_ctx + (size_t)(pm - 128) * 256 * D;
        float* dp = lat ? dst_lat + (size_t)pm * 256 * D : dst_ctx + (size_t)(pm - 128) * 256 * D;
        const int modrow = lat ? (pm >> 3) : 16;
        const int col0 = u.pn * BM + wc * 32 + 4 * fq;
        f32x4 gv[2][2];
#pragma unroll
        for (int bj = 0; bj < 2; ++bj)
#pragma unroll
            for (int n = 0; n < 2; ++n) gv[bj][n] = *(const f32x4*)(gate + (size_t)modrow * NMODC + col0 + bj * HALF + n * 16) * coef;
#pragma unroll
        for (int ai = 0; ai < 2; ++ai)
#pragma unroll
            for (int mp = 0; mp < 2; ++mp) {
                f32x4 rv[2][2][2];
#pragma unroll
                for (int mm = 0; mm < 2; ++mm)
#pragma unroll
                    for (int bj = 0; bj < 2; ++bj)
#pragma unroll
                        for (int n = 0; n < 2; ++n)
                            rv[mm][bj][n] = *(const f32x4*)(sp + (size_t)(wr * 64 + fr + ai * HALF + (mp * 2 + mm) * 16) * D + col0 + bj * HALF + n * 16);
#pragma unroll
                for (int mm = 0; mm < 2; ++mm)
#pragma unroll
                    for (int bj = 0; bj < 2; ++bj)
#pragma unroll
                        for (int n = 0; n < 2; ++n)
                            *(f32x4*)(dp + (size_t)(wr * 64 + fr + ai * HALF + (mp * 2 + mm) * 16) * D + col0 + bj * HALF + n * 16) = rv[mm][bj][n] + gv[bj][n] * acc[ai][bj][mp * 2 + mm][n];
            }
    }
};
struct EpiIn {
    bf16_t *Q, *KB, *VT, *EW; const float *qw, *kw; const LAS float* ropeL;
    __device__ __forceinline__ void operator()(const f32x4 (&acc)[2][2][4][2], const GUnit& u, int wr, int wc, int fr, int fq) const {
        const int pm = u.pm, pn = u.pn;
        if (u.kind == 1) {
            int b, key0; if (pn < 128) { b = pn >> 3; key0 = (pn & 7) * 256; } else { b = pn - 128; key0 = SEQ; }
#pragma unroll
            for (int ai = 0; ai < 2; ++ai)
#pragma unroll
                for (int m = 0; m < 4; ++m) {
                    const int vcol = pm * 256 + ai * HALF + wr * 64 + m * 16 + fr;
                    bf16_t* rowp = VT + (size_t)(b * 512 + vcol) * NKEYS + key0 + wc * 32 + 4 * fq;
#pragma unroll
                    for (int bj = 0; bj < 2; ++bj)
#pragma unroll
                        for (int n = 0; n < 2; ++n) {
                            const f32x4 a = acc[ai][bj][m][n]; u32x2 w; w.x = cvt_pk_bf16(a[0], a[1]); w.y = cvt_pk_bf16(a[2], a[3]);
                            *(u32x2*)(rowp + bj * HALF + n * 16) = w;
                        }
                }
            return;
        }
        const bool lat = pm < 128;
        const int rl0 = wr * 64 + fr;
        if (pn >= 4) {
#pragma unroll
            for (int ai = 0; ai < 2; ++ai)
#pragma unroll
                for (int m = 0; m < 4; ++m) {
                    bf16_t* rowp = EW + (size_t)(pm * 256 + rl0 + ai * HALF + m * 16) * 1024 + (pn - 4) * 256 + wc * 64 + 4 * fq;
#pragma unroll
                    for (int bj = 0; bj < 2; ++bj)
#pragma unroll
                        for (int n = 0; n < 2; ++n) {
                            const f32x4 a = acc[ai][bj][m][n]; u32x2 w; w.x = cvt_pk_bf16(a[0], a[1]); w.y = cvt_pk_bf16(a[2], a[3]);
                            *(u32x2*)(rowp + bj * 32 + n * 16) = w;
                        }
                }
            return;
        }
        const bool isq = pn < 2;
        const float* w = isq ? qw : kw;
        f32x4 wv[2][2];
#pragma unroll
        for (int bj = 0; bj < 2; ++bj)
#pragma unroll
            for (int n = 0; n < 2; ++n) wv[bj][n] = *(const f32x4*)(w + bj * 32 + n * 16 + 4 * fq);
        const float osc = isq ? 0.125f * LOG2E : 1.0f;
        bf16_t* dst; size_t drow0;
        if (isq) { dst = Q; drow0 = (size_t)pm * 256; }
        else { dst = KB; drow0 = lat ? (size_t)(pm >> 3) * NKEYS + (size_t)(pm & 7) * 256 : (size_t)(pm - 128) * NKEYS + SEQ; }
        const int colb = (pn & 1) * 256 + wc * 64 + 4 * fq;
#pragma unroll
        for (int ai = 0; ai < 2; ++ai)
#pragma unroll
            for (int m = 0; m < 4; ++m) {
                const int rl = rl0 + ai * HALF + m * 16;
                float ss = 0.f;
#pragma unroll
                for (int bj = 0; bj < 2; ++bj)
#pragma unroll
                    for (int n = 0; n < 2; ++n) { const f32x4 a = acc[ai][bj][m][n]; ss += a[0] * a[0] + a[1] * a[1] + a[2] * a[2] + a[3] * a[3]; }
                ss += shx(ss, 16, fq * 16 + fr); ss += shx(ss, 32, fq * 16 + fr);
                const float rs = rsqrtf(ss * (1.0f / 64.0f) + 1e-6f) * osc;
                f32x4 y[2][2];
#pragma unroll
                for (int bj = 0; bj < 2; ++bj)
#pragma unroll
                    for (int n = 0; n < 2; ++n) y[bj][n] = acc[ai][bj][m][n] * rs * wv[bj][n];
                if (lat) {
                    const int s = (pm & 7) * 256 + rl;
#pragma unroll
                    for (int bj = 0; bj < 2; ++bj) {
                        const int pos = bj ? (s & 63) : (s >> 6);
                        const f32x4 c4 = *(const LAS f32x4*)(ropeL + pos * 16 + 4 * fq), s4 = *(const LAS f32x4*)(ropeL + 1024 + pos * 16 + 4 * fq);
                        const f32x4 x1 = y[bj][0], x2 = y[bj][1];
                        y[bj][0] = x1 * c4 - x2 * s4; y[bj][1] = x1 * s4 + x2 * c4;
                    }
                }
                bf16_t* rowp = dst + (drow0 + rl) * 512 + colb;
#pragma unroll
                for (int bj = 0; bj < 2; ++bj)
#pragma unroll
                    for (int n = 0; n < 2; ++n) {
                        const f32x4 a = y[bj][n]; u32x2 ww; ww.x = cvt_pk_bf16(a[0], a[1]); ww.y = cvt_pk_bf16(a[2], a[3]);
                        *(u32x2*)(rowp + bj * 32 + n * 16) = ww;
                    }
            }
    }
};

template <class Sched, class Epi>
__device__ __forceinline__ void gemm_phase(LAS unsigned char* lds, const int K, const Sched& S, const Epi& E) {
    const int tid = fresh_tid(), wid = __builtin_amdgcn_readfirstlane(tid >> 6), lane = tid & 63, wr = wid >> 2, wc = wid & 3, fr = lane & 15, fq = lane >> 4;
    const int nt = K / BK;
    unsigned voff[2];
#pragma unroll
    for (int i = 0; i < 2; ++i) { int R, C; stage_rc(tid * 16 + i * 8192, R, C); voff[i] = (unsigned)(R * K + C) * 2u; }
    const size_t kstep = (size_t)(BK * 2);
    const size_t hstep = (size_t)HALF * K * 2;
    const unsigned ldsw = (unsigned)wid * 1024u;
    const int aoff = lds_byte(wr * 64 + fr, fq * 8), boff = lds_byte(wc * 32 + fr, fq * 8);
#define PG8_SA(b, h) (((b) * 2 + (h)) * HTB)
#define PG8_SB(b, h) ((4 + (b) * 2 + (h)) * HTB)
#define PG8_STAGE(bufoff, gbase) do { _Pragma("unroll") for (int _i = 0; _i < 2; ++_i) \
        __builtin_amdgcn_global_load_lds((const unsigned*)((const char*)(gbase) + voff[_i]), (LAS unsigned*)(lds + (bufoff) + ldsw + _i * 8192), 16, 0, 0); } while (0)
#define PG8_LDA(dst, b, h) do { _Pragma("unroll") for (int m = 0; m < 4; ++m) _Pragma("unroll") for (int k = 0; k < 2; ++k) dst[m][k] = *(const LAS bf16x8*)(lds + PG8_SA(b, h) + aoff + m * 2048 + k * 1024); } while (0)
#define PG8_LDB(dst, b, h) do { _Pragma("unroll") for (int n = 0; n < 2; ++n) _Pragma("unroll") for (int k = 0; k < 2; ++k) dst[n][k] = *(const LAS bf16x8*)(lds + PG8_SB(b, h) + boff + n * 2048 + k * 1024); } while (0)
#define PG8_MMA(ai, bj, At, Bt) do { __builtin_amdgcn_s_setprio(1); _Pragma("unroll") for (int m = 0; m < 4; ++m) _Pragma("unroll") for (int n = 0; n < 2; ++n) _Pragma("unroll") for (int k = 0; k < 2; ++k) \
        acc[ai][bj][m][n] = __builtin_amdgcn_mfma_f32_16x16x32_bf16(Bt[n][k], At[m][k], acc[ai][bj][m][n], 0, 0, 0); __builtin_amdgcn_s_setprio(0); } while (0)
#define PG8_WAIT_V(n) asm volatile("s_waitcnt vmcnt(" #n ")" ::: "memory")
#define PG8_WAIT_L(n) asm volatile("s_waitcnt lgkmcnt(" #n ")" ::: "memory")
#define PG8_BAR __builtin_amdgcn_s_barrier()
#define PG8_SCHED __builtin_amdgcn_sched_barrier(0)
    GUnit cur, nxt; int ui = 0;
    if (!S.next(0, cur)) return;
    f32x4 acc[2][2][4][2];
#pragma unroll
    for (int a = 0; a < 2; ++a)
#pragma unroll
        for (int b = 0; b < 2; ++b)
#pragma unroll
            for (int m = 0; m < 4; ++m)
#pragma unroll
                for (int n = 0; n < 2; ++n) acc[a][b][m][n] = (f32x4){0.f, 0.f, 0.f, 0.f};
    bf16x8 At[4][2], B0[2][2], B1[2][2];
    const char* cA = cur.a; const char* cB = cur.b;
    PG8_STAGE(PG8_SB(0, 0), cB); PG8_STAGE(PG8_SA(0, 0), cA); PG8_STAGE(PG8_SB(0, 1), cB + hstep); PG8_STAGE(PG8_SA(0, 1), cA + hstep);
    if (wr == 1) PG8_BAR;
    PG8_WAIT_V(4); PG8_BAR;
    PG8_STAGE(PG8_SB(1, 0), cB + kstep); PG8_STAGE(PG8_SA(1, 0), cA + kstep); PG8_STAGE(PG8_SB(1, 1), cB + hstep + kstep);
    PG8_WAIT_V(6); PG8_BAR;
    for (;;) {
        const bool has_next = S.next(ui + 1, nxt);
        const char* nA = has_next ? nxt.a : cA; const char* nB = has_next ? nxt.b : cB;
        for (int t = 0; t < nt; t += 2) {
            const bool last = (t == nt - 2);
            const char* a1 = cA + (size_t)(t + 1) * kstep;
            const char* a2 = last ? nA : cA + (size_t)(t + 2) * kstep; const char* b2 = last ? nB : cB + (size_t)(t + 2) * kstep;
            const char* a3 = a2 + kstep; const char* b3 = b2 + kstep;
            PG8_LDB(B0, 0, 0); PG8_SCHED; PG8_LDA(At, 0, 0); PG8_STAGE(PG8_SA(1, 1), a1 + hstep);
            PG8_WAIT_L(8); PG8_BAR; PG8_WAIT_L(0); PG8_MMA(0, 0, At, B0); PG8_BAR; PG8_SCHED;
            PG8_LDB(B1, 0, 1); PG8_STAGE(PG8_SB(0, 0), b2);
            PG8_BAR; PG8_WAIT_L(0); PG8_MMA(0, 1, At, B1); PG8_BAR;
            PG8_LDA(At, 0, 1); PG8_STAGE(PG8_SA(0, 0), a2);
            PG8_BAR; PG8_WAIT_L(0); PG8_MMA(1, 0, At, B0); PG8_BAR; PG8_SCHED;
            PG8_STAGE(PG8_SB(0, 1), b2 + hstep);
            PG8_WAIT_V(6); PG8_BAR; PG8_MMA(1, 1, At, B1); PG8_BAR;
            PG8_LDB(B0, 1, 0); PG8_SCHED; PG8_LDA(At, 1, 0); PG8_STAGE(PG8_SA(0, 1), a2 + hstep);
            PG8_WAIT_L(8); PG8_BAR; PG8_WAIT_L(0); PG8_MMA(0, 0, At, B0); PG8_BAR; PG8_SCHED;
            PG8_LDB(B1, 1, 1); PG8_STAGE(PG8_SB(1, 0), b3);
            PG8_BAR; PG8_WAIT_L(0); PG8_MMA(0, 1, At, B1); PG8_BAR;
            PG8_LDA(At, 1, 1); PG8_STAGE(PG8_SA(1, 0), a3);
            PG8_BAR; PG8_WAIT_L(0); PG8_MMA(1, 0, At, B0); PG8_BAR; PG8_SCHED;
            PG8_STAGE(PG8_SB(1, 1), b3 + hstep);
            PG8_WAIT_V(6); PG8_BAR; PG8_MMA(1, 1, At, B1); PG8_BAR;
        }
        E(acc, cur, wr, wc, fr, fq);
        if (!has_next) break;
#pragma unroll
        for (int a = 0; a < 2; ++a)
#pragma unroll
            for (int b = 0; b < 2; ++b)
#pragma unroll
                for (int m = 0; m < 4; ++m)
#pragma unroll
                    for (int n = 0; n < 2; ++n) acc[a][b][m][n] = (f32x4){0.f, 0.f, 0.f, 0.f};
        cur = nxt; cA = nA; cB = nB; ++ui;
    }
    PG8_WAIT_V(0);
    if (wr == 0) PG8_BAR;
    PG8_BAR;
#undef PG8_SA
#undef PG8_SB
#undef PG8_STAGE
#undef PG8_LDA
#undef PG8_LDB
#undef PG8_MMA
#undef PG8_WAIT_V
#undef PG8_WAIT_L
#undef PG8_BAR
#undef PG8_SCHED
}

__device__ __forceinline__ void mod_item(LAS unsigned char* lds, int item) {
    const KArgP pp = kargs(); const float* p_c = pp->c; const float* p_cctx = pp->c_ctx; const float* p_wmod = pp->w_mod; const float* p_bmod = pp->b_mod; unsigned char* p_ws = pp->ws;
    const int tid = fresh_tid(), lane = tid & 63, wave = tid >> 6;
    const int l = item / 72, n0 = (item % 72) * 128;
    LAS float* sil = (LAS float*)lds;
    __syncthreads();
    for (int idx = tid; idx < 17 * 1024; idx += 512) {
        const int r = idx >> 10, k = idx & 1023;
        const float v = (r < 16) ? p_c[r * 1024 + k] : p_cctx[k];
        sil[k * 20 + r] = v / (1.0f + __expf(-v));
    }
    __syncthreads();
    const int cgp = tid & 31, ksl = tid >> 5;
    f32x4 acc[17];
#pragma unroll
    for (int r = 0; r < 17; ++r) acc[r] = (f32x4){0.f, 0.f, 0.f, 0.f};
    const float* wp = p_wmod + ((size_t)l * 1024 + (size_t)ksl * 64) * NMODC + n0 + 4 * cgp;
#pragma unroll 4
    for (int kk = 0; kk < 64; ++kk) {
        const f32x4 w = *(const f32x4*)(wp + (size_t)kk * NMODC);
        const LAS float* sp = sil + (ksl * 64 + kk) * 20;
        const f32x4 s0 = *(const LAS f32x4*)(sp), s1 = *(const LAS f32x4*)(sp + 4), s2 = *(const LAS f32x4*)(sp + 8), s3 = *(const LAS f32x4*)(sp + 12);
        const float s16 = sp[16];
#pragma unroll
        for (int j = 0; j < 4; ++j) { acc[j] += w * s0[j]; acc[4 + j] += w * s1[j]; acc[8 + j] += w * s2[j]; acc[12 + j] += w * s3[j]; }
        acc[16] += w * s16;
    }
#pragma unroll
    for (int r = 0; r < 17; ++r)
#pragma unroll
        for (int j = 0; j < 4; ++j) acc[r][j] += shx(acc[r][j], 32, lane);
    __syncthreads();
    LAS float* red = (LAS float*)lds;
    if (lane < 32) {
#pragma unroll
        for (int r = 0; r < 17; ++r) *(LAS f32x4*)(red + (wave * 17 + r) * 128 + 4 * cgp) = acc[r];
    }
    __syncthreads();
    float* modp = (float*)(p_ws + OFF_MOD);
    for (int o = tid; o < 17 * 128; o += 512) {
        const int r = o >> 7, cc = o & 127;
        float s = p_bmod[l * NMODC + n0 + cc];
#pragma unroll
        for (int w = 0; w < 8; ++w) s += red[(w * 17 + r) * 128 + cc];
        modp[((size_t)l * 17 + r) * NMODC + n0 + cc] = s;
    }
    __syncthreads();
}

__device__ __forceinline__ void conv_tile(LAS unsigned char* lds, int idx) {
    const KArgP p = kargs();
    const int tid = fresh_tid();
    const float* src; bf16_t* dst; int Nsrc, K, ntile, kt, type, l;
    if (idx < 11264) { const int mat = idx / 1408, rem = idx % 1408; ntile = rem >> 4; kt = rem & 15; l = mat >> 1; type = 0;
        src = ((mat & 1) ? p->w_gu2 : p->w_gu1) + (size_t)l * D * NGU; Nsrc = NGU; K = D; dst = (bf16_t*)(p->ws + OFF_WGU) + (size_t)mat * NGU * D; }
    else if (idx < 11264 + 5632) { const int i2 = idx - 11264; const int mat = i2 / 704, rem = i2 % 704; ntile = rem / 44; kt = rem % 44; l = mat >> 1; type = 1;
        src = ((mat & 1) ? p->w_dn2 : p->w_dn1) + (size_t)l * DFF * D; Nsrc = D; K = DFF; dst = (bf16_t*)(p->ws + OFF_WDN) + (size_t)mat * D * DFF; }
    else if (idx < 11264 + 5632 + 2560) { const int i2 = idx - 16896; l = i2 / 640; const int rem = i2 % 640; ntile = rem >> 4; kt = rem & 15; type = 2;
        src = p->w_in + (size_t)l * D * INC; Nsrc = INC; K = D; dst = (bf16_t*)(p->ws + OFF_WIN) + (size_t)l * INC * D; }
    else { const int i2 = idx - 19456; l = i2 >> 8; const int rem = i2 & 255; ntile = rem >> 4; kt = rem & 15; type = 3;
        src = p->w_out + (size_t)l * D * D; Nsrc = D; K = D; dst = (bf16_t*)(p->ws + OFF_WOUT) + (size_t)l * D * D; }
    const int n0 = ntile * 64, k0 = kt * 64;
    LAS float* tile = (LAS float*)lds;
    const int c4 = tid & 15, kk = tid >> 4;
    const int np = n0 + 4 * c4;
    int fcol;
    if (type == 0) { const int s = np & 255; fcol = (s >> 7) * DFF + 128 * (np >> 8) + 32 * ((s >> 5) & 3) + 8 * ((s >> 2) & 3) + 4 * ((s >> 4) & 1); }
    else if (type == 2) {
        if (np < 2048) { const int t8 = np >> 8, s = np & 255, R = s & 127; const int colbase = (t8 < 4) ? t8 * 256 : 1536 + (t8 - 4) * 256; fcol = colbase + 64 * (R >> 5) + 32 * (s >> 7) + (R & 31); }
        else fcol = 1024 + (np - 2048);
    } else fcol = np;
    __syncthreads();
#pragma unroll
    for (int hlf = 0; hlf < 2; ++hlf) {
        const int k = kk + 32 * hlf;
        f32x4 v;
        if (type == 3 && k0 >= 768) {
            const int g = (k0 - 768) >> 6;
            const float* pw = p->pool_w + ((size_t)(l * 4 + g) * 64 + k) * 64;
            const float* sc = p->pool_scale + l * 256 + g * 64;
            const float* ws = src + (size_t)(768 + g * 64) * D + fcol;
            v = (f32x4){0.f, 0.f, 0.f, 0.f};
            for (int d = 0; d < 64; ++d) v += *(const f32x4*)(ws + (size_t)d * D) * (pw[d] * sc[d]);
        } else v = *(const f32x4*)(src + (size_t)(k0 + k) * Nsrc + fcol);
        LAS float* tp = tile + k * 65 + 4 * c4;
        tp[0] = v[0]; tp[1] = v[1]; tp[2] = v[2]; tp[3] = v[3];
    }
    __syncthreads();
    const int n = tid >> 3, kseg = (tid & 7) * 8;
    float f[8];
#pragma unroll
    for (int i = 0; i < 8; ++i) f[i] = tile[(kseg + i) * 65 + n];
    u32x4 w; w.x = cvt_pk_bf16(f[0], f[1]); w.y = cvt_pk_bf16(f[2], f[3]); w.z = cvt_pk_bf16(f[4], f[5]); w.w = cvt_pk_bf16(f[6], f[7]);
    *(u32x4*)(dst + (size_t)(n0 + n) * K + k0 + kseg) = w;
}

__device__ __forceinline__ void rope_item() {
    float* cosT = (float*)(kargs()->ws + OFF_ROPE); float* sinT = cosT + 1024;
    for (int idx = threadIdx.x; idx < 1024; idx += 512) {
        const int pos = idx >> 4, f = idx & 15, fm = f & 3, fqd = f >> 2;
        double inv = (fm == 0) ? 1.0 : (fm == 1) ? 0.5623413251903491 : (fm == 2) ? 0.31622776601683794 : 0.1778279410038923;
        inv *= (fqd == 0) ? 1.0 : (fqd == 1) ? 0.1 : (fqd == 2) ? 0.01 : 0.001;
        const double a = (double)((float)pos * (float)inv);
        const double twopi = 6.283185307179586476925;
        const double nrev = __builtin_rint(a / twopi);
        const double x = a - nrev * twopi, x2 = x * x;
        double sn = 0.0, cs = 0.0, ts = x, tc = 1.0;
#pragma unroll 1
        for (int i = 0; i < 16; ++i) { cs += tc; sn += ts; tc = -tc * x2 / (double)((2 * i + 1) * (2 * i + 2)); ts = -ts * x2 / (double)((2 * i + 2) * (2 * i + 3)); }
        cosT[idx] = (float)cs; sinT[idx] = (float)sn;
    }
}

__device__ __forceinline__ void prep_phase(const float* src_lat, const float* src_ctx, bf16_t* A, const float* nw, const float* modl, int shift_i, int scale_i, int nrows) {
    const int tid = fresh_tid();
    const int lane = tid & 63, gw = blockIdx.x * 8 + (tid >> 6), nwaves = gridDim.x * 8;
    const int rpw = (nrows + nwaves - 1) / nwaves;
    const int r0 = gw * rpw, r1 = (r0 + rpw < nrows) ? r0 + rpw : nrows;
    f32x4 nwv[4], sc[4], sh[4];
#pragma unroll
    for (int q = 0; q < 4; ++q) nwv[q] = *(const f32x4*)(nw + 4 * lane + 256 * q);
    int cur = -1;
    for (int row = r0; row < r1; ++row) {
        const bool lat = row < NLAT;
        const int mr = lat ? (row >> 11) : 16;
        if (mr != cur) {
            cur = mr;
#pragma unroll
            for (int q = 0; q < 4; ++q) {
                sc[q] = *(const f32x4*)(modl + (size_t)mr * NMODC + scale_i * 1024 + 4 * lane + 256 * q) + 1.0f;
                sh[q] = *(const f32x4*)(modl + (size_t)mr * NMODC + shift_i * 1024 + 4 * lane + 256 * q);
            }
        }
        const float* xp = lat ? src_lat + (size_t)row * D : src_ctx + (size_t)(row - NLAT) * D;
        f32x4 x[4]; float ss = 0.f;
#pragma unroll
        for (int q = 0; q < 4; ++q) { x[q] = *(const f32x4*)(xp + 4 * lane + 256 * q); ss += x[q][0] * x[q][0] + x[q][1] * x[q][1] + x[q][2] * x[q][2] + x[q][3] * x[q][3]; }
        ss = wave_sum(ss, lane);
        const float rstd = rsqrtf(ss * (1.0f / 1024.0f) + 1e-6f);
#pragma unroll
        for (int q = 0; q < 4; ++q) {
            const f32x4 y = (x[q] * rstd * nwv[q]) * sc[q] + sh[q];
            u32x2 w; w.x = cvt_pk_bf16(y[0], y[1]); w.y = cvt_pk_bf16(y[2], y[3]);
            *(u32x2*)(A + (size_t)row * D + 4 * lane + 256 * q) = w;
        }
    }
}

__device__ __forceinline__ void attn_item(LAS unsigned char* lds, const bf16_t* Q, const bf16_t* KB, const bf16_t* VT, bf16_t* MIX,
                                          int b, int h, int qrow0, int key0, int nkeys, float lam, float negM, const float* subw, float post_scale) {
    const int tid = fresh_tid(), lane = tid & 63, wave = tid >> 6, r = lane & 31, h2 = lane >> 5;
    f32x16 O[2][4];
#pragma unroll
    for (int i = 0; i < 2; ++i)
#pragma unroll
        for (int et = 0; et < 4; ++et)
#pragma unroll
            for (int j = 0; j < 16; ++j) O[i][et][j] = 0.f;
    float ls0 = 0.f, ls1 = 0.f;
    const char* kg = (const char*)(KB + ((size_t)(b * NKEYS + key0)) * 512 + h * 128);
    const char* vg = (const char*)(VT + ((size_t)(b * 512 + h * 128)) * NKEYS + key0);
    const int wu = __builtin_amdgcn_readfirstlane(wave);
    unsigned kgo[2], vgo[2];
#pragma unroll
    for (int i = 0; i < 2; ++i) {
        const int pc = wu + 8 * i;
        const int key = pc * 4 + (lane >> 4), c = (lane & 15) ^ (key & 15); kgo[i] = (unsigned)(key * 1024 + c * 16);
        const int e = pc * 8 + (lane >> 3), cv = (lane & 7) ^ ((e >> 1) & 7); vgo[i] = (unsigned)(e * (NKEYS * 2) + cv * 16);
    }
    const int nt = nkeys >> 6;
#define ATT_STAGE(t_, bufo_) do { _Pragma("unroll") for (int _i = 0; _i < 2; ++_i) { \
        __builtin_amdgcn_global_load_lds((const unsigned*)(kg + (size_t)(t_) * 65536 + kgo[_i]), (LAS unsigned*)(lds + (bufo_) + (wu + 8 * _i) * 1024), 16, 0, 0); \
        __builtin_amdgcn_global_load_lds((const unsigned*)(vg + (size_t)(t_) * 128 + vgo[_i]), (LAS unsigned*)(lds + (bufo_) + 16384 + (wu + 8 * _i) * 1024), 16, 0, 0); } } while (0)
    __syncthreads();
    {
        const char* qg = (const char*)(Q + (size_t)qrow0 * 512 + h * 128);
#pragma unroll
        for (int i = 0; i < 8; ++i) {
            const int pq = wu * 8 + i, row = pq * 4 + (lane >> 4), c = (lane & 15) ^ (row & 15);
            __builtin_amdgcn_global_load_lds((const unsigned*)(qg + (size_t)row * 1024 + c * 16), (LAS unsigned*)(lds + 65536 + pq * 1024), 16, 0, 0);
        }
    }
    ATT_STAGE(0, 0);
    asm volatile("s_waitcnt vmcnt(0)" ::: "memory");
    __syncthreads();
    const int rs = (r & 0x13) | ((r & 4) << 1) | ((r & 8) >> 1);
    const int qrow = wave * 32 + r, qx = qrow & 15;
    for (int t = 0; t < nt; ++t) {
        const bool more = (t + 1 < nt);
        if (more) ATT_STAGE(t + 1, ((t + 1) & 1) * 32768);
        const LAS unsigned char* Kb = lds + (t & 1) * 32768;
        const LAS unsigned char* Vb = Kb + 16384;
#pragma unroll 1
        for (int kb = 0; kb < 2; ++kb) {
            const int krow = kb * 32 + rs, kx = krow & 15;
            bf16x8 pf[2][2];
#pragma unroll
            for (int i = 0; i < 2; ++i) {
                f32x16 Sv;
#pragma unroll
                for (int j = 0; j < 16; ++j) Sv[j] = negM;
#pragma unroll
                for (int ks = 0; ks < 4; ++ks) {
                    const bf16x8 kf = *(const LAS bf16x8*)(Kb + krow * 256 + (((i * 8 + ks * 2 + h2) ^ kx) << 4));
                    const bf16x8 qf = *(const LAS bf16x8*)(lds + 65536 + qrow * 256 + (((i * 8 + ks * 2 + h2) ^ qx) << 4));
                    Sv = __builtin_amdgcn_mfma_f32_32x32x16_bf16(kf, qf, Sv, 0, 0, 0);
                }
                float psum = 0.f;
#pragma unroll
                for (int j = 0; j < 16; ++j) { Sv[j] = __builtin_amdgcn_exp2f(Sv[j]); psum += Sv[j]; }
                if (i == 0) ls0 += psum; else ls1 += psum;
#pragma unroll
                for (int s = 0; s < 2; ++s) {
                    u32x4 w; w.x = cvt_pk_bf16(Sv[8 * s + 0], Sv[8 * s + 1]); w.y = cvt_pk_bf16(Sv[8 * s + 2], Sv[8 * s + 3]);
                    w.z = cvt_pk_bf16(Sv[8 * s + 4], Sv[8 * s + 5]); w.w = cvt_pk_bf16(Sv[8 * s + 6], Sv[8 * s + 7]);
                    pf[i][s] = __builtin_bit_cast(bf16x8, w);
                }
            }
#pragma unroll
            for (int et = 0; et < 4; ++et) {
                const int e = et * 32 + r, ex = (e >> 1) & 7;
#pragma unroll
                for (int s = 0; s < 2; ++s) {
                    const bf16x8 vf = *(const LAS bf16x8*)(Vb + e * 128 + (((kb * 4 + s * 2 + h2) ^ ex) << 4));
                    O[0][et] = __builtin_amdgcn_mfma_f32_32x32x16_bf16(vf, pf[0][s], O[0][et], 0, 0, 0);
                    O[1][et] = __builtin_amdgcn_mfma_f32_32x32x16_bf16(vf, pf[1][s], O[1][et], 0, 0, 0);
                }
            }
        }
        asm volatile("s_waitcnt vmcnt(0)" ::: "memory");
        __syncthreads();
    }
    ls0 += shx(ls0, 32, lane); ls1 += shx(ls1, 32, lane);
    const float inv1 = 1.0f / ls0, inv2 = lam / ls1;
    float ss = 0.f;
#pragma unroll
    for (int et = 0; et < 4; ++et)
#pragma unroll
        for (int j = 0; j < 16; ++j) { const float o = O[0][et][j] * inv1 - O[1][et][j] * inv2; O[0][et][j] = o; ss += o * o; }
    ss += shx(ss, 32, lane);
    const float rstd = rsqrtf(ss * (1.0f / 128.0f) + 1e-6f) * post_scale;
    bf16_t* op = MIX + (size_t)(qrow0 + wave * 32 + r) * 1024 + h * 128 + 4 * h2;
#pragma unroll
    for (int et = 0; et < 4; ++et)
#pragma unroll
        for (int g4 = 0; g4 < 4; ++g4) {
            const int e0 = 32 * et + 8 * g4;
            const f32x4 w4 = *(const f32x4*)(subw + e0 + 4 * h2);
            u32x2 w; w.x = cvt_pk_bf16(O[0][et][4 * g4 + 0] * rstd * w4[0], O[0][et][4 * g4 + 1] * rstd * w4[1]);
            w.y = cvt_pk_bf16(O[0][et][4 * g4 + 2] * rstd * w4[2], O[0][et][4 * g4 + 3] * rstd * w4[3]);
            *(u32x2*)(op + e0) = w;
        }
}

__device__ __forceinline__ void ew_item(const bf16_t* EW, bf16_t* MIX, const float* convw, int row0, int row_limit) {
    for (int task = fresh_tid(); task < 192 * 64; task += 512) {
        const int row = row0 + (task >> 6), slot = task & 63;
        if (row >= row_limit) continue;
        int t, L; if (row < NLAT) { t = row & (SEQ - 1); L = SEQ; } else { t = (row - NLAT) & (LCTX - 1); L = LCTX; }
        const bf16_t* er = EW + (size_t)row * 1024;
        if (slot < 32) {
            const int c0 = slot * 8;
            float accv[8];
#pragma unroll
            for (int j = 0; j < 8; ++j) accv[j] = 0.f;
#pragma unroll
            for (int dt = -1; dt <= 1; ++dt) {
                if (t + dt < 0 || t + dt >= L) continue;
                const bf16_t* rp = er + dt * 1024;
                const u32x4 cc = *(const u32x4*)(rp + 256 + c0), cx = *(const u32x4*)(rp + 512 + c0);
                const float* wp = convw + (dt + 1) * 256 + c0;
                const f32x4 wa = *(const f32x4*)(wp), wb = *(const f32x4*)(wp + 4);
                accv[0] += bf_lo(cc.x) * bf_lo(cx.x) * wa[0]; accv[1] += bf_hi(cc.x) * bf_hi(cx.x) * wa[1];
                accv[2] += bf_lo(cc.y) * bf_lo(cx.y) * wa[2]; accv[3] += bf_hi(cc.y) * bf_hi(cx.y) * wa[3];
                accv[4] += bf_lo(cc.z) * bf_lo(cx.z) * wb[0]; accv[5] += bf_hi(cc.z) * bf_hi(cx.z) * wb[1];
                accv[6] += bf_lo(cc.w) * bf_lo(cx.w) * wb[2]; accv[7] += bf_hi(cc.w) * bf_hi(cx.w) * wb[3];
            }
            const u32x4 cb = *(const u32x4*)(er + c0);
            u32x4 w;
            w.x = cvt_pk_bf16(bf_lo(cb.x) * accv[0], bf_hi(cb.x) * accv[1]); w.y = cvt_pk_bf16(bf_lo(cb.y) * accv[2], bf_hi(cb.y) * accv[3]);
            w.z = cvt_pk_bf16(bf_lo(cb.z) * accv[4], bf_hi(cb.z) * accv[5]); w.w = cvt_pk_bf16(bf_lo(cb.w) * accv[6], bf_hi(cb.w) * accv[7]);
            *(u32x4*)(MIX + (size_t)row * 1024 + 512 + c0) = w;
        } else {
            const int ps = slot - 32, c0 = ps * 8, g = ps >> 3, half = 1 << g;
            const int lo = (t - half > 0) ? t - half : 0, hi = (t + half < L) ? t + half : L;
            float sm[8];
#pragma unroll
            for (int j = 0; j < 8; ++j) sm[j] = 0.f;
            const bf16_t* bp = er + 768 + c0 - (size_t)t * 1024;
            for (int jj = lo; jj < hi; ++jj) {
                const u32x4 v = *(const u32x4*)(bp + (size_t)jj * 1024);
                sm[0] += bf_lo(v.x); sm[1] += bf_hi(v.x); sm[2] += bf_lo(v.y); sm[3] += bf_hi(v.y);
                sm[4] += bf_lo(v.z); sm[5] += bf_hi(v.z); sm[6] += bf_lo(v.w); sm[7] += bf_hi(v.w);
            }
            const float ic = 1.0f / (float)(hi - lo);
            const u32x4 sv = *(const u32x4*)(er + 768 + c0);
            u32x4 w;
            w.x = cvt_pk_bf16(sm[0] * ic - bf_lo(sv.x), sm[1] * ic - bf_hi(sv.x)); w.y = cvt_pk_bf16(sm[2] * ic - bf_lo(sv.y), sm[3] * ic - bf_hi(sv.y));
            w.z = cvt_pk_bf16(sm[4] * ic - bf_lo(sv.z), sm[5] * ic - bf_hi(sv.z)); w.w = cvt_pk_bf16(sm[6] * ic - bf_lo(sv.w), sm[7] * ic - bf_hi(sv.w));
            *(u32x4*)(MIX + (size_t)row * 1024 + 768 + c0) = w;
        }
    }
}


#define XB_TMO      128
#define XB_XCNT(j)  (256  + 64 * (j))
#define XB_XSUB(j)  (1280 + 64 * (j))
#define XB_XGEN(j)  (2304 + 64 * (j))
#define XB_TOP      3328
#define XB_TOPGEN   3392
#define XCD_BAR_WORDS 3456
#define XB_SPIN_CAP (1u << 22)
__device__ __forceinline__ unsigned xb_ld(unsigned* p)              { return __hip_atomic_load(p, __ATOMIC_RELAXED, __HIP_MEMORY_SCOPE_AGENT); }
__device__ __forceinline__ unsigned xb_add(unsigned* p, unsigned v) { return __hip_atomic_fetch_add(p, v, __ATOMIC_RELAXED, __HIP_MEMORY_SCOPE_AGENT); }
__device__ __forceinline__ unsigned xb_xcc_id() { return (unsigned)__builtin_amdgcn_s_getreg((3 << 11) | 20) & 0xFu; }
#define XB_SPIN(cond, bar) do { unsigned _sp = 0; while (cond) { __builtin_amdgcn_s_sleep(1); \
    if ((++_sp & 255u) == 0u) { if (xb_ld(&(bar)[XB_TMO])) break; if (_sp > XB_SPIN_CAP) { atomicAdd(&(bar)[XB_TMO], 1u); break; } } } } while (0)
struct XcdBarrier { unsigned* bar; unsigned x; volatile LAS unsigned* st; };
__device__ __forceinline__ XcdBarrier xcd_barrier_post(unsigned* bar, volatile LAS unsigned* st) {
    XcdBarrier b; b.bar = bar; b.x = xb_xcc_id(); b.st = st;
    if (threadIdx.x == 0) (void)xb_add(&bar[XB_XCNT(b.x)], 1u);
    return b;
}
__device__ __forceinline__ void xcd_barrier_complete(unsigned* bar, unsigned x, unsigned& nloc, unsigned& nx) {
    const unsigned G = gridDim.x * gridDim.y * gridDim.z;
    unsigned sum, cnt, mine, sp = 0u;
    for (;;) {
        sum = 0u; cnt = 0u; mine = 0u;
#pragma unroll
        for (unsigned j = 0; j < 16; ++j) { const unsigned c = xb_ld(&bar[XB_XCNT(j)]); sum += c; cnt += (c > 0u) ? 1u : 0u; mine = (j == x) ? c : mine; }
        if (sum == G) break;
        __builtin_amdgcn_s_sleep(1);
        if ((++sp & 255u) == 0u) { if (xb_ld(&bar[XB_TMO])) break; if (sp > XB_SPIN_CAP) { atomicAdd(&bar[XB_TMO], 1u); break; } }
    }
    nloc = mine > 0u ? mine : 1u; nx = cnt > 0u ? cnt : 1u;
}
__device__ __forceinline__ void xcd_barrier(const XcdBarrier& b) {
    asm volatile("s_waitcnt vmcnt(0)" ::: "memory");
    __syncthreads();
    if (threadIdx.x == 0) {
        unsigned* bar = b.bar;
        __builtin_amdgcn_s_waitcnt(0);
        unsigned nloc = b.st[0], nx = b.st[1];
        if (nloc == 0u) { xcd_barrier_complete(bar, b.x, nloc, nx); b.st[0] = nloc; b.st[1] = nx; }
        const unsigned old = xb_add(&bar[XB_XSUB(b.x)], 1u);
        const unsigned gen = old / nloc;
        if (old + 1u == (gen + 1u) * nloc) {
            __builtin_amdgcn_fence(__ATOMIC_RELEASE, "agent");
            asm volatile("s_waitcnt vmcnt(0)" ::: "memory");
            const unsigned og = xb_add(&bar[XB_TOP], 1u);
            const unsigned tg = og / nx;
            if (og + 1u == (tg + 1u) * nx) xb_add(&bar[XB_TOPGEN], 1u);
            else XB_SPIN(xb_ld(&bar[XB_TOPGEN]) == tg, bar);
            __builtin_amdgcn_fence(__ATOMIC_ACQUIRE, "agent");
            xb_add(&bar[XB_XGEN(b.x)], 1u);
            asm volatile("s_waitcnt vmcnt(0)" ::: "memory");
        } else {
            XB_SPIN(xb_ld(&bar[XB_XGEN(b.x)]) == gen, bar);
            __builtin_amdgcn_fence(__ATOMIC_ACQUIRE, "agent");
            asm volatile("s_waitcnt vmcnt(0)" ::: "memory");
        }
    }
    __syncthreads();
}

__global__ void __launch_bounds__(512, 2) hymba_mega(Params p_unused) {
    extern __shared__ __attribute__((aligned(16))) unsigned char lds_raw[];
    LAS unsigned char* lds = (LAS unsigned char*)lds_raw;
    cg::grid_group grid = cg::this_grid();
    const int G = gridDim.x, bid = blockIdx.x;
#define WSP(T, off) ((T*)(q->ws + (off)))
    volatile LAS unsigned* xst = (volatile LAS unsigned*)(lds + 131072 + 8192);
    if (threadIdx.x < 4) xst[threadIdx.x] = 0u;
    __syncthreads();
    const XcdBarrier xbar = xcd_barrier_post((unsigned*)(kargs()->ws + OFF_BAR), xst);

    for (int rep = 0; rep < REP_P0; ++rep)
    for (int item = bid; item < 288 + 20480 + 1; item += G) {
        if (item < 288) mod_item(lds, item);
        else if (item < 288 + 20480) conv_tile(lds, item - 288);
        else rope_item();
    }
    grid.sync();

#pragma unroll 1
    for (int l = 0; l < DEPTH; ++l) {
        const bool lastl = (l == DEPTH - 1);
        { const KArgP q = kargs();
          for (int rep = 0; rep < REP_PREP; ++rep) prep_phase((l == 0) ? q->x : q->out, (l == 0) ? q->ctx : WSP(float, OFF_HC), WSP(bf16_t, OFF_A), q->norm_w + (l * 3 + 0) * D, WSP(float, OFF_MOD) + (size_t)l * 17 * NMODC, 0, 1, NROWS); }
        GRID_SYNC();
        { const KArgP q = kargs();
          Sched1 S{144, 22, G, bid, (const char*)WSP(bf16_t, OFF_A), (const char*)(WSP(bf16_t, OFF_WGU) + (size_t)(l * 2 + 0) * NGU * D), (size_t)256 * D * 2}; EpiSwiGLU E{WSP(bf16_t, OFF_HID)};
          gemm_phase(lds, D, S, E); }
        GRID_SYNC();
        { const KArgP q = kargs();
          Sched1 S{144, 4, G, bid, (const char*)WSP(bf16_t, OFF_HID), (const char*)(WSP(bf16_t, OFF_WDN) + (size_t)(l * 2 + 0) * D * DFF), (size_t)256 * DFF * 2};
          EpiResid E{(l == 0) ? q->x : q->out, (l == 0) ? q->ctx : WSP(float, OFF_HC), q->out, WSP(float, OFF_HC), WSP(float, OFF_MOD) + (size_t)l * 17 * NMODC + 2 * D, 0.5f};
          gemm_phase(lds, DFF, S, E); }
        GRID_SYNC();
        { const KArgP q = kargs();
          for (int rep = 0; rep < REP_PREP; ++rep) prep_phase(q->out, WSP(float, OFF_HC), WSP(bf16_t, OFF_A), q->norm_w + (l * 3 + 1) * D, WSP(float, OFF_MOD) + (size_t)l * 17 * NMODC, 3, 4, NROWS); }
        GRID_SYNC();
        { const KArgP q = kargs();
          SchedIn S{G, bid, (const char*)WSP(bf16_t, OFF_A), (const char*)(WSP(bf16_t, OFF_WIN) + (size_t)l * INC * D), (size_t)256 * D * 2};
          { const int t = fresh_tid(); *(LAS f32x4*)(lds + 131072 + t * 16) = *(const f32x4*)(WSP(float, OFF_ROPE) + t * 4); __syncthreads(); }
          EpiIn E{WSP(bf16_t, OFF_Q), WSP(bf16_t, OFF_KB), WSP(bf16_t, OFF_VT), WSP(bf16_t, OFF_EW), q->q_norm_w + l * 64, q->k_norm_w + l * 64, (const LAS float*)(lds + 131072)};
          gemm_phase(lds, D, S, E); }
        GRID_SYNC();
        {
            const KArgP q = kargs();
            const float lam_init = 0.8f - 0.6f * __expf(-0.3f * (float)l);
            const float* lq = q->lambda_qk + l * 256; const int lane = fresh_tid() & 63;
            const float sa = wave_sum(lq[lane] * lq[64 + lane], lane), sb = wave_sum(lq[128 + lane] * lq[192 + lane], lane);
            const float lam = __expf(sa) - __expf(sb) + lam_init;
            const float mq = wave_max(fabsf(q->q_norm_w[l * 64 + lane]), lane), mk = wave_max(fabsf(q->k_norm_w[l * 64 + lane]), lane);
            const float negM = -(8.0f * LOG2E * mq * mk);
            const int n_ctx = lastl ? 0 : 64;
            const int n_items = 512 + n_ctx + 192;
            for (int rep = 0; rep < REP_MIX; ++rep)
            for (int item = bid; item < n_items; item += G) {
                if (item < 512 + n_ctx) {
                    int b, h, qrow0, key0, nkeys;
                    if (item < 512) { b = item >> 5; h = (item >> 3) & 3; qrow0 = b * SEQ + (item & 7) * 256; key0 = 0; nkeys = NKEYS; }
                    else { const int it = item - 512; b = it >> 2; h = it & 3; qrow0 = NLAT + b * LCTX; key0 = SEQ; nkeys = LCTX; }
                    attn_item(lds, WSP(bf16_t, OFF_Q), WSP(bf16_t, OFF_KB), WSP(bf16_t, OFF_VT), WSP(bf16_t, OFF_A), b, h, qrow0, key0, nkeys, lam, negM, q->subln_w + l * 128, 1.0f - lam_init);
                } else { const int ch = item - 512 - n_ctx; ew_item(WSP(bf16_t, OFF_EW), WSP(bf16_t, OFF_A), q->conv_w + l * 768, ch * 192, lastl ? NLAT : NROWS); }
            }
        }
        GRID_SYNC();
        const int nMr = lastl ? 128 : 144;
        { const KArgP q = kargs();
          Sched1 S{nMr, 4, G, bid, (const char*)WSP(bf16_t, OFF_A), (const char*)(WSP(bf16_t, OFF_WOUT) + (size_t)l * D * D), (size_t)256 * D * 2};
          EpiResid E{q->out, WSP(float, OFF_HC), q->out, WSP(float, OFF_HC), WSP(float, OFF_MOD) + (size_t)l * 17 * NMODC + 5 * D, 1.0f};
          gemm_phase(lds, D, S, E); }
        GRID_SYNC();
        { const KArgP q = kargs();
          for (int rep = 0; rep < REP_PREP; ++rep) prep_phase(q->out, WSP(float, OFF_HC), WSP(bf16_t, OFF_A), q->norm_w + (l * 3 + 2) * D, WSP(float, OFF_MOD) + (size_t)l * 17 * NMODC, 6, 7, nMr * 256); }
        GRID_SYNC();
        { const KArgP q = kargs();
          Sched1 S{nMr, 22, G, bid, (const char*)WSP(bf16_t, OFF_A), (const char*)(WSP(bf16_t, OFF_WGU) + (size_t)(l * 2 + 1) * NGU * D), (size_t)256 * D * 2}; EpiSwiGLU E{WSP(bf16_t, OFF_HID)};
          gemm_phase(lds, D, S, E); }
        GRID_SYNC();
        { const KArgP q = kargs();
          Sched1 S{nMr, 4, G, bid, (const char*)WSP(bf16_t, OFF_HID), (const char*)(WSP(bf16_t, OFF_WDN) + (size_t)(l * 2 + 1) * D * DFF), (size_t)256 * DFF * 2};
          EpiResid E{q->out, WSP(float, OFF_HC), q->out, WSP(float, OFF_HC), WSP(float, OFF_MOD) + (size_t)l * 17 * NMODC + 8 * D, 0.5f};
          gemm_phase(lds, DFF, S, E); }
        if (!lastl) GRID_SYNC();
    }
#undef WSP
}

extern "C" void kernel_launch(void* const* d_in, const int* in_sizes, int n_in, void* d_out, int out_size, void* d_ws, size_t ws_size, hipStream_t stream) {
    static int grid_blocks = 0;
    if (!grid_blocks) {
        int dev = 0, cus = 0, per_cu = 0;
        hipGetDevice(&dev);
        hipDeviceGetAttribute(&cus, hipDeviceAttributeMultiprocessorCount, dev);
        hipFuncSetAttribute((const void*)hymba_mega, hipFuncAttributeMaxDynamicSharedMemorySize, LDS_BYTES);
        hipOccupancyMaxActiveBlocksPerMultiprocessor(&per_cu, (const void*)hymba_mega, 512, LDS_BYTES);
        if (per_cu < 1) per_cu = 1;
        if (per_cu > 1) per_cu = 1;
        grid_blocks = cus * per_cu;
        if (ws_size < WS_END) fprintf(stderr, "kernel_launch: workspace too small: %zu < %zu\n", ws_size, (size_t)WS_END);
    }
    Params p{};
    p.x = (const float*)d_in[0]; p.c = (const float*)d_in[1]; p.ctx = (const float*)d_in[2]; p.c_ctx = (const float*)d_in[3];
    p.norm_w = (const float*)d_in[4]; p.w_mod = (const float*)d_in[5]; p.b_mod = (const float*)d_in[6];
    p.w_gu1 = (const float*)d_in[7]; p.w_dn1 = (const float*)d_in[8]; p.w_gu2 = (const float*)d_in[9]; p.w_dn2 = (const float*)d_in[10];
    p.w_in = (const float*)d_in[11]; p.w_out = (const float*)d_in[12]; p.q_norm_w = (const float*)d_in[13]; p.k_norm_w = (const float*)d_in[14];
    p.lambda_qk = (const float*)d_in[15]; p.subln_w = (const float*)d_in[16]; p.conv_w = (const float*)d_in[17]; p.pool_w = (const float*)d_in[18]; p.pool_scale = (const float*)d_in[19];
    p.out = (float*)d_out; p.ws = (unsigned char*)d_ws;
    (void)hipMemsetAsync((unsigned char*)d_ws + OFF_BAR, 0, 16384, stream);
    void* args[] = {&p};
    hipError_t e = hipLaunchCooperativeKernel((const void*)hymba_mega, dim3(grid_blocks), dim3(512), args, LDS_BYTES, stream);
    if (e != hipSuccess) fprintf(stderr, "cooperative launch failed: %s (grid %d)\n", hipGetErrorString(e), grid_blocks);
}
```

```cpp
#include <hip/hip_runtime.h>
#include <hip/hip_cooperative_groups.h>
#include <cstdio>
namespace cg = cooperative_groups;

#define LAS __attribute__((address_space(3)))
typedef unsigned short bf16_t;
typedef short bf16x8 __attribute__((ext_vector_type(8)));
typedef float f32x4 __attribute__((ext_vector_type(4)));
typedef float f32x16 __attribute__((ext_vector_type(16)));
typedef unsigned u32x4 __attribute__((ext_vector_type(4)));
typedef unsigned u32x2 __attribute__((ext_vector_type(2)));

constexpr int D = 1024, NB = 16, SEQ = 2048, LCTX = 256, NLAT = NB * SEQ, NCTX = NB * LCTX, NROWS = NLAT + NCTX;
constexpr int DFF = 2816, NGU = 2 * DFF, INC = 2560, NKEYS = SEQ + LCTX, DEPTH = 4, NMODC = 9 * D;
constexpr int LDS_BYTES = 131072 + 8192 + 16;
constexpr float LOG2E = 1.4426950408889634f;
#ifndef REP_SYNC
#define REP_SYNC 1
#endif
#ifndef REP_PREP
#define REP_PREP 1
#endif
#ifndef REP_MIX
#define REP_MIX 1
#endif
#ifndef REP_P0
#define REP_P0 1
#endif
#define GRID_SYNC() do { for (int _r = 0; _r < REP_SYNC; ++_r) xcd_barrier(xbar); } while (0)

constexpr size_t OFF_WGU = 0;
constexpr size_t OFF_WDN = OFF_WGU + (size_t)8 * NGU * D * 2;
constexpr size_t OFF_WIN = OFF_WDN + (size_t)8 * D * DFF * 2;
constexpr size_t OFF_WOUT = OFF_WIN + (size_t)4 * INC * D * 2;
constexpr size_t OFF_MOD = OFF_WOUT + (size_t)4 * D * D * 2;
constexpr size_t OFF_ROPE = OFF_MOD + (size_t)4 * 17 * NMODC * 4;
constexpr size_t OFF_HC = OFF_ROPE + 8192;
constexpr size_t OFF_A = OFF_HC + (size_t)NCTX * D * 4;
constexpr size_t OFF_HID = OFF_A + (size_t)NROWS * D * 2;
constexpr size_t OFF_Q = OFF_HID;
constexpr size_t OFF_KB = OFF_Q + (size_t)NROWS * 512 * 2;
constexpr size_t OFF_VT = OFF_KB + (size_t)NROWS * 512 * 2;
constexpr size_t OFF_EW = OFF_VT + (size_t)NROWS * 512 * 2;
constexpr size_t OFF_Y0 = OFF_HID + (size_t)NROWS * DFF * 2;
constexpr size_t OFF_YC = OFF_Y0;
constexpr size_t OFF_BAR = OFF_YC + (size_t)3 * NCTX * D * 2;
constexpr size_t WS_END = OFF_BAR + 16384;
static_assert(OFF_EW + (size_t)NROWS * 1024 * 2 <= OFF_BAR, "alias region");

struct Params {
    const float *x, *c, *ctx, *c_ctx, *norm_w, *w_mod, *b_mod, *w_gu1, *w_dn1, *w_gu2, *w_dn2, *w_in, *w_out, *q_norm_w, *k_norm_w, *lambda_qk, *subln_w, *conv_w, *pool_w, *pool_scale;
    float* out; unsigned char* ws;
};

typedef const Params __attribute__((address_space(4)))* KArgP;
__device__ __forceinline__ KArgP kargs() { KArgP q = (KArgP)__builtin_amdgcn_kernarg_segment_ptr(); asm volatile("" : "+s"(q)); return q; }
__device__ __forceinline__ unsigned cvt_pk_bf16(float lo, float hi) { unsigned r; asm volatile("v_cvt_pk_bf16_f32 %0, %1, %2" : "=v"(r) : "v"(lo), "v"(hi)); return r; }
__device__ __forceinline__ int fresh_tid() { int t = threadIdx.x; asm volatile("" : "+v"(t)); return t; }
__device__ __forceinline__ float uniformf(float v) { return __int_as_float(__builtin_amdgcn_readfirstlane(__float_as_int(v))); }
__device__ __forceinline__ float bf_lo(unsigned w) { return __uint_as_float(w << 16); }
__device__ __forceinline__ float bf_hi(unsigned w) { return __uint_as_float(w & 0xffff0000u); }
__device__ __forceinline__ float shx(float v, int mask, int lane) { return __int_as_float(__builtin_amdgcn_ds_bpermute((lane ^ mask) << 2, __float_as_int(v))); }
__device__ __forceinline__ float wave_sum(float v, int lane) {
#pragma unroll
    for (int o = 32; o >= 1; o >>= 1) v += shx(v, o, lane);
    return v;
}
__device__ __forceinline__ float wave_max(float v, int lane) {
#pragma unroll
    for (int o = 32; o >= 1; o >>= 1) v = fmaxf(v, shx(v, o, lane));
    return v;
}

constexpr int BM = 256, BK = 64, HALF = 128, HTB = HALF * BK * 2;
__device__ __forceinline__ int lds_byte(int r, int c) { const int st = (r >> 4) * 2 + (c >> 5), rr = r & 15, cc = c & 31, ob = rr * 64 + cc * 2; return st * 1024 + (ob ^ (((ob >> 9) & 1) << 5)); }
__device__ __forceinline__ void stage_rc(int b, int& R, int& C) { const int st = b / 1024, sb = b % 1024, swz = sb ^ (((sb >> 9) & 1) << 5); R = (st >> 1) * 16 + swz / 64; C = (st & 1) * 32 + (swz % 64) / 2; }

struct GUnit { int pm, pn, kind, nt; const char* a; const char* b; };

__device__ __forceinline__ int unit_index(int i, int c_, int U) {
    int c = c_; asm volatile("" : "+s"(c));
    const int x = c & 7, off = c >> 3;
    const int R = (U + 255) >> 8, nx = (U - ((R - 1) << 8)) >> 5;
    const int start = (x < nx) ? x * R * 32 : nx * R * 32 + (x - nx) * (R - 1) * 32;
    const int mine = (x < nx) ? R : R - 1;
    return (i < mine) ? start + i * 32 + off : -1;
}
__device__ __forceinline__ void tile_of(int wgid, int nM, int nN, int& pm, int& pn) {
    const int nig = 8 * nN, gid = wgid / nig, fm = gid * 8, gsz = (nM - fm) < 8 ? (nM - fm) : 8;
    pm = fm + ((wgid % nig) % gsz); pn = (wgid % nig) / gsz;
}
__device__ __forceinline__ int stagger_ticks(int total_units, int c_, int nt) {
    int c = c_; asm volatile("" : "+s"(c));
    const int x = c & 7;
    const int R = (total_units + 255) >> 8, nx = (total_units - ((R - 1) << 8)) >> 5;
    if (x < nx || nx == 8) return 0;
    return (int)((float)(x - nx + 1) * (float)(nt * 140) * __builtin_amdgcn_rcpf((float)(8 - nx + 1)));
}
__device__ __forceinline__ void stagger_wait(int ticks) {
    if (ticks <= 0) return;
    const unsigned long long t0 = __builtin_amdgcn_s_memrealtime();
    while ((long long)(__builtin_amdgcn_s_memrealtime() - t0) < (long long)ticks) __builtin_amdgcn_s_sleep(16);
}
struct Sched1 {
    int nM, nN, G, c; const char* A; const char* Bt; size_t tstep; int nt;
    __device__ __forceinline__ bool next(int i, GUnit& u) const {
        const int L = unit_index(i, c, nM * nN); if (L < 0) return false;
        tile_of(L, nM, nN, u.pm, u.pn); u.kind = 0; u.nt = nt; u.a = A + (size_t)u.pm * tstep; u.b = Bt + (size_t)u.pn * tstep; return true;
    }
};
struct SchedIn {
    int G, c; const char* A; const char* Win; size_t tstep;
    __device__ __forceinline__ bool next(int i, GUnit& u) const {
        const int L = unit_index(i, c, 1440);
        if (L < 0) return false;
        u.nt = 16;
        if (L < 1152) { tile_of(L, 144, 8, u.pm, u.pn); u.kind = 0; u.a = A + (size_t)u.pm * tstep; u.b = Win + (size_t)u.pn * tstep; return true; }
        if (L < 1440) { tile_of(L - 1152, 2, 144, u.pm, u.pn); u.kind = 1; u.a = Win + (size_t)(8 + u.pm) * tstep; u.b = A + (size_t)u.pn * tstep; return true; }
        return false;
    }
};

struct SchedR {
    int c; bool has_ctx; const char* A; const char* Bt; size_t tstep; int NT;
    __device__ __forceinline__ bool next(int i, GUnit& u) const {
        if (i < 2) { const int L = unit_index(i, c, 512); tile_of(L, 128, 4, u.pm, u.pn); u.kind = 0; u.nt = NT; u.a = A + (size_t)u.pm * tstep; u.b = Bt + (size_t)u.pn * tstep; return true; }
        if (i == 2 && has_ctx) {
            int cc = c; asm volatile("" : "+s"(cc));
            const int Lc = (cc & 7) * 32 + (cc >> 3), ct = Lc >> 2, sp = Lc & 3;
            u.pm = 128 + (ct >> 2); u.pn = ct & 3; u.kind = sp;
            int ks;
            if (NT == 44) { ks = sp * 12 - (sp == 3 ? 2 : 0); u.nt = (sp < 2) ? 12 : 10; } else { ks = sp * (NT >> 2); u.nt = NT >> 2; }
            u.a = A + (size_t)u.pm * tstep + (size_t)ks * 128; u.b = Bt + (size_t)u.pn * tstep + (size_t)ks * 128; return true;
        }
        return false;
    }
};

struct EpiSwiGLU {
    bf16_t* hid;
    __device__ __forceinline__ void operator()(const f32x4 (&acc)[2][2][4][2], const GUnit& u, int wr, int wc, int fr, int fq) const {
        const int row0 = u.pm * BM + wr * 64 + fr;
        const int col0 = u.pn * 128 + wc * 32 + 8 * fq;
#pragma unroll
        for (int ai = 0; ai < 2; ++ai)
#pragma unroll
            for (int m = 0; m < 4; ++m) {
                float v[8];
#pragma unroll
                for (int n = 0; n < 2; ++n)
#pragma unroll
                    for (int j = 0; j < 4; ++j) {
                        const float g = acc[ai][0][m][n][j], uu = acc[ai][1][m][n][j];
                        const float sg = g * __builtin_amdgcn_rcpf(1.0f + __builtin_amdgcn_exp2f(-g * LOG2E));
                        v[n * 4 + j] = sg * uu;
                    }
                u32x4 w; w.x = cvt_pk_bf16(v[0], v[1]); w.y = cvt_pk_bf16(v[2], v[3]); w.z = cvt_pk_bf16(v[4], v[5]); w.w = cvt_pk_bf16(v[6], v[7]);
                *(u32x4*)(hid + (size_t)(row0 + ai * HALF + m * 16) * DFF + col0) = w;
            }
    }
};
struct EpiResid {
    const float* src_lat; const float* src_ctx; float* dst_lat; float* dst_ctx; const float* gate; float coef; bf16_t* Yc;
    __device__ __forceinline__ void operator()(const f32x4 (&acc)[2][2][4][2], const GUnit& u, int wr, int wc, int fr, int fq) const {
        if (u.kind != 0) {
            const int pmc = u.pm - 128; const int colc = u.pn * BM + wc * 32 + 4 * fq;
            bf16_t* yb = Yc + ((size_t)(u.kind - 1) * NCTX + (size_t)pmc * 256) * D;
            f32x4 gq[2][2];
#pragma unroll
            for (int bj = 0; bj < 2; ++bj)
#pragma unroll
                for (int n = 0; n < 2; ++n) gq[bj][n] = *(const f32x4*)(gate + (size_t)16 * NMODC + colc + bj * HALF + n * 16) * coef;
#pragma unroll
            for (int ai = 0; ai < 2; ++ai)
#pragma unroll
                for (int m = 0; m < 4; ++m) {
                    bf16_t* rowp = yb + (size_t)(wr * 64 + fr + ai * HALF + m * 16) * D + colc;
#pragma unroll
                    for (int bj = 0; bj < 2; ++bj)
#pragma unroll
                        for (int n = 0; n < 2; ++n) {
                            const f32x4 a = gq[bj][n] * acc[ai][bj][m][n]; u32x2 w; w.x = cvt_pk_bf16(a[0], a[1]); w.y = cvt_pk_bf16(a[2], a[3]);
                            *(u32x2*)(rowp + bj * HALF + n * 16) = w;
                        }
                }
            return;
        }
        const int pm = u.pm; const bool lat = pm < 128;
        const float* sp = lat ? src_lat + (size_t)pm * 256 * D : src_ctx + (size_t)(pm - 128) * 256 * D;
        float* dp = lat ? dst_lat + (size_t)pm * 256 * D : dst_ctx + (size_t)(pm - 128) * 256 * D;
        const int modrow = lat ? (pm >> 3) : 16;
        const int col0 = u.pn * BM + wc * 32 + 4 * fq;
        f32x4 gv[2][2];
#pragma unroll
        for (int bj = 0; bj < 2; ++bj)
#pragma unroll
            for (int n = 0; n < 2; ++n) gv[bj][n] = *(const f32x4*)(gate + (size_t)modrow * NMODC + col0 + bj * HALF + n * 16) * coef;
#pragma unroll
        for (int ai = 0; ai < 2; ++ai)
#pragma unroll
            for (int mp = 0; mp < 2; ++mp) {
                f32x4 rv[2][2][2];
#pragma unroll
                for (int mm = 0; mm < 2; ++mm)
#pragma unroll
                    for (int bj = 0; bj < 2; ++bj)
#pragma unroll
                        for (int n = 0; n < 2; ++n)
                            rv[mm][bj][n] = *(const f32x4*)(sp + (size_t)(wr * 64 + fr + ai * HALF + (mp * 2 + mm) * 16) * D + col0 + bj * HALF + n * 16);
#pragma unroll
                for (int mm = 0; mm < 2; ++mm)
#pragma unroll
                    for (int bj = 0; bj < 2; ++bj)
#pragma unroll
                        for (int n = 0; n < 2; ++n)
                            *(f32x4*)(dp + (size_t)(wr * 64 + fr + ai * HALF + (mp * 2 + mm) * 16) * D + col0 + bj * HALF + n * 16) = rv[mm][bj][n] + gv[bj][n] * acc[ai][bj][mp * 2 + mm][n];
            }
    }
};
struct EpiY {
    bf16_t* Y0; bf16_t* Yc; const float* gate; float coef;
    __device__ __forceinline__ void operator()(const f32x4 (&acc)[2][2][4][2], const GUnit& u, int wr, int wc, int fr_, int fq_) const {
        int fr = fr_, fq = fq_; asm volatile("" : "+v"(fr), "+v"(fq));
        const int pm = u.pm; const int modrow = (pm < 128) ? (pm >> 3) : 16;
        const int col0 = u.pn * BM + wc * 32 + 4 * fq;
        bf16_t* yb = (u.kind == 0) ? Y0 + (size_t)pm * 256 * D : Yc + ((size_t)(u.kind - 1) * NCTX + (size_t)(pm - 128) * 256) * D;
        f32x4 gv[2][2];
#pragma unroll
        for (int bj = 0; bj < 2; ++bj)
#pragma unroll
            for (int n = 0; n < 2; ++n) gv[bj][n] = *(const f32x4*)(gate + (size_t)modrow * NMODC + col0 + bj * HALF + n * 16) * coef;
#pragma unroll
        for (int ai = 0; ai < 2; ++ai)
#pragma unroll
            for (int m = 0; m < 4; ++m) {
                bf16_t* rowp = yb + (size_t)(wr * 64 + fr + ai * HALF + m * 16) * D + col0;
#pragma unroll
                for (int bj = 0; bj < 2; ++bj)
#pragma unroll
                    for (int n = 0; n < 2; ++n) {
                        const f32x4 a = gv[bj][n] * acc[ai][bj][m][n]; u32x2 w; w.x = cvt_pk_bf16(a[0], a[1]); w.y = cvt_pk_bf16(a[2], a[3]);
                        *(u32x2*)(rowp + bj * HALF + n * 16) = w;
                    }
            }
    }
};
struct EpiIn {
    bf16_t *Q, *KB, *VT, *EW; const float *qw, *kw; const LAS float* ropeL;
    __device__ __forceinline__ void operator()(const f32x4 (&acc)[2][2][4][2], const GUnit& u, int wr, int wc, int fr, int fq) const {
        const int pm = u.pm, pn = u.pn;
        if (u.kind == 1) {
            int b, key0; if (pn < 128) { b = pn >> 3; key0 = (pn & 7) * 256; } else { b = pn - 128; key0 = SEQ; }
#pragma unroll
            for (int ai = 0; ai < 2; ++ai)
#pragma unroll
                for (int m = 0; m < 4; ++m) {
                    const int vcol = pm * 256 + ai * HALF + wr * 64 + m * 16 + fr;
                    bf16_t* rowp = VT + (size_t)(b * 512 + vcol) * NKEYS + key0 + wc * 32 + 4 * fq;
#pragma unroll
                    for (int bj = 0; bj < 2; ++bj)
#pragma unroll
                        for (int n = 0; n < 2; ++n) {
                            const f32x4 a = acc[ai][bj][m][n]; u32x2 w; w.x = cvt_pk_bf16(a[0], a[1]); w.y = cvt_pk_bf16(a[2], a[3]);
                            *(u32x2*)(rowp + bj * HALF + n * 16) = w;
                        }
                }
            return;
        }
        const bool lat = pm < 128;
        const int rl0 = wr * 64 + fr;
        if (pn >= 4) {
#pragma unroll
            for (int ai = 0; ai < 2; ++ai)
#pragma unroll
                for (int m = 0; m < 4; ++m) {
                    bf16_t* rowp = EW + (size_t)(pm * 256 + rl0 + ai * HALF + m * 16) * 1024 + (pn - 4) * 256 + wc * 64 + 4 * fq;
#pragma unroll
                    for (int bj = 0; bj < 2; ++bj)
#pragma unroll
                        for (int n = 0; n < 2; ++n) {
                            const f32x4 a = acc[ai][bj][m][n]; u32x2 w; w.x = cvt_pk_bf16(a[0], a[1]); w.y = cvt_pk_bf16(a[2], a[3]);
                            *(u32x2*)(rowp + bj * 32 + n * 16) = w;
                        }
                }
            return;
        }
        const bool isq = pn < 2;
        const float* w = isq ? qw : kw;
        f32x4 wv[2][2];
#pragma unroll
        for (int bj = 0; bj < 2; ++bj)
#pragma unroll
            for (int n = 0; n < 2; ++n) wv[bj][n] = *(const f32x4*)(w + bj * 32 + n * 16 + 4 * fq);
        const float osc = isq ? 0.125f * LOG2E : 1.0f;
        bf16_t* dst; size_t drow0;
        if (isq) { dst = Q; drow0 = (size_t)pm * 256; }
        else { dst = KB; drow0 = lat ? (size_t)(pm >> 3) * NKEYS + (size_t)(pm & 7) * 256 : (size_t)(pm - 128) * NKEYS + SEQ; }
        const int colb = (pn & 1) * 256 + wc * 64 + 4 * fq;
#pragma unroll
        for (int ai = 0; ai < 2; ++ai)
#pragma unroll
            for (int m = 0; m < 4; ++m) {
                const int rl = rl0 + ai * HALF + m * 16;
                float ss = 0.f;
#pragma unroll
                for (int bj = 0; bj < 2; ++bj)
#pragma unroll
                    for (int n = 0; n < 2; ++n) { const f32x4 a = acc[ai][bj][m][n]; ss += a[0] * a[0] + a[1] * a[1] + a[2] * a[2] + a[3] * a[3]; }
                ss += shx(ss, 16, fq * 16 + fr); ss += shx(ss, 32, fq * 16 + fr);
                const float rs = rsqrtf(ss * (1.0f / 64.0f) + 1e-6f) * osc;
                f32x4 y[2][2];
#pragma unroll
                for (int bj = 0; bj < 2; ++bj)
#pragma unroll
                    for (int n = 0; n < 2; ++n) y[bj][n] = acc[ai][bj][m][n] * rs * wv[bj][n];
                if (lat) {
                    const int s = (pm & 7) * 256 + rl;
#pragma unroll
                    for (int bj = 0; bj < 2; ++bj) {
                        const int pos = bj ? (s & 63) : (s >> 6);
                        const f32x4 c4 = *(const LAS f32x4*)(ropeL + pos * 16 + 4 * fq), s4 = *(const LAS f32x4*)(ropeL + 1024 + pos * 16 + 4 * fq);
                        const f32x4 x1 = y[bj][0], x2 = y[bj][1];
                        y[bj][0] = x1 * c4 - x2 * s4; y[bj][1] = x1 * s4 + x2 * c4;
                    }
                }
                bf16_t* rowp = dst + (drow0 + rl) * 512 + colb;
#pragma unroll
                for (int bj = 0; bj < 2; ++bj)
#pragma unroll
                    for (int n = 0; n < 2; ++n) {
                        const f32x4 a = y[bj][n]; u32x2 ww; ww.x = cvt_pk_bf16(a[0], a[1]); ww.y = cvt_pk_bf16(a[2], a[3]);
                        *(u32x2*)(rowp + bj * 32 + n * 16) = ww;
                    }
            }
    }
};

template <class Sched, class Epi>
__device__ __forceinline__ void gemm_phase(LAS unsigned char* lds, const int K, const Sched& S, const Epi& E, const int delay_ticks) {
    const int tid = fresh_tid(), wid = __builtin_amdgcn_readfirstlane(tid >> 6), lane = tid & 63, wr = wid >> 2, wc = wid & 3, fr = lane & 15, fq = lane >> 4;
    unsigned voff[2];
#pragma unroll
    for (int i = 0; i < 2; ++i) { int R, C; stage_rc(tid * 16 + i * 8192, R, C); voff[i] = (unsigned)(R * K + C) * 2u; }
    const size_t kstep = (size_t)(BK * 2);
    const size_t hstep = (size_t)HALF * K * 2;
    const unsigned ldsw = (unsigned)wid * 1024u;
    const int aoff = lds_byte(wr * 64 + fr, fq * 8), boff = lds_byte(wc * 32 + fr, fq * 8);
#define PG8_SA(b, h) (((b) * 2 + (h)) * HTB)
#define PG8_SB(b, h) ((4 + (b) * 2 + (h)) * HTB)
#define PG8_STAGE(bufoff, gbase) do { _Pragma("unroll") for (int _i = 0; _i < 2; ++_i) \
        __builtin_amdgcn_global_load_lds((const unsigned*)((const char*)(gbase) + voff[_i]), (LAS unsigned*)(lds + (bufoff) + ldsw + _i * 8192), 16, 0, 0); } while (0)
#define PG8_LDA(dst, b, h) do { _Pragma("unroll") for (int m = 0; m < 4; ++m) _Pragma("unroll") for (int k = 0; k < 2; ++k) dst[m][k] = *(const LAS bf16x8*)(lds + PG8_SA(b, h) + aoff + m * 2048 + k * 1024); } while (0)
#define PG8_LDB(dst, b, h) do { _Pragma("unroll") for (int n = 0; n < 2; ++n) _Pragma("unroll") for (int k = 0; k < 2; ++k) dst[n][k] = *(const LAS bf16x8*)(lds + PG8_SB(b, h) + boff + n * 2048 + k * 1024); } while (0)
#define PG8_MMA(ai, bj, At, Bt) do { __builtin_amdgcn_s_setprio(1); _Pragma("unroll") for (int m = 0; m < 4; ++m) _Pragma("unroll") for (int n = 0; n < 2; ++n) _Pragma("unroll") for (int k = 0; k < 2; ++k) \
        acc[ai][bj][m][n] = __builtin_amdgcn_mfma_f32_16x16x32_bf16(Bt[n][k], At[m][k], acc[ai][bj][m][n], 0, 0, 0); __builtin_amdgcn_s_setprio(0); } while (0)
#define PG8_WAIT_V(n) asm volatile("s_waitcnt vmcnt(" #n ")" ::: "memory")
#define PG8_WAIT_L(n) asm volatile("s_waitcnt lgkmcnt(" #n ")" ::: "memory")
#define PG8_BAR __builtin_amdgcn_s_barrier()
#define PG8_SCHED __builtin_amdgcn_sched_barrier(0)
    GUnit cur, nxt; int ui = 0;
    if (!S.next(0, cur)) return;
    (void)delay_ticks;
    f32x4 acc[2][2][4][2];
#pragma unroll
    for (int a = 0; a < 2; ++a)
#pragma unroll
        for (int b = 0; b < 2; ++b)
#pragma unroll
            for (int m = 0; m < 4; ++m)
#pragma unroll
                for (int n = 0; n < 2; ++n) acc[a][b][m][n] = (f32x4){0.f, 0.f, 0.f, 0.f};
    bf16x8 At[4][2], B0[2][2], B1[2][2];
    const char* cA = cur.a; const char* cB = cur.b;
    PG8_STAGE(PG8_SB(0, 0), cB); PG8_STAGE(PG8_SA(0, 0), cA); PG8_STAGE(PG8_SB(0, 1), cB + hstep); PG8_STAGE(PG8_SA(0, 1), cA + hstep);
    if (wr == 1) PG8_BAR;
    PG8_WAIT_V(4); PG8_BAR;
    PG8_STAGE(PG8_SB(1, 0), cB + kstep); PG8_STAGE(PG8_SA(1, 0), cA + kstep); PG8_STAGE(PG8_SB(1, 1), cB + hstep + kstep);
    PG8_WAIT_V(6); PG8_BAR;
    for (;;) {
        const bool has_next = S.next(ui + 1, nxt);
        const char* nA = has_next ? nxt.a : cA; const char* nB = has_next ? nxt.b : cB;
        const int cnt = cur.nt;
        for (int t = 0; t < cnt; t += 2) {
            const bool last = (t == cnt - 2);
            const char* a1 = cA + (size_t)(t + 1) * kstep;
            const char* a2 = last ? nA : cA + (size_t)(t + 2) * kstep; const char* b2 = last ? nB : cB + (size_t)(t + 2) * kstep;
            const char* a3 = a2 + kstep; const char* b3 = b2 + kstep;
            PG8_LDB(B0, 0, 0); PG8_SCHED; PG8_LDA(At, 0, 0); PG8_STAGE(PG8_SA(1, 1), a1 + hstep);
            PG8_WAIT_L(8); PG8_BAR; PG8_WAIT_L(0); PG8_MMA(0, 0, At, B0); PG8_BAR; PG8_SCHED;
            PG8_LDB(B1, 0, 1); PG8_STAGE(PG8_SB(0, 0), b2);
            PG8_BAR; PG8_WAIT_L(0); PG8_MMA(0, 1, At, B1); PG8_BAR;
            PG8_LDA(At, 0, 1); PG8_STAGE(PG8_SA(0, 0), a2);
            PG8_BAR; PG8_WAIT_L(0); PG8_MMA(1, 0, At, B0); PG8_BAR; PG8_SCHED;
            PG8_STAGE(PG8_SB(0, 1), b2 + hstep);
            PG8_WAIT_V(6); PG8_BAR; PG8_MMA(1, 1, At, B1); PG8_BAR;
            PG8_LDB(B0, 1, 0); PG8_SCHED; PG8_LDA(At, 1, 0); PG8_STAGE(PG8_SA(0, 1), a2 + hstep);
            PG8_WAIT_L(8); PG8_BAR; PG8_WAIT_L(0); PG8_MMA(0, 0, At, B0); PG8_BAR; PG8_SCHED;
            PG8_LDB(B1, 1, 1); PG8_STAGE(PG8_SB(1, 0), b3);
            PG8_BAR; PG8_WAIT_L(0); PG8_MMA(0, 1, At, B1); PG8_BAR;
            PG8_LDA(At, 1, 1); PG8_STAGE(PG8_SA(1, 0), a3);
            PG8_BAR; PG8_WAIT_L(0); PG8_MMA(1, 0, At, B0); PG8_BAR; PG8_SCHED;
            PG8_STAGE(PG8_SB(1, 1), b3 + hstep);
            PG8_WAIT_V(6); PG8_BAR; PG8_MMA(1, 1, At, B1); PG8_BAR;
        }
        E(acc, cur, wr, wc, fr, fq);
        if (!has_next) break;
#pragma unroll
        for (int a = 0; a < 2; ++a)
#pragma unroll
            for (int b = 0; b < 2; ++b)
#pragma unroll
                for (int m = 0; m < 4; ++m)
#pragma unroll
                    for (int n = 0; n < 2; ++n) acc[a][b][m][n] = (f32x4){0.f, 0.f, 0.f, 0.f};
        cur = nxt; cA = nA; cB = nB; ++ui;
    }
    PG8_WAIT_V(0);
    if (wr == 0) PG8_BAR;
    PG8_BAR;
#undef PG8_SA
#undef PG8_SB
#undef PG8_STAGE
#undef PG8_LDA
#undef PG8_LDB
#undef PG8_MMA
#undef PG8_WAIT_V
#undef PG8_WAIT_L
#undef PG8_BAR
#undef PG8_SCHED
}

__device__ __forceinline__ void mod_item(LAS unsigned char* lds, int item) {
    const KArgP pp = kargs(); const float* p_c = pp->c; const float* p_cctx = pp->c_ctx; const float* p_wmod = pp->w_mod; const float* p_bmod = pp->b_mod; unsigned char* p_ws = pp->ws;
    const int tid = fresh_tid(), lane = tid & 63, wave = tid >> 6;
    const int l = item / 72, n0 = (item % 72) * 128;
    LAS float* sil = (LAS float*)lds;
    __syncthreads();
    for (int idx = tid; idx < 17 * 1024; idx += 512) {
        const int r = idx >> 10, k = idx & 1023;
        const float v = (r < 16) ? p_c[r * 1024 + k] : p_cctx[k];
        sil[k * 20 + r] = v / (1.0f + __expf(-v));
    }
    __syncthreads();
    const int cgp = tid & 31, ksl = tid >> 5;
    f32x4 acc[17];
#pragma unroll
    for (int r = 0; r < 17; ++r) acc[r] = (f32x4){0.f, 0.f, 0.f, 0.f};
    const float* wp = p_wmod + ((size_t)l * 1024 + (size_t)ksl * 64) * NMODC + n0 + 4 * cgp;
#pragma unroll 4
    for (int kk = 0; kk < 64; ++kk) {
        const f32x4 w = *(const f32x4*)(wp + (size_t)kk * NMODC);
        const LAS float* sp = sil + (ksl * 64 + kk) * 20;
        const f32x4 s0 = *(const LAS f32x4*)(sp), s1 = *(const LAS f32x4*)(sp + 4), s2 = *(const LAS f32x4*)(sp + 8), s3 = *(const LAS f32x4*)(sp + 12);
        const float s16 = sp[16];
#pragma unroll
        for (int j = 0; j < 4; ++j) { acc[j] += w * s0[j]; acc[4 + j] += w * s1[j]; acc[8 + j] += w * s2[j]; acc[12 + j] += w * s3[j]; }
        acc[16] += w * s16;
    }
#pragma unroll
    for (int r = 0; r < 17; ++r)
#pragma unroll
        for (int j = 0; j < 4; ++j) acc[r][j] += shx(acc[r][j], 32, lane);
    __syncthreads();
    LAS float* red = (LAS float*)lds;
    if (lane < 32) {
#pragma unroll
        for (int r = 0; r < 17; ++r) *(LAS f32x4*)(red + (wave * 17 + r) * 128 + 4 * cgp) = acc[r];
    }
    __syncthreads();
    float* modp = (float*)(p_ws + OFF_MOD);
    for (int o = tid; o < 17 * 128; o += 512) {
        const int r = o >> 7, cc = o & 127;
        float s = p_bmod[l * NMODC + n0 + cc];
#pragma unroll
        for (int w = 0; w < 8; ++w) s += red[(w * 17 + r) * 128 + cc];
        modp[((size_t)l * 17 + r) * NMODC + n0 + cc] = s;
    }
    __syncthreads();
}

__device__ __forceinline__ void conv_tile(LAS unsigned char* lds, int idx) {
    const KArgP p = kargs();
    const int tid = fresh_tid();
    const float* src; bf16_t* dst; int Nsrc, K, ntile, kg, type, l;
    if (idx < 2816) { const int mat = idx / 352, rem = idx % 352; ntile = rem >> 2; kg = rem & 3; l = mat >> 1; type = 0;
        src = ((mat & 1) ? p->w_gu2 : p->w_gu1) + (size_t)l * D * NGU; Nsrc = NGU; K = D; dst = (bf16_t*)(p->ws + OFF_WGU) + (size_t)mat * NGU * D; }
    else if (idx < 2816 + 1408) { const int i2 = idx - 2816; const int mat = i2 / 176, rem = i2 % 176; ntile = rem / 11; kg = rem % 11; l = mat >> 1; type = 1;
        src = ((mat & 1) ? p->w_dn2 : p->w_dn1) + (size_t)l * DFF * D; Nsrc = D; K = DFF; dst = (bf16_t*)(p->ws + OFF_WDN) + (size_t)mat * D * DFF; }
    else if (idx < 2816 + 1408 + 640) { const int i2 = idx - 4224; l = i2 / 160; const int rem = i2 % 160; ntile = rem >> 2; kg = rem & 3; type = 2;
        src = p->w_in + (size_t)l * D * INC; Nsrc = INC; K = D; dst = (bf16_t*)(p->ws + OFF_WIN) + (size_t)l * INC * D; }
    else { const int i2 = idx - 4864; l = i2 >> 6; const int rem = i2 & 63; ntile = rem >> 2; kg = rem & 3; type = 3;
        src = p->w_out + (size_t)l * D * D; Nsrc = D; K = D; dst = (bf16_t*)(p->ws + OFF_WOUT) + (size_t)l * D * D; }
    const int n0 = ntile * 64, k0 = kg * 256;
    LAS float* tile = (LAS float*)lds;
    const int c4 = tid & 15, kk = tid >> 4;
    const int np = n0 + 4 * c4;
    int fcol;
    if (type == 0) { const int s = np & 255; fcol = (s >> 7) * DFF + 128 * (np >> 8) + 32 * ((s >> 5) & 3) + 8 * ((s >> 2) & 3) + 4 * ((s >> 4) & 1); }
    else if (type == 2) {
        if (np < 2048) { const int t8 = np >> 8, s = np & 255, R = s & 127; const int colbase = (t8 < 4) ? t8 * 256 : 1536 + (t8 - 4) * 256; fcol = colbase + 64 * (R >> 5) + 32 * (s >> 7) + (R & 31); }
        else fcol = 1024 + (np - 2048);
    } else fcol = np;
    __syncthreads();
    if (type == 3 && k0 >= 768) {
#pragma unroll 1
        for (int g = 0; g < 4; ++g)
#pragma unroll
            for (int hlf = 0; hlf < 2; ++hlf) {
                const int k = kk + 32 * hlf;
                const float* pw = p->pool_w + ((size_t)(l * 4 + g) * 64 + k) * 64;
                const float* sc = p->pool_scale + l * 256 + g * 64;
                const float* ws = src + (size_t)(768 + g * 64) * D + fcol;
                f32x4 v = (f32x4){0.f, 0.f, 0.f, 0.f};
                for (int d = 0; d < 64; ++d) v += *(const f32x4*)(ws + (size_t)d * D) * (pw[d] * sc[d]);
                LAS float* tp = tile + g * 4160 + k * 65 + 4 * c4;
                tp[0] = v[0]; tp[1] = v[1]; tp[2] = v[2]; tp[3] = v[3];
            }
    } else {
        f32x4 v[8];
#pragma unroll
        for (int q = 0; q < 8; ++q) v[q] = *(const f32x4*)(src + (size_t)(k0 + kk + 32 * q) * Nsrc + fcol);
#pragma unroll
        for (int q = 0; q < 8; ++q) {
            LAS float* tp = tile + (q >> 1) * 4160 + (kk + 32 * (q & 1)) * 65 + 4 * c4;
            tp[0] = v[q][0]; tp[1] = v[q][1]; tp[2] = v[q][2]; tp[3] = v[q][3];
        }
    }
    __syncthreads();
    const int n = tid >> 3, kseg = (tid & 7) * 8;
#pragma unroll
    for (int g = 0; g < 4; ++g) {
        float f[8];
#pragma unroll
        for (int i = 0; i < 8; ++i) f[i] = tile[g * 4160 + (kseg + i) * 65 + n];
        u32x4 w; w.x = cvt_pk_bf16(f[0], f[1]); w.y = cvt_pk_bf16(f[2], f[3]); w.z = cvt_pk_bf16(f[4], f[5]); w.w = cvt_pk_bf16(f[6], f[7]);
        *(u32x4*)(dst + (size_t)(n0 + n) * K + k0 + g * 64 + kseg) = w;
    }
}

__device__ __forceinline__ void rope_item() {
    float* cosT = (float*)(kargs()->ws + OFF_ROPE); float* sinT = cosT + 1024;
    for (int idx = threadIdx.x; idx < 1024; idx += 512) {
        const int pos = idx >> 4, f = idx & 15, fm = f & 3, fqd = f >> 2;
        double inv = (fm == 0) ? 1.0 : (fm == 1) ? 0.5623413251903491 : (fm == 2) ? 0.31622776601683794 : 0.1778279410038923;
        inv *= (fqd == 0) ? 1.0 : (fqd == 1) ? 0.1 : (fqd == 2) ? 0.01 : 0.001;
        const double a = (double)((float)pos * (float)inv);
        const double twopi = 6.283185307179586476925;
        const double nrev = __builtin_rint(a / twopi);
        const double x = a - nrev * twopi, x2 = x * x;
        double sn = 0.0, cs = 0.0, ts = x, tc = 1.0;
#pragma unroll 1
        for (int i = 0; i < 16; ++i) { cs += tc; sn += ts; tc = -tc * x2 / (double)((2 * i + 1) * (2 * i + 2)); ts = -ts * x2 / (double)((2 * i + 2) * (2 * i + 3)); }
        cosT[idx] = (float)cs; sinT[idx] = (float)sn;
    }
}

template <int NR>
__device__ __forceinline__ void prep_rows(const float* xp, float* dp, const bf16_t* y0, const bf16_t* yc, bf16_t* ap, int n, const f32x4 (&nwv)[4], const f32x4 (&sc)[4], const f32x4 (&sh)[4], int lane) {
    for (int i0 = 0; i0 < n; i0 += NR) {
        f32x4 x[NR][4];
#pragma unroll
        for (int k = 0; k < NR; ++k)
#pragma unroll
            for (int q = 0; q < 4; ++q) x[k][q] = *(const f32x4*)(xp + (size_t)(i0 + k) * D + 4 * lane + 256 * q);
        if (y0) {
#pragma unroll
            for (int k = 0; k < NR; ++k)
#pragma unroll
                for (int q = 0; q < 4; ++q) { const u32x2 w = *(const u32x2*)(y0 + (size_t)(i0 + k) * D + 4 * lane + 256 * q); x[k][q] += (f32x4){bf_lo(w.x), bf_hi(w.x), bf_lo(w.y), bf_hi(w.y)}; }
        }
        if (yc) {
#pragma unroll
            for (int sp = 0; sp < 3; ++sp)
#pragma unroll
                for (int k = 0; k < NR; ++k)
#pragma unroll
                    for (int q = 0; q < 4; ++q) { const u32x2 w = *(const u32x2*)(yc + (size_t)sp * NCTX * D + (size_t)(i0 + k) * D + 4 * lane + 256 * q); x[k][q] += (f32x4){bf_lo(w.x), bf_hi(w.x), bf_lo(w.y), bf_hi(w.y)}; }
        }
        float ss[NR];
#pragma unroll
        for (int k = 0; k < NR; ++k) {
            ss[k] = 0.f;
#pragma unroll
            for (int q = 0; q < 4; ++q) ss[k] += x[k][q][0] * x[k][q][0] + x[k][q][1] * x[k][q][1] + x[k][q][2] * x[k][q][2] + x[k][q][3] * x[k][q][3];
        }
        if (dp) {
#pragma unroll
            for (int k = 0; k < NR; ++k)
#pragma unroll
                for (int q = 0; q < 4; ++q) *(f32x4*)(dp + (size_t)(i0 + k) * D + 4 * lane + 256 * q) = x[k][q];
        }
#pragma unroll
        for (int o = 32; o >= 1; o >>= 1)
#pragma unroll
            for (int k = 0; k < NR; ++k) ss[k] += shx(ss[k], o, lane);
#pragma unroll
        for (int k = 0; k < NR; ++k) {
            const float rstd = rsqrtf(ss[k] * (1.0f / 1024.0f) + 1e-6f);
#pragma unroll
            for (int q = 0; q < 4; ++q) {
                const f32x4 y = (x[k][q] * rstd * nwv[q]) * sc[q] + sh[q];
                u32x2 w; w.x = cvt_pk_bf16(y[0], y[1]); w.y = cvt_pk_bf16(y[2], y[3]);
                *(u32x2*)(ap + (size_t)(i0 + k) * D + 4 * lane + 256 * q) = w;
            }
        }
    }
}
__device__ __forceinline__ void prep_phase(const float* src_lat, const float* src_ctx, float* dst_lat, float* dst_ctx, const bf16_t* Y0, const bf16_t* Yc, bool ctx_split,
                                           bf16_t* A, const float* nw, const float* modl, int shift_i, int scale_i, bool with_ctx) {
    const int tid = fresh_tid();
    const int lane = tid & 63, gw = blockIdx.x * 8 + (tid >> 6);
    f32x4 nwv[4], sc[4], sh[4];
#pragma unroll
    for (int q = 0; q < 4; ++q) nwv[q] = *(const f32x4*)(nw + 4 * lane + 256 * q);
    {
        const int row0 = gw * 16, mr = row0 >> 11;
#pragma unroll
        for (int q = 0; q < 4; ++q) {
            sc[q] = *(const f32x4*)(modl + (size_t)mr * NMODC + scale_i * 1024 + 4 * lane + 256 * q) + 1.0f;
            sh[q] = *(const f32x4*)(modl + (size_t)mr * NMODC + shift_i * 1024 + 4 * lane + 256 * q);
        }
        prep_rows<4>(src_lat + (size_t)row0 * D, nullptr, nullptr, nullptr, A + (size_t)row0 * D, 16, nwv, sc, sh, lane);
    }
    if (with_ctx) {
        const int crow0 = gw * 2;
#pragma unroll
        for (int q = 0; q < 4; ++q) {
            sc[q] = *(const f32x4*)(modl + (size_t)16 * NMODC + scale_i * 1024 + 4 * lane + 256 * q) + 1.0f;
            sh[q] = *(const f32x4*)(modl + (size_t)16 * NMODC + shift_i * 1024 + 4 * lane + 256 * q);
        }
        prep_rows<2>(src_ctx + (size_t)crow0 * D, ctx_split ? dst_ctx + (size_t)crow0 * D : nullptr, nullptr, ctx_split ? Yc + (size_t)crow0 * D : nullptr,
                  A + (size_t)(NLAT + crow0) * D, 2, nwv, sc, sh, lane);
    }
}

__device__ __forceinline__ void attn_item(LAS unsigned char* lds, const bf16_t* Q, const bf16_t* KB, const bf16_t* VT, bf16_t* MIX,
                                          int b, int h, int qrow0, int key0, int nkeys, float lam, float negM, const float* subw, float post_scale) {
    const int tid = fresh_tid(), lane = tid & 63, wave = tid >> 6, r = lane & 31, h2 = lane >> 5;
    f32x16 O[2][4];
#pragma unroll
    for (int i = 0; i < 2; ++i)
#pragma unroll
        for (int et = 0; et < 4; ++et)
#pragma unroll
            for (int j = 0; j < 16; ++j) O[i][et][j] = 0.f;
    float ls0 = 0.f, ls1 = 0.f;
    const char* kg = (const char*)(KB + ((size_t)(b * NKEYS + key0)) * 512 + h * 128);
    const char* vg = (const char*)(VT + ((size_t)(b * 512 + h * 128)) * NKEYS + key0);
    const int wu = __builtin_amdgcn_readfirstlane(wave);
    const int nt = nkeys >> 6;
#define ATT_STAGE(t_, bufo_) do { int ln = lane; asm volatile("" : "+v"(ln)); _Pragma("unroll") for (int _i = 0; _i < 2; ++_i) { const int pc = wu + 8 * _i; \
        const int key = pc * 4 + (ln >> 4), c = (ln & 15) ^ (key & 15); const unsigned kgo = (unsigned)(key * 1024 + c * 16); \
        const int e = pc * 8 + (ln >> 3), cv = (ln & 7) ^ ((e >> 1) & 7); const unsigned vgo = (unsigned)(e * (NKEYS * 2) + cv * 16); \
        __builtin_amdgcn_global_load_lds((const unsigned*)(kg + (size_t)(t_) * 65536 + kgo), (LAS unsigned*)(lds + (bufo_) + pc * 1024), 16, 0, 0); \
        __builtin_amdgcn_global_load_lds((const unsigned*)(vg + (size_t)(t_) * 128 + vgo), (LAS unsigned*)(lds + (bufo_) + 16384 + pc * 1024), 16, 0, 0); } } while (0)
    __syncthreads();
    {
        const char* qg = (const char*)(Q + (size_t)qrow0 * 512 + h * 128);
#pragma unroll
        for (int i = 0; i < 8; ++i) {
            const int pq = wu * 8 + i, row = pq * 4 + (lane >> 4), c = (lane & 15) ^ (row & 15);
            __builtin_amdgcn_global_load_lds((const unsigned*)(qg + (size_t)row * 1024 + c * 16), (LAS unsigned*)(lds + 65536 + pq * 1024), 16, 0, 0);
        }
    }
    ATT_STAGE(0, 0);
    asm volatile("s_waitcnt vmcnt(0)" ::: "memory");
    __syncthreads();
    const int rs = (r & 0x13) | ((r & 4) << 1) | ((r & 8) >> 1);
    const int qrow = wave * 32 + r, qx = qrow & 15;
    const int kx = rs & 15;
    const LAS unsigned char* qbase = lds + 65536 + qrow * 256;
#define SB() __builtin_amdgcn_sched_barrier(0)
#define LD_QK(i_, kb_, kf_, qf_) do { _Pragma("unroll") for (int ks = 0; ks < 4; ++ks) { \
        kf_[ks] = *(const LAS bf16x8*)(Kb + ((kb_) * 32 + rs) * 256 + ((((i_) * 8 + ks * 2 + h2) ^ kx) << 4)); \
        qf_[ks] = *(const LAS bf16x8*)(qbase + ((((i_) * 8 + ks * 2 + h2) ^ qx) << 4)); } } while (0)
#define MM_S(Sv_, kf_, qf_) do { _Pragma("unroll") for (int j = 0; j < 16; ++j) Sv_[j] = negM; \
        _Pragma("unroll") for (int ks = 0; ks < 4; ++ks) Sv_ = __builtin_amdgcn_mfma_f32_32x32x16_bf16(kf_[ks], qf_[ks], Sv_, 0, 0, 0); } while (0)
#define EXP_P(Sv_, ls_, pf_) do { float psum = 0.f; _Pragma("unroll") for (int j = 0; j < 16; ++j) { Sv_[j] = __builtin_amdgcn_exp2f(Sv_[j]); psum += Sv_[j]; } ls_ += psum; \
        _Pragma("unroll") for (int sq = 0; sq < 2; ++sq) { u32x4 w; w.x = cvt_pk_bf16(Sv_[8 * sq + 0], Sv_[8 * sq + 1]); w.y = cvt_pk_bf16(Sv_[8 * sq + 2], Sv_[8 * sq + 3]); \
            w.z = cvt_pk_bf16(Sv_[8 * sq + 4], Sv_[8 * sq + 5]); w.w = cvt_pk_bf16(Sv_[8 * sq + 6], Sv_[8 * sq + 7]); pf_[sq] = __builtin_bit_cast(bf16x8, w); } } while (0)
#define LD_V(hf_, kb_, vf_) do { _Pragma("unroll") for (int el = 0; el < 2; ++el) { const int e = ((hf_) * 2 + el) * 32 + r, ex = (e >> 1) & 7; \
        _Pragma("unroll") for (int sq = 0; sq < 2; ++sq) vf_[el][sq] = *(const LAS bf16x8*)(Vb + e * 128 + ((((kb_) * 4 + sq * 2 + h2) ^ ex) << 4)); } } while (0)
#define MM_PV(hf_, vf_) do { _Pragma("unroll") for (int el = 0; el < 2; ++el) _Pragma("unroll") for (int sq = 0; sq < 2; ++sq) { \
        O[0][(hf_) * 2 + el] = __builtin_amdgcn_mfma_f32_32x32x16_bf16(vf_[el][sq], pf0[sq], O[0][(hf_) * 2 + el], 0, 0, 0); \
        O[1][(hf_) * 2 + el] = __builtin_amdgcn_mfma_f32_32x32x16_bf16(vf_[el][sq], pf1[sq], O[1][(hf_) * 2 + el], 0, 0, 0); } } while (0)
    for (int t = 0; t < nt; ++t) {
        const bool more = (t + 1 < nt);
        if (more) ATT_STAGE(t + 1, ((t + 1) & 1) * 32768);
        const LAS unsigned char* Kb = lds + (t & 1) * 32768;
        const LAS unsigned char* Vb = Kb + 16384;
        bf16x8 kfa[4], qfa[4], va[2][2], pf0[2], pf1[2];
        f32x16 S0, S1;
#pragma unroll 1
        for (int kb = 0; kb < 2; ++kb) {
            LD_QK(0, kb, kfa, qfa);
            SB(); MM_S(S0, kfa, qfa);
            SB(); LD_QK(1, kb, kfa, qfa);
            SB(); MM_S(S1, kfa, qfa); EXP_P(S0, ls0, pf0);
            SB(); LD_V(0, kb, va); EXP_P(S1, ls1, pf1);
            SB(); MM_PV(0, va); LD_V(1, kb, va);
            SB(); MM_PV(1, va);
        }
        SB();
        asm volatile("s_waitcnt vmcnt(0)" ::: "memory");
        __syncthreads();
    }
#undef SB
#undef LD_QK
#undef MM_S
#undef EXP_P
#undef LD_V
#undef MM_PV
    const int tid2 = fresh_tid(), lane2 = tid2 & 63, wave2 = tid2 >> 6, r2 = lane2 & 31, h2b = lane2 >> 5;
    ls0 += shx(ls0, 32, lane2); ls1 += shx(ls1, 32, lane2);
    const float inv1 = 1.0f / ls0, inv2 = lam / ls1;
    float ss = 0.f;
#pragma unroll
    for (int et = 0; et < 4; ++et)
#pragma unroll
        for (int j = 0; j < 16; ++j) { const float o = O[0][et][j] * inv1 - O[1][et][j] * inv2; O[0][et][j] = o; ss += o * o; }
    ss += shx(ss, 32, lane2);
    float li_ = post_scale; asm volatile("" : "+s"(li_));
    const float rstd = rsqrtf(ss * (1.0f / 128.0f) + 1e-6f) * (1.0f - li_);
    bf16_t* op = MIX + (size_t)(qrow0 + wave2 * 32 + r2) * 1024 + h * 128 + 4 * h2b;
#pragma unroll
    for (int et = 0; et < 4; ++et)
#pragma unroll
        for (int g4 = 0; g4 < 4; ++g4) {
            const int e0 = 32 * et + 8 * g4;
            const f32x4 w4 = *(const f32x4*)(subw + e0 + 4 * h2b);
            u32x2 w; w.x = cvt_pk_bf16(O[0][et][4 * g4 + 0] * rstd * w4[0], O[0][et][4 * g4 + 1] * rstd * w4[1]);
            w.y = cvt_pk_bf16(O[0][et][4 * g4 + 2] * rstd * w4[2], O[0][et][4 * g4 + 3] * rstd * w4[3]);
            *(u32x2*)(op + e0) = w;
        }
}

__device__ __forceinline__ void ew_rows(const bf16_t* EW, bf16_t* MIX, const float* convw, int row0, int nrows) {
    const int tid = fresh_tid();
    for (int task = tid; task < nrows * 32; task += 512) {
        const int row = row0 + (task >> 5), c0 = (task & 31) * 8;
        int t, L; if (row < NLAT) { t = row & (SEQ - 1); L = SEQ; } else { t = (row - NLAT) & (LCTX - 1); L = LCTX; }
        const bf16_t* er = EW + (size_t)row * 1024;
        u32x4 cc[3], cx[3]; f32x4 wa[3], wb[3];
#pragma unroll
        for (int i = 0; i < 3; ++i) {
            const int dt = i - 1; const bool ok = (t + dt >= 0) && (t + dt < L);
            const bf16_t* rp = er + (ok ? dt : 0) * 1024;
            cc[i] = *(const u32x4*)(rp + 256 + c0); cx[i] = *(const u32x4*)(rp + 512 + c0);
            const float m = ok ? 1.0f : 0.0f;
            wa[i] = *(const f32x4*)(convw + i * 256 + c0) * m; wb[i] = *(const f32x4*)(convw + i * 256 + c0 + 4) * m;
        }
        const u32x4 cb = *(const u32x4*)(er + c0);
        float accv[8];
#pragma unroll
        for (int j = 0; j < 8; ++j) accv[j] = 0.f;
#pragma unroll
        for (int i = 0; i < 3; ++i) {
            accv[0] += bf_lo(cc[i].x) * bf_lo(cx[i].x) * wa[i][0]; accv[1] += bf_hi(cc[i].x) * bf_hi(cx[i].x) * wa[i][1];
            accv[2] += bf_lo(cc[i].y) * bf_lo(cx[i].y) * wa[i][2]; accv[3] += bf_hi(cc[i].y) * bf_hi(cx[i].y) * wa[i][3];
            accv[4] += bf_lo(cc[i].z) * bf_lo(cx[i].z) * wb[i][0]; accv[5] += bf_hi(cc[i].z) * bf_hi(cx[i].z) * wb[i][1];
            accv[6] += bf_lo(cc[i].w) * bf_lo(cx[i].w) * wb[i][2]; accv[7] += bf_hi(cc[i].w) * bf_hi(cx[i].w) * wb[i][3];
        }
        u32x4 w;
        w.x = cvt_pk_bf16(bf_lo(cb.x) * accv[0], bf_hi(cb.x) * accv[1]); w.y = cvt_pk_bf16(bf_lo(cb.y) * accv[2], bf_hi(cb.y) * accv[3]);
        w.z = cvt_pk_bf16(bf_lo(cb.z) * accv[4], bf_hi(cb.z) * accv[5]); w.w = cvt_pk_bf16(bf_lo(cb.w) * accv[6], bf_hi(cb.w) * accv[7]);
        *(u32x4*)(MIX + (size_t)row * 1024 + 512 + c0) = w;
    }
    for (int task = tid; task < nrows * 32; task += 512) {
        const int row = row0 + (task >> 5), ps = task & 31, c0 = ps * 8, half = 1 << (ps >> 3);
        int t, L; if (row < NLAT) { t = row & (SEQ - 1); L = SEQ; } else { t = (row - NLAT) & (LCTX - 1); L = LCTX; }
        const bf16_t* er = EW + (size_t)row * 1024 + 768 + c0;
        const int lo = (t - half > 0) ? t - half : 0, hi = (t + half < L) ? t + half : L;
        u32x4 v[16];
#pragma unroll
        for (int i = 0; i < 16; ++i) { const int tt = t + i - 8; const bool ok = (tt >= lo) && (tt < hi); v[i] = *(const u32x4*)(er + (ok ? (i - 8) : 0) * 1024); if (!ok) v[i] = (u32x4){0u, 0u, 0u, 0u}; }
        const u32x4 sv = *(const u32x4*)(er);
        float sm[8];
#pragma unroll
        for (int j = 0; j < 8; ++j) sm[j] = 0.f;
#pragma unroll
        for (int i = 0; i < 16; ++i) {
            sm[0] += bf_lo(v[i].x); sm[1] += bf_hi(v[i].x); sm[2] += bf_lo(v[i].y); sm[3] += bf_hi(v[i].y);
            sm[4] += bf_lo(v[i].z); sm[5] += bf_hi(v[i].z); sm[6] += bf_lo(v[i].w); sm[7] += bf_hi(v[i].w);
        }
        const float ic = 1.0f / (float)(hi - lo);
        u32x4 w;
        w.x = cvt_pk_bf16(sm[0] * ic - bf_lo(sv.x), sm[1] * ic - bf_hi(sv.x)); w.y = cvt_pk_bf16(sm[2] * ic - bf_lo(sv.y), sm[3] * ic - bf_hi(sv.y));
        w.z = cvt_pk_bf16(sm[4] * ic - bf_lo(sv.z), sm[5] * ic - bf_hi(sv.z)); w.w = cvt_pk_bf16(sm[6] * ic - bf_lo(sv.w), sm[7] * ic - bf_hi(sv.w));
        *(u32x4*)(MIX + (size_t)row * 1024 + 768 + c0) = w;
    }
}


#define XB_TMO      128
#define XB_XCNT(j)  (256  + 64 * (j))
#define XB_XSUB(j)  (1280 + 64 * (j))
#define XB_XGEN(j)  (2304 + 64 * (j))
#define XB_TOP      3328
#define XB_TOPGEN   3392
#define XCD_BAR_WORDS 3456
#define XB_SPIN_CAP (1u << 22)
__device__ __forceinline__ unsigned xb_ld(unsigned* p)              { return __hip_atomic_load(p, __ATOMIC_RELAXED, __HIP_MEMORY_SCOPE_AGENT); }
__device__ __forceinline__ unsigned xb_add(unsigned* p, unsigned v) { return __hip_atomic_fetch_add(p, v, __ATOMIC_RELAXED, __HIP_MEMORY_SCOPE_AGENT); }
__device__ __forceinline__ unsigned xb_xcc_id() { return (unsigned)__builtin_amdgcn_s_getreg((3 << 11) | 20) & 0xFu; }
#define XB_SPIN(cond, bar) do { unsigned _sp = 0; while (cond) { __builtin_amdgcn_s_sleep(1); \
    if ((++_sp & 255u) == 0u) { if (xb_ld(&(bar)[XB_TMO])) break; if (_sp > XB_SPIN_CAP) { atomicAdd(&(bar)[XB_TMO], 1u); break; } } } } while (0)
struct XcdBarrier { unsigned* bar; unsigned x; volatile LAS unsigned* st; };
__device__ __forceinline__ XcdBarrier xcd_barrier_post(unsigned* bar, volatile LAS unsigned* st) {
    XcdBarrier b; b.bar = bar; b.x = xb_xcc_id(); b.st = st;
    if (threadIdx.x == 0) (void)xb_add(&bar[XB_XCNT(b.x)], 1u);
    return b;
}
__device__ __forceinline__ void xcd_barrier_complete(unsigned* bar, unsigned x, unsigned& nloc, unsigned& nx) {
    const unsigned G = gridDim.x * gridDim.y * gridDim.z;
    unsigned sum, cnt, mine, sp = 0u;
    for (;;) {
        sum = 0u; cnt = 0u; mine = 0u;
#pragma unroll
        for (unsigned j = 0; j < 16; ++j) { const unsigned c = xb_ld(&bar[XB_XCNT(j)]); sum += c; cnt += (c > 0u) ? 1u : 0u; mine = (j == x) ? c : mine; }
        if (sum == G) break;
        __builtin_amdgcn_s_sleep(1);
        if ((++sp & 255u) == 0u) { if (xb_ld(&bar[XB_TMO])) break; if (sp > XB_SPIN_CAP) { atomicAdd(&bar[XB_TMO], 1u); break; } }
    }
    nloc = mine > 0u ? mine : 1u; nx = cnt > 0u ? cnt : 1u;
}
__device__ __forceinline__ void xcd_barrier(const XcdBarrier& b) {
    asm volatile("s_waitcnt vmcnt(0)" ::: "memory");
    __syncthreads();
    if (threadIdx.x == 0) {
        unsigned* bar = b.bar;
        __builtin_amdgcn_s_waitcnt(0);
        unsigned nloc = b.st[0], nx = b.st[1];
        if (nloc == 0u) { xcd_barrier_complete(bar, b.x, nloc, nx); b.st[0] = nloc; b.st[1] = nx; }
        const unsigned old = xb_add(&bar[XB_XSUB(b.x)], 1u);
        const unsigned gen = old / nloc;
        if (old + 1u == (gen + 1u) * nloc) {
            __builtin_amdgcn_fence(__ATOMIC_RELEASE, "agent");
            asm volatile("s_waitcnt vmcnt(0)" ::: "memory");
            const unsigned og = xb_add(&bar[XB_TOP], 1u);
            const unsigned tg = og / nx;
            if (og + 1u == (tg + 1u) * nx) xb_add(&bar[XB_TOPGEN], 1u);
            else XB_SPIN(xb_ld(&bar[XB_TOPGEN]) == tg, bar);
            __builtin_amdgcn_fence(__ATOMIC_ACQUIRE, "agent");
            xb_add(&bar[XB_XGEN(b.x)], 1u);
            asm volatile("s_waitcnt vmcnt(0)" ::: "memory");
        } else {
            XB_SPIN(xb_ld(&bar[XB_XGEN(b.x)]) == gen, bar);
            __builtin_amdgcn_fence(__ATOMIC_ACQUIRE, "agent");
            asm volatile("s_waitcnt vmcnt(0)" ::: "memory");
        }
    }
    __syncthreads();
}

__global__ void __launch_bounds__(512, 2) hymba_mega(Params p_unused) {
    extern __shared__ __attribute__((aligned(16))) unsigned char lds_raw[];
    LAS unsigned char* lds = (LAS unsigned char*)lds_raw;
    cg::grid_group grid = cg::this_grid();
    const int G = gridDim.x, bid = blockIdx.x;
#define WSP(T, off) ((T*)(q->ws + (off)))
    volatile LAS unsigned* xst = (volatile LAS unsigned*)(lds + 131072 + 8192);
    if (threadIdx.x < 4) xst[threadIdx.x] = 0u;
    __syncthreads();
    const XcdBarrier xbar = xcd_barrier_post((unsigned*)(kargs()->ws + OFF_BAR), xst);

    for (int rep = 0; rep < REP_P0; ++rep)
    for (int item = bid; item < 288 + 5120 + 1; item += G) {
        if (item < 288) mod_item(lds, item);
        else if (item < 288 + 5120) conv_tile(lds, item - 288);
        else rope_item();
    }
    grid.sync();

#pragma unroll 1
    for (int l = 0; l < DEPTH; ++l) {
        const bool lastl = (l == DEPTH - 1);
        { const KArgP q = kargs();
          if (l == 0) prep_phase(q->x, q->ctx, nullptr, nullptr, nullptr, nullptr, false, WSP(bf16_t, OFF_A), q->norm_w, WSP(float, OFF_MOD), 0, 1, true);
          else prep_phase(q->out, WSP(float, OFF_HC), nullptr, WSP(float, OFF_HC), nullptr, WSP(bf16_t, OFF_YC), true, WSP(bf16_t, OFF_A), q->norm_w + (l * 3 + 0) * D, WSP(float, OFF_MOD) + (size_t)l * 17 * NMODC, 0, 1, true); }
        GRID_SYNC();
        { const KArgP q = kargs();
          Sched1 S{144, 22, G, bid, (const char*)WSP(bf16_t, OFF_A), (const char*)(WSP(bf16_t, OFF_WGU) + (size_t)(l * 2 + 0) * NGU * D), (size_t)256 * D * 2, 16}; EpiSwiGLU E{WSP(bf16_t, OFF_HID)};
          gemm_phase(lds, D, S, E, stagger_ticks(S.nM * 22, bid, 16)); }
        GRID_SYNC();
        { const KArgP q = kargs();
          SchedR S{bid, true, (const char*)WSP(bf16_t, OFF_HID), (const char*)(WSP(bf16_t, OFF_WDN) + (size_t)(l * 2 + 0) * D * DFF), (size_t)256 * DFF * 2, 44};
          EpiResid E{(l == 0) ? q->x : q->out, (l == 0) ? q->ctx : WSP(float, OFF_HC), q->out, WSP(float, OFF_HC), WSP(float, OFF_MOD) + (size_t)l * 17 * NMODC + 2 * D, 0.5f, WSP(bf16_t, OFF_YC)};
          gemm_phase(lds, DFF, S, E, 0); }
        GRID_SYNC();
        { const KArgP q = kargs();
          prep_phase(q->out, WSP(float, OFF_HC), nullptr, WSP(float, OFF_HC), nullptr, WSP(bf16_t, OFF_YC), true,
                     WSP(bf16_t, OFF_A), q->norm_w + (l * 3 + 1) * D, WSP(float, OFF_MOD) + (size_t)l * 17 * NMODC, 3, 4, true); }
        GRID_SYNC();
        { const KArgP q = kargs();
          SchedIn S{G, bid, (const char*)WSP(bf16_t, OFF_A), (const char*)(WSP(bf16_t, OFF_WIN) + (size_t)l * INC * D), (size_t)256 * D * 2};
          { const int t = fresh_tid(); *(LAS f32x4*)(lds + 131072 + t * 16) = *(const f32x4*)(WSP(float, OFF_ROPE) + t * 4); __syncthreads(); }
          EpiIn E{WSP(bf16_t, OFF_Q), WSP(bf16_t, OFF_KB), WSP(bf16_t, OFF_VT), WSP(bf16_t, OFF_EW), q->q_norm_w + l * 64, q->k_norm_w + l * 64, (const LAS float*)(lds + 131072)};
          gemm_phase(lds, D, S, E, stagger_ticks(1440, bid, 16)); }
        GRID_SYNC();
        {
            const KArgP q = kargs();
            const float lam_init = 0.8f - 0.6f * __expf(-0.3f * (float)l);
            const float* lq = q->lambda_qk + l * 256; const int lane = fresh_tid() & 63;
            const float sa = wave_sum(lq[lane] * lq[64 + lane], lane), sb = wave_sum(lq[128 + lane] * lq[192 + lane], lane);
            const float lam = uniformf(__expf(sa) - __expf(sb) + lam_init);
            const float mq = wave_max(fabsf(q->q_norm_w[l * 64 + lane]), lane), mk = wave_max(fabsf(q->k_norm_w[l * 64 + lane]), lane);
            const float negM = uniformf(-(8.0f * LOG2E * mq * mk));
            const float post_scale = uniformf(lam_init);
            const int n_ctx = lastl ? 0 : 64;
            const int n_items = 512 + n_ctx;
            for (int rep = 0; rep < REP_MIX; ++rep)
            for (int item = bid; item < n_items; item += G) {
                if (item < 512 + n_ctx) {
                    int b, h, qrow0, key0, nkeys;
                    if (item < 512) { const int u = ((item & 7) << 6) + ((item >> 8) << 5) + ((item & 255) >> 3);
                        b = u >> 5; h = (u >> 3) & 3; qrow0 = b * SEQ + (u & 7) * 256; key0 = 0; nkeys = NKEYS; }
                    else { const int it = item - 512; b = it >> 2; h = it & 3; qrow0 = NLAT + b * LCTX; key0 = SEQ; nkeys = LCTX; }
                    attn_item(lds, WSP(bf16_t, OFF_Q), WSP(bf16_t, OFF_KB), WSP(bf16_t, OFF_VT), WSP(bf16_t, OFF_A), b, h, qrow0, key0, nkeys, lam, negM, q->subln_w + l * 128, post_scale);
                }
            }
            if (lastl) ew_rows(WSP(bf16_t, OFF_EW), WSP(bf16_t, OFF_A), q->conv_w + l * 768, bid * (NLAT / 256), NLAT / 256);
            else if (bid >= 64) ew_rows(WSP(bf16_t, OFF_EW), WSP(bf16_t, OFF_A), q->conv_w + l * 768, (bid - 64) * 192, 192);
        }
        GRID_SYNC();
        const int nMr = lastl ? 128 : 144;
        { const KArgP q = kargs();
          SchedR S{bid, !lastl, (const char*)WSP(bf16_t, OFF_A), (const char*)(WSP(bf16_t, OFF_WOUT) + (size_t)l * D * D), (size_t)256 * D * 2, 16};
          EpiResid E{q->out, WSP(float, OFF_HC), q->out, WSP(float, OFF_HC), WSP(float, OFF_MOD) + (size_t)l * 17 * NMODC + 5 * D, 1.0f, WSP(bf16_t, OFF_YC)};
          gemm_phase(lds, D, S, E, 0); }
        GRID_SYNC();
        { const KArgP q = kargs();
          prep_phase(q->out, WSP(float, OFF_HC), nullptr, WSP(float, OFF_HC), nullptr, WSP(bf16_t, OFF_YC), !lastl,
                     WSP(bf16_t, OFF_A), q->norm_w + (l * 3 + 2) * D, WSP(float, OFF_MOD) + (size_t)l * 17 * NMODC, 6, 7, !lastl); }
        GRID_SYNC();
        { const KArgP q = kargs();
          Sched1 S{nMr, 22, G, bid, (const char*)WSP(bf16_t, OFF_A), (const char*)(WSP(bf16_t, OFF_WGU) + (size_t)(l * 2 + 1) * NGU * D), (size_t)256 * D * 2, 16}; EpiSwiGLU E{WSP(bf16_t, OFF_HID)};
          gemm_phase(lds, D, S, E, stagger_ticks(S.nM * 22, bid, 16)); }
        GRID_SYNC();
        if (!lastl) {
          const KArgP q = kargs();
          SchedR S{bid, true, (const char*)WSP(bf16_t, OFF_HID), (const char*)(WSP(bf16_t, OFF_WDN) + (size_t)(l * 2 + 1) * D * DFF), (size_t)256 * DFF * 2, 44};
          EpiResid E{q->out, WSP(float, OFF_HC), q->out, WSP(float, OFF_HC), WSP(float, OFF_MOD) + (size_t)l * 17 * NMODC + 8 * D, 0.5f, WSP(bf16_t, OFF_YC)};
          gemm_phase(lds, DFF, S, E, 0);
          GRID_SYNC();
        } else {
          const KArgP q = kargs();
          Sched1 S{128, 4, G, bid, (const char*)WSP(bf16_t, OFF_HID), (const char*)(WSP(bf16_t, OFF_WDN) + (size_t)(l * 2 + 1) * D * DFF), (size_t)256 * DFF * 2, 44};
          EpiResid E{q->out, WSP(float, OFF_HC), q->out, WSP(float, OFF_HC), WSP(float, OFF_MOD) + (size_t)l * 17 * NMODC + 8 * D, 0.5f, nullptr};
          gemm_phase(lds, DFF, S, E, 0);
        }
    }
#undef WSP
}

extern "C" void kernel_launch(void* const* d_in, const int* in_sizes, int n_in, void* d_out, int out_size, void* d_ws, size_t ws_size, hipStream_t stream) {
    static int grid_blocks = 0;
    if (!grid_blocks) {
        int dev = 0, cus = 0, per_cu = 0;
        hipGetDevice(&dev);
        hipDeviceGetAttribute(&cus, hipDeviceAttributeMultiprocessorCount, dev);
        hipFuncSetAttribute((const void*)hymba_mega, hipFuncAttributeMaxDynamicSharedMemorySize, LDS_BYTES);
        hipOccupancyMaxActiveBlocksPerMultiprocessor(&per_cu, (const void*)hymba_mega, 512, LDS_BYTES);
        if (per_cu < 1) per_cu = 1;
        if (per_cu > 1) per_cu = 1;
        grid_blocks = 256;
        if (ws_size < WS_END) fprintf(stderr, "kernel_launch: workspace too small: %zu < %zu\n", ws_size, (size_t)WS_END);
    }
    Params p{};
    p.x = (const float*)d_in[0]; p.c = (const float*)d_in[1]; p.ctx = (const float*)d_in[2]; p.c_ctx = (const float*)d_in[3];
    p.norm_w = (const float*)d_in[4]; p.w_mod = (const float*)d_in[5]; p.b_mod = (const float*)d_in[6];
    p.w_gu1 = (const float*)d_in[7]; p.w_dn1 = (const float*)d_in[8]; p.w_gu2 = (const float*)d_in[9]; p.w_dn2 = (const float*)d_in[10];
    p.w_in = (const float*)d_in[11]; p.w_out = (const float*)d_in[12]; p.q_norm_w = (const float*)d_in[13]; p.k_norm_w = (const float*)d_in[14];
    p.lambda_qk = (const float*)d_in[15]; p.subln_w = (const float*)d_in[16]; p.conv_w = (const float*)d_in[17]; p.pool_w = (const float*)d_in[18]; p.pool_scale = (const float*)d_in[19];
    p.out = (float*)d_out; p.ws = (unsigned char*)d_ws;
    (void)hipMemsetAsync((unsigned char*)d_ws + OFF_BAR, 0, 16384, stream);
    void* args[] = {&p};
    hipError_t e = hipLaunchCooperativeKernel((const void*)hymba_mega, dim3(grid_blocks), dim3(512), args, LDS_BYTES, stream);
    if (e != hipSuccess) fprintf(stderr, "cooperative launch failed: %s (grid %d)\n", hipGetErrorString(e), grid_blocks);
}
```

```cpp
#include <hip/hip_runtime.h>
#include <hip/hip_cooperative_groups.h>
#include <cstdio>
namespace cg = cooperative_groups;

#define LAS __attribute__((address_space(3)))
typedef unsigned short bf16_t;
typedef short bf16x8 __attribute__((ext_vector_type(8)));
typedef float f32x4 __attribute__((ext_vector_type(4)));
typedef float f32x16 __attribute__((ext_vector_type(16)));
typedef unsigned u32x4 __attribute__((ext_vector_type(4)));
typedef unsigned u32x2 __attribute__((ext_vector_type(2)));

constexpr int D = 1024, NB = 16, SEQ = 2048, LCTX = 256, NLAT = NB * SEQ, NCTX = NB * LCTX, NROWS = NLAT + NCTX;
constexpr int DFF = 2816, NGU = 2 * DFF, INC = 2560, NKEYS = SEQ + LCTX, DEPTH = 4, NMODC = 9 * D;
constexpr int LDS_BYTES = 131072 + 8192 + 16;
constexpr float LOG2E = 1.4426950408889634f;
#ifndef REP_SYNC
#define REP_SYNC 1
#endif
#ifndef REP_PREP
#define REP_PREP 1
#endif
#ifndef REP_MIX
#define REP_MIX 1
#endif
#ifndef REP_P0
#define REP_P0 1
#endif
#define GRID_SYNC() do { for (int _r = 0; _r < REP_SYNC; ++_r) xcd_barrier(xbar); } while (0)

constexpr size_t OFF_WGU = 0;
constexpr size_t OFF_WDN = OFF_WGU + (size_t)8 * NGU * D * 2;
constexpr size_t OFF_WIN = OFF_WDN + (size_t)8 * D * DFF * 2;
constexpr size_t OFF_WOUT = OFF_WIN + (size_t)4 * INC * D * 2;
constexpr size_t OFF_MOD = OFF_WOUT + (size_t)4 * D * D * 2;
constexpr size_t OFF_ROPE = OFF_MOD + (size_t)4 * 17 * NMODC * 4;
constexpr size_t OFF_HC = OFF_ROPE + 8192;
constexpr size_t OFF_A = OFF_HC + (size_t)NCTX * D * 4;
constexpr size_t OFF_HID = OFF_A + (size_t)NROWS * D * 2;
constexpr size_t OFF_Q = OFF_HID;
constexpr size_t OFF_KB = OFF_Q + (size_t)NROWS * 512 * 2;
constexpr size_t OFF_VT = OFF_KB + (size_t)NROWS * 512 * 2;
constexpr size_t OFF_EW = OFF_VT + (size_t)NROWS * 512 * 2;
constexpr size_t OFF_Y0 = OFF_HID + (size_t)NROWS * DFF * 2;
constexpr size_t OFF_YC = OFF_Y0;
constexpr size_t OFF_BAR = OFF_YC + (size_t)3 * NCTX * D * 2;
constexpr size_t WS_END = OFF_BAR + 32768;
static_assert(OFF_EW + (size_t)NROWS * 1024 * 2 <= OFF_BAR, "alias region");

struct Params {
    const float *x, *c, *ctx, *c_ctx, *norm_w, *w_mod, *b_mod, *w_gu1, *w_dn1, *w_gu2, *w_dn2, *w_in, *w_out, *q_norm_w, *k_norm_w, *lambda_qk, *subln_w, *conv_w, *pool_w, *pool_scale;
    float* out; unsigned char* ws;
};

typedef const Params __attribute__((address_space(4)))* KArgP;
__device__ __forceinline__ KArgP kargs() { KArgP q = (KArgP)__builtin_amdgcn_kernarg_segment_ptr(); asm volatile("" : "+s"(q)); return q; }
__device__ __forceinline__ unsigned cvt_pk_bf16(float lo, float hi) { unsigned r; asm volatile("v_cvt_pk_bf16_f32 %0, %1, %2" : "=v"(r) : "v"(lo), "v"(hi)); return r; }
__device__ __forceinline__ int fresh_tid() { int t = threadIdx.x; asm volatile("" : "+v"(t)); return t; }
__device__ __forceinline__ float uniformf(float v) { return __int_as_float(__builtin_amdgcn_readfirstlane(__float_as_int(v))); }
__device__ __forceinline__ float bf_lo(unsigned w) { return __uint_as_float(w << 16); }
__device__ __forceinline__ float bf_hi(unsigned w) { return __uint_as_float(w & 0xffff0000u); }
__device__ __forceinline__ float shx(float v, int mask, int lane) { return __int_as_float(__builtin_amdgcn_ds_bpermute((lane ^ mask) << 2, __float_as_int(v))); }
__device__ __forceinline__ float wave_sum(float v, int lane) {
#pragma unroll
    for (int o = 32; o >= 1; o >>= 1) v += shx(v, o, lane);
    return v;
}
__device__ __forceinline__ float wave_max(float v, int lane) {
#pragma unroll
    for (int o = 32; o >= 1; o >>= 1) v = fmaxf(v, shx(v, o, lane));
    return v;
}

constexpr int BM = 256, BK = 64, HALF = 128, HTB = HALF * BK * 2;
__device__ __forceinline__ int lds_byte(int r, int c) { const int st = (r >> 4) * 2 + (c >> 5), rr = r & 15, cc = c & 31, ob = rr * 64 + cc * 2; return st * 1024 + (ob ^ (((ob >> 9) & 1) << 5)); }
__device__ __forceinline__ void stage_rc(int b, int& R, int& C) { const int st = b / 1024, sb = b % 1024, swz = sb ^ (((sb >> 9) & 1) << 5); R = (st >> 1) * 16 + swz / 64; C = (st & 1) * 32 + (swz % 64) / 2; }

struct GUnit { int pm, pn, kind, nt; const char* a; const char* b; };

__device__ __forceinline__ int unit_index(int i, int c_, int U) {
    int c = c_; asm volatile("" : "+s"(c));
    const int x = c & 7, off = c >> 3;
    const int R = (U + 255) >> 8, nx = (U - ((R - 1) << 8)) >> 5;
    const int start = (x < nx) ? x * R * 32 : nx * R * 32 + (x - nx) * (R - 1) * 32;
    const int mine = (x < nx) ? R : R - 1;
    return (i < mine) ? start + i * 32 + off : -1;
}
__device__ __forceinline__ void tile_of(int wgid, int nM, int nN, int& pm, int& pn) {
    const int nig = 8 * nN, gid = wgid / nig, fm = gid * 8, gsz = (nM - fm) < 8 ? (nM - fm) : 8;
    pm = fm + ((wgid % nig) % gsz); pn = (wgid % nig) / gsz;
}
__device__ __forceinline__ int stagger_ticks(int total_units, int c_, int nt) {
    int c = c_; asm volatile("" : "+s"(c));
    const int x = c & 7;
    const int R = (total_units + 255) >> 8, nx = (total_units - ((R - 1) << 8)) >> 5;
    if (x < nx || nx == 8) return 0;
    return (int)((float)(x - nx + 1) * (float)(nt * 140) * __builtin_amdgcn_rcpf((float)(8 - nx + 1)));
}
__device__ __forceinline__ void stagger_wait(int ticks) {
    if (ticks <= 0) return;
    const unsigned long long t0 = __builtin_amdgcn_s_memrealtime();
    while ((long long)(__builtin_amdgcn_s_memrealtime() - t0) < (long long)ticks) __builtin_amdgcn_s_sleep(16);
}
struct Sched1 {
    int nM, nN, G, c; const char* A; const char* Bt; size_t tstep; int nt;
    __device__ __forceinline__ bool next(int i, GUnit& u) const {
        const int L = unit_index(i, c, nM * nN); if (L < 0) return false;
        tile_of(L, nM, nN, u.pm, u.pn); u.kind = 0; u.nt = nt; u.a = A + (size_t)u.pm * tstep; u.b = Bt + (size_t)u.pn * tstep; return true;
    }
};
struct SchedIn {
    int G, c; const char* A; const char* Win; size_t tstep;
    __device__ __forceinline__ bool next(int i, GUnit& u) const {
        const int L = unit_index(i, c, 1440);
        if (L < 0) return false;
        u.nt = 16;
        if (L < 1152) { tile_of(L, 144, 8, u.pm, u.pn); u.kind = 0; u.a = A + (size_t)u.pm * tstep; u.b = Win + (size_t)u.pn * tstep; return true; }
        if (L < 1440) { tile_of(L - 1152, 2, 144, u.pm, u.pn); u.kind = 1; u.a = Win + (size_t)(8 + u.pm) * tstep; u.b = A + (size_t)u.pn * tstep; return true; }
        return false;
    }
};

struct SchedR {
    int c; bool has_ctx; const char* A; const char* Bt; size_t tstep; int NT;
    __device__ __forceinline__ bool next(int i, GUnit& u) const {
        if (i < 2) { const int L = unit_index(i, c, 512); tile_of(L, 128, 4, u.pm, u.pn); u.kind = 0; u.nt = NT; u.a = A + (size_t)u.pm * tstep; u.b = Bt + (size_t)u.pn * tstep; return true; }
        if (i == 2 && has_ctx) {
            int cc = c; asm volatile("" : "+s"(cc));
            const int Lc = (cc & 7) * 32 + (cc >> 3), ct = Lc >> 2, sp = Lc & 3;
            u.pm = 128 + (ct >> 2); u.pn = ct & 3; u.kind = sp;
            int ks;
            if (NT == 44) { ks = sp * 12 - (sp == 3 ? 2 : 0); u.nt = (sp < 2) ? 12 : 10; } else { ks = sp * (NT >> 2); u.nt = NT >> 2; }
            u.a = A + (size_t)u.pm * tstep + (size_t)ks * 128; u.b = Bt + (size_t)u.pn * tstep + (size_t)ks * 128; return true;
        }
        return false;
    }
};

struct EpiSwiGLU {
    bf16_t* hid;
    __device__ __forceinline__ void operator()(const f32x4 (&acc)[2][2][4][2], const GUnit& u, int wr, int wc, int fr, int fq) const {
        const int row0 = u.pm * BM + wr * 64 + fr;
        const int col0 = u.pn * 128 + wc * 32 + 8 * fq;
#pragma unroll
        for (int ai = 0; ai < 2; ++ai)
#pragma unroll
            for (int m = 0; m < 4; ++m) {
                float v[8];
#pragma unroll
                for (int n = 0; n < 2; ++n)
#pragma unroll
                    for (int j = 0; j < 4; ++j) {
                        const float g = acc[ai][0][m][n][j], uu = acc[ai][1][m][n][j];
                        const float sg = g * __builtin_amdgcn_rcpf(1.0f + __builtin_amdgcn_exp2f(-g * LOG2E));
                        v[n * 4 + j] = sg * uu;
                    }
                u32x4 w; w.x = cvt_pk_bf16(v[0], v[1]); w.y = cvt_pk_bf16(v[2], v[3]); w.z = cvt_pk_bf16(v[4], v[5]); w.w = cvt_pk_bf16(v[6], v[7]);
                *(u32x4*)(hid + (size_t)(row0 + ai * HALF + m * 16) * DFF + col0) = w;
            }
    }
};
struct EpiResid {
    const float* src_lat; const float* src_ctx; float* dst_lat; float* dst_ctx; const float* gate; float coef; bf16_t* Yc;
    __device__ __forceinline__ void operator()(const f32x4 (&acc)[2][2][4][2], const GUnit& u, int wr, int wc, int fr, int fq) const {
        if (u.kind != 0) {
            const int pmc = u.pm - 128; const int colc = u.pn * BM + wc * 32 + 4 * fq;
            bf16_t* yb = Yc + ((size_t)(u.kind - 1) * NCTX + (size_t)pmc * 256) * D;
            f32x4 gq[2][2];
#pragma unroll
            for (int bj = 0; bj < 2; ++bj)
#pragma unroll
                for (int n = 0; n < 2; ++n) gq[bj][n] = *(const f32x4*)(gate + (size_t)16 * NMODC + colc + bj * HALF + n * 16) * coef;
#pragma unroll
            for (int ai = 0; ai < 2; ++ai)
#pragma unroll
                for (int m = 0; m < 4; ++m) {
                    bf16_t* rowp = yb + (size_t)(wr * 64 + fr + ai * HALF + m * 16) * D + colc;
#pragma unroll
                    for (int bj = 0; bj < 2; ++bj)
#pragma unroll
                        for (int n = 0; n < 2; ++n) {
                            const f32x4 a = gq[bj][n] * acc[ai][bj][m][n]; u32x2 w; w.x = cvt_pk_bf16(a[0], a[1]); w.y = cvt_pk_bf16(a[2], a[3]);
                            *(u32x2*)(rowp + bj * HALF + n * 16) = w;
                        }
                }
            return;
        }
        const int pm = u.pm; const bool lat = pm < 128;
        const float* sp = lat ? src_lat + (size_t)pm * 256 * D : src_ctx + (size_t)(pm - 128) * 256 * D;
        float* dp = lat ? dst_lat + (size_t)pm * 256 * D : dst_ctx + (size_t)(pm - 128) * 256 * D;
        const int modrow = lat ? (pm >> 3) : 16;
        const int col0 = u.pn * BM + wc * 32 + 4 * fq;
        f32x4 gv[2][2];
#pragma unroll
        for (int bj = 0; bj < 2; ++bj)
#pragma unroll
            for (int n = 0; n < 2; ++n) gv[bj][n] = *(const f32x4*)(gate + (size_t)modrow * NMODC + col0 + bj * HALF + n * 16) * coef;
#pragma unroll
        for (int ai = 0; ai < 2; ++ai)
#pragma unroll
            for (int mp = 0; mp < 2; ++mp) {
                f32x4 rv[2][2][2];
#pragma unroll
                for (int mm = 0; mm < 2; ++mm)
#pragma unroll
                    for (int bj = 0; bj < 2; ++bj)
#pragma unroll
                        for (int n = 0; n < 2; ++n)
                            rv[mm][bj][n] = *(const f32x4*)(sp + (size_t)(wr * 64 + fr + ai * HALF + (mp * 2 + mm) * 16) * D + col0 + bj * HALF + n * 16);
#pragma unroll
                for (int mm = 0; mm < 2; ++mm)
#pragma unroll
                    for (int bj = 0; bj < 2; ++bj)
#pragma unroll
                        for (int n = 0; n < 2; ++n)
                            *(f32x4*)(dp + (size_t)(wr * 64 + fr + ai * HALF + (mp * 2 + mm) * 16) * D + col0 + bj * HALF + n * 16) = rv[mm][bj][n] + gv[bj][n] * acc[ai][bj][mp * 2 + mm][n];
            }
    }
};
struct EpiY {
    bf16_t* Y0; bf16_t* Yc; const float* gate; float coef;
    __device__ __forceinline__ void operator()(const f32x4 (&acc)[2][2][4][2], const GUnit& u, int wr, int wc, int fr_, int fq_) const {
        int fr = fr_, fq = fq_; asm volatile("" : "+v"(fr), "+v"(fq));
        const int pm = u.pm; const int modrow = (pm < 128) ? (pm >> 3) : 16;
        const int col0 = u.pn * BM + wc * 32 + 4 * fq;
        bf16_t* yb = (u.kind == 0) ? Y0 + (size_t)pm * 256 * D : Yc + ((size_t)(u.kind - 1) * NCTX + (size_t)(pm - 128) * 256) * D;
        f32x4 gv[2][2];
#pragma unroll
        for (int bj = 0; bj < 2; ++bj)
#pragma unroll
            for (int n = 0; n < 2; ++n) gv[bj][n] = *(const f32x4*)(gate + (size_t)modrow * NMODC + col0 + bj * HALF + n * 16) * coef;
#pragma unroll
        for (int ai = 0; ai < 2; ++ai)
#pragma unroll
            for (int m = 0; m < 4; ++m) {
                bf16_t* rowp = yb + (size_t)(wr * 64 + fr + ai * HALF + m * 16) * D + col0;
#pragma unroll
                for (int bj = 0; bj < 2; ++bj)
#pragma unroll
                    for (int n = 0; n < 2; ++n) {
                        const f32x4 a = gv[bj][n] * acc[ai][bj][m][n]; u32x2 w; w.x = cvt_pk_bf16(a[0], a[1]); w.y = cvt_pk_bf16(a[2], a[3]);
                        *(u32x2*)(rowp + bj * HALF + n * 16) = w;
                    }
            }
    }
};
struct EpiIn {
    bf16_t *Q, *KB, *VT, *EW; const float *qw, *kw; const LAS float* ropeL;
    __device__ __forceinline__ void operator()(const f32x4 (&acc)[2][2][4][2], const GUnit& u, int wr, int wc, int fr, int fq) const {
        const int pm = u.pm, pn = u.pn;
        if (u.kind == 1) {
            int b, key0; if (pn < 128) { b = pn >> 3; key0 = (pn & 7) * 256; } else { b = pn - 128; key0 = SEQ; }
#pragma unroll
            for (int ai = 0; ai < 2; ++ai)
#pragma unroll
                for (int m = 0; m < 4; ++m) {
                    const int vcol = pm * 256 + ai * HALF + wr * 64 + m * 16 + fr;
                    bf16_t* rowp = VT + (size_t)(b * 512 + vcol) * NKEYS + key0 + wc * 32 + 4 * fq;
#pragma unroll
                    for (int bj = 0; bj < 2; ++bj)
#pragma unroll
                        for (int n = 0; n < 2; ++n) {
                            const f32x4 a = acc[ai][bj][m][n]; u32x2 w; w.x = cvt_pk_bf16(a[0], a[1]); w.y = cvt_pk_bf16(a[2], a[3]);
                            *(u32x2*)(rowp + bj * HALF + n * 16) = w;
                        }
                }
            return;
        }
        const bool lat = pm < 128;
        const int rl0 = wr * 64 + fr;
        if (pn >= 4) {
#pragma unroll
            for (int ai = 0; ai < 2; ++ai)
#pragma unroll
                for (int m = 0; m < 4; ++m) {
                    bf16_t* rowp = EW + (size_t)(pm * 256 + rl0 + ai * HALF + m * 16) * 1024 + (pn - 4) * 256 + wc * 64 + 4 * fq;
#pragma unroll
                    for (int bj = 0; bj < 2; ++bj)
#pragma unroll
                        for (int n = 0; n < 2; ++n) {
                            const f32x4 a = acc[ai][bj][m][n]; u32x2 w; w.x = cvt_pk_bf16(a[0], a[1]); w.y = cvt_pk_bf16(a[2], a[3]);
                            *(u32x2*)(rowp + bj * 32 + n * 16) = w;
                        }
                }
            return;
        }
        const bool isq = pn < 2;
        const float* w = isq ? qw : kw;
        f32x4 wv[2][2];
#pragma unroll
        for (int bj = 0; bj < 2; ++bj)
#pragma unroll
            for (int n = 0; n < 2; ++n) wv[bj][n] = *(const f32x4*)(w + bj * 32 + n * 16 + 4 * fq);
        const float osc = isq ? 0.125f * LOG2E : 1.0f;
        bf16_t* dst; size_t drow0;
        if (isq) { dst = Q; drow0 = (size_t)pm * 256; }
        else { dst = KB; drow0 = lat ? (size_t)(pm >> 3) * NKEYS + (size_t)(pm & 7) * 256 : (size_t)(pm - 128) * NKEYS + SEQ; }
        const int colb = (pn & 1) * 256 + wc * 64 + 4 * fq;
#pragma unroll
        for (int ai = 0; ai < 2; ++ai)
#pragma unroll
            for (int m = 0; m < 4; ++m) {
                const int rl = rl0 + ai * HALF + m * 16;
                float ss = 0.f;
#pragma unroll
                for (int bj = 0; bj < 2; ++bj)
#pragma unroll
                    for (int n = 0; n < 2; ++n) { const f32x4 a = acc[ai][bj][m][n]; ss += a[0] * a[0] + a[1] * a[1] + a[2] * a[2] + a[3] * a[3]; }
                ss += shx(ss, 16, fq * 16 + fr); ss += shx(ss, 32, fq * 16 + fr);
                const float rs = rsqrtf(ss * (1.0f / 64.0f) + 1e-6f) * osc;
                f32x4 y[2][2];
#pragma unroll
                for (int bj = 0; bj < 2; ++bj)
#pragma unroll
                    for (int n = 0; n < 2; ++n) y[bj][n] = acc[ai][bj][m][n] * rs * wv[bj][n];
                if (lat) {
                    const int s = (pm & 7) * 256 + rl;
#pragma unroll
                    for (int bj = 0; bj < 2; ++bj) {
                        const int pos = bj ? (s & 63) : (s >> 6);
                        const f32x4 c4 = *(const LAS f32x4*)(ropeL + pos * 16 + 4 * fq), s4 = *(const LAS f32x4*)(ropeL + 1024 + pos * 16 + 4 * fq);
                        const f32x4 x1 = y[bj][0], x2 = y[bj][1];
                        y[bj][0] = x1 * c4 - x2 * s4; y[bj][1] = x1 * s4 + x2 * c4;
                    }
                }
                bf16_t* rowp = dst + (drow0 + rl) * 512 + colb;
#pragma unroll
                for (int bj = 0; bj < 2; ++bj)
#pragma unroll
                    for (int n = 0; n < 2; ++n) {
                        const f32x4 a = y[bj][n]; u32x2 ww; ww.x = cvt_pk_bf16(a[0], a[1]); ww.y = cvt_pk_bf16(a[2], a[3]);
                        *(u32x2*)(rowp + bj * 32 + n * 16) = ww;
                    }
            }
    }
};

template <class Sched, class Epi>
__device__ __forceinline__ void gemm_phase(LAS unsigned char* lds, const int K, const Sched& S, const Epi& E, const int delay_ticks) {
    const int tid = fresh_tid(), wid = __builtin_amdgcn_readfirstlane(tid >> 6), lane = tid & 63, wr = wid >> 2, wc = wid & 3, fr = lane & 15, fq = lane >> 4;
    unsigned voff[2];
#pragma unroll
    for (int i = 0; i < 2; ++i) { int R, C; stage_rc(tid * 16 + i * 8192, R, C); voff[i] = (unsigned)(R * K + C) * 2u; }
    const size_t kstep = (size_t)(BK * 2);
    const size_t hstep = (size_t)HALF * K * 2;
    const unsigned ldsw = (unsigned)wid * 1024u;
    const int aoff = lds_byte(wr * 64 + fr, fq * 8), boff = lds_byte(wc * 32 + fr, fq * 8);
#define PG8_SA(b, h) (((b) * 2 + (h)) * HTB)
#define PG8_SB(b, h) ((4 + (b) * 2 + (h)) * HTB)
#define PG8_STAGE(bufoff, gbase) do { _Pragma("unroll") for (int _i = 0; _i < 2; ++_i) \
        __builtin_amdgcn_global_load_lds((const unsigned*)((const char*)(gbase) + voff[_i]), (LAS unsigned*)(lds + (bufoff) + ldsw + _i * 8192), 16, 0, 0); } while (0)
#define PG8_LDA(dst, b, h) do { _Pragma("unroll") for (int m = 0; m < 4; ++m) _Pragma("unroll") for (int k = 0; k < 2; ++k) dst[m][k] = *(const LAS bf16x8*)(lds + PG8_SA(b, h) + aoff + m * 2048 + k * 1024); } while (0)
#define PG8_LDB(dst, b, h) do { _Pragma("unroll") for (int n = 0; n < 2; ++n) _Pragma("unroll") for (int k = 0; k < 2; ++k) dst[n][k] = *(const LAS bf16x8*)(lds + PG8_SB(b, h) + boff + n * 2048 + k * 1024); } while (0)
#define PG8_MMA(ai, bj, At, Bt) do { __builtin_amdgcn_s_setprio(1); _Pragma("unroll") for (int m = 0; m < 4; ++m) _Pragma("unroll") for (int n = 0; n < 2; ++n) _Pragma("unroll") for (int k = 0; k < 2; ++k) \
        acc[ai][bj][m][n] = __builtin_amdgcn_mfma_f32_16x16x32_bf16(Bt[n][k], At[m][k], acc[ai][bj][m][n], 0, 0, 0); __builtin_amdgcn_s_setprio(0); } while (0)
#define PG8_WAIT_V(n) asm volatile("s_waitcnt vmcnt(" #n ")" ::: "memory")
#define PG8_WAIT_L(n) asm volatile("s_waitcnt lgkmcnt(" #n ")" ::: "memory")
#define PG8_BAR __builtin_amdgcn_s_barrier()
#define PG8_SCHED __builtin_amdgcn_sched_barrier(0)
    GUnit cur, nxt; int ui = 0;
    if (!S.next(0, cur)) return;
    (void)delay_ticks;
    f32x4 acc[2][2][4][2];
#pragma unroll
    for (int a = 0; a < 2; ++a)
#pragma unroll
        for (int b = 0; b < 2; ++b)
#pragma unroll
            for (int m = 0; m < 4; ++m)
#pragma unroll
                for (int n = 0; n < 2; ++n) acc[a][b][m][n] = (f32x4){0.f, 0.f, 0.f, 0.f};
    bf16x8 At[4][2], B0[2][2], B1[2][2];
    const char* cA = cur.a; const char* cB = cur.b;
    PG8_STAGE(PG8_SB(0, 0), cB); PG8_STAGE(PG8_SA(0, 0), cA); PG8_STAGE(PG8_SB(0, 1), cB + hstep); PG8_STAGE(PG8_SA(0, 1), cA + hstep);
    if (wr == 1) PG8_BAR;
    PG8_WAIT_V(4); PG8_BAR;
    PG8_STAGE(PG8_SB(1, 0), cB + kstep); PG8_STAGE(PG8_SA(1, 0), cA + kstep); PG8_STAGE(PG8_SB(1, 1), cB + hstep + kstep);
    PG8_WAIT_V(6); PG8_BAR;
    for (;;) {
        const bool has_next = S.next(ui + 1, nxt);
        const char* nA = has_next ? nxt.a : cA; const char* nB = has_next ? nxt.b : cB;
        const int cnt = cur.nt;
        for (int t = 0; t < cnt; t += 2) {
            const bool last = (t == cnt - 2);
            const char* a1 = cA + (size_t)(t + 1) * kstep;
            const char* a2 = last ? nA : cA + (size_t)(t + 2) * kstep; const char* b2 = last ? nB : cB + (size_t)(t + 2) * kstep;
            const char* a3 = a2 + kstep; const char* b3 = b2 + kstep;
            PG8_LDB(B0, 0, 0); PG8_SCHED; PG8_LDA(At, 0, 0); PG8_STAGE(PG8_SA(1, 1), a1 + hstep);
            PG8_WAIT_L(8); PG8_BAR; PG8_WAIT_L(0); PG8_MMA(0, 0, At, B0); PG8_BAR; PG8_SCHED;
            PG8_LDB(B1, 0, 1); PG8_STAGE(PG8_SB(0, 0), b2);
            PG8_BAR; PG8_WAIT_L(0); PG8_MMA(0, 1, At, B1); PG8_BAR;
            PG8_LDA(At, 0, 1); PG8_STAGE(PG8_SA(0, 0), a2);
            PG8_BAR; PG8_WAIT_L(0); PG8_MMA(1, 0, At, B0); PG8_BAR; PG8_SCHED;
            PG8_STAGE(PG8_SB(0, 1), b2 + hstep);
            PG8_WAIT_V(6); PG8_BAR; PG8_MMA(1, 1, At, B1); PG8_BAR;
            PG8_LDB(B0, 1, 0); PG8_SCHED; PG8_LDA(At, 1, 0); PG8_STAGE(PG8_SA(0, 1), a2 + hstep);
            PG8_WAIT_L(8); PG8_BAR; PG8_WAIT_L(0); PG8_MMA(0, 0, At, B0); PG8_BAR; PG8_SCHED;
            PG8_LDB(B1, 1, 1); PG8_STAGE(PG8_SB(1, 0), b3);
            PG8_BAR; PG8_WAIT_L(0); PG8_MMA(0, 1, At, B1); PG8_BAR;
            PG8_LDA(At, 1, 1); PG8_STAGE(PG8_SA(1, 0), a3);
            PG8_BAR; PG8_WAIT_L(0); PG8_MMA(1, 0, At, B0); PG8_BAR; PG8_SCHED;
            PG8_STAGE(PG8_SB(1, 1), b3 + hstep);
            PG8_WAIT_V(6); PG8_BAR; PG8_MMA(1, 1, At, B1); PG8_BAR;
        }
        E(acc, cur, wr, wc, fr, fq);
        if (!has_next) break;
#pragma unroll
        for (int a = 0; a < 2; ++a)
#pragma unroll
            for (int b = 0; b < 2; ++b)
#pragma unroll
                for (int m = 0; m < 4; ++m)
#pragma unroll
                    for (int n = 0; n < 2; ++n) acc[a][b][m][n] = (f32x4){0.f, 0.f, 0.f, 0.f};
        cur = nxt; cA = nA; cB = nB; ++ui;
    }
    PG8_WAIT_V(0);
    if (wr == 0) PG8_BAR;
    PG8_BAR;
#undef PG8_SA
#undef PG8_SB
#undef PG8_STAGE
#undef PG8_LDA
#undef PG8_LDB
#undef PG8_MMA
#undef PG8_WAIT_V
#undef PG8_WAIT_L
#undef PG8_BAR
#undef PG8_SCHED
}

__device__ __forceinline__ void mod_item(LAS unsigned char* lds, int item) {
    const KArgP pp = kargs(); const float* p_c = pp->c; const float* p_cctx = pp->c_ctx; const float* p_wmod = pp->w_mod; const float* p_bmod = pp->b_mod; unsigned char* p_ws = pp->ws;
    const int tid = fresh_tid(), lane = tid & 63, wave = tid >> 6;
    const int l = item / 72, n0 = (item % 72) * 128;
    LAS float* sil = (LAS float*)lds;
    __syncthreads();
    for (int idx = tid; idx < 17 * 1024; idx += 512) {
        const int r = idx >> 10, k = idx & 1023;
        const float v = (r < 16) ? p_c[r * 1024 + k] : p_cctx[k];
        sil[k * 20 + r] = v / (1.0f + __expf(-v));
    }
    __syncthreads();
    const int cgp = tid & 31, ksl = tid >> 5;
    f32x4 acc[17];
#pragma unroll
    for (int r = 0; r < 17; ++r) acc[r] = (f32x4){0.f, 0.f, 0.f, 0.f};
    const float* wp = p_wmod + ((size_t)l * 1024 + (size_t)ksl * 64) * NMODC + n0 + 4 * cgp;
#pragma unroll 4
    for (int kk = 0; kk < 64; ++kk) {
        const f32x4 w = *(const f32x4*)(wp + (size_t)kk * NMODC);
        const LAS float* sp = sil + (ksl * 64 + kk) * 20;
        const f32x4 s0 = *(const LAS f32x4*)(sp), s1 = *(const LAS f32x4*)(sp + 4), s2 = *(const LAS f32x4*)(sp + 8), s3 = *(const LAS f32x4*)(sp + 12);
        const float s16 = sp[16];
#pragma unroll
        for (int j = 0; j < 4; ++j) { acc[j] += w * s0[j]; acc[4 + j] += w * s1[j]; acc[8 + j] += w * s2[j]; acc[12 + j] += w * s3[j]; }
        acc[16] += w * s16;
    }
#pragma unroll
    for (int r = 0; r < 17; ++r)
#pragma unroll
        for (int j = 0; j < 4; ++j) acc[r][j] += shx(acc[r][j], 32, lane);
    __syncthreads();
    LAS float* red = (LAS float*)lds;
    if (lane < 32) {
#pragma unroll
        for (int r = 0; r < 17; ++r) *(LAS f32x4*)(red + (wave * 17 + r) * 128 + 4 * cgp) = acc[r];
    }
    __syncthreads();
    float* modp = (float*)(p_ws + OFF_MOD);
    for (int o = tid; o < 17 * 128; o += 512) {
        const int r = o >> 7, cc = o & 127;
        float s = p_bmod[l * NMODC + n0 + cc];
#pragma unroll
        for (int w = 0; w < 8; ++w) s += red[(w * 17 + r) * 128 + cc];
        modp[((size_t)l * 17 + r) * NMODC + n0 + cc] = s;
    }
    __syncthreads();
}

__device__ __forceinline__ void conv_tile(LAS unsigned char* lds, int idx) {
    const KArgP p = kargs();
    const int tid = fresh_tid();
    const float* src; bf16_t* dst; int Nsrc, K, ntile, kg, type, l;
    if (idx < 2816) { const int mat = idx / 352, rem = idx % 352; ntile = rem >> 2; kg = rem & 3; l = mat >> 1; type = 0;
        src = ((mat & 1) ? p->w_gu2 : p->w_gu1) + (size_t)l * D * NGU; Nsrc = NGU; K = D; dst = (bf16_t*)(p->ws + OFF_WGU) + (size_t)mat * NGU * D; }
    else if (idx < 2816 + 1408) { const int i2 = idx - 2816; const int mat = i2 / 176, rem = i2 % 176; ntile = rem / 11; kg = rem % 11; l = mat >> 1; type = 1;
        src = ((mat & 1) ? p->w_dn2 : p->w_dn1) + (size_t)l * DFF * D; Nsrc = D; K = DFF; dst = (bf16_t*)(p->ws + OFF_WDN) + (size_t)mat * D * DFF; }
    else if (idx < 2816 + 1408 + 640) { const int i2 = idx - 4224; l = i2 / 160; const int rem = i2 % 160; ntile = rem >> 2; kg = rem & 3; type = 2;
        src = p->w_in + (size_t)l * D * INC; Nsrc = INC; K = D; dst = (bf16_t*)(p->ws + OFF_WIN) + (size_t)l * INC * D; }
    else { const int i2 = idx - 4864; l = i2 >> 6; const int rem = i2 & 63; ntile = rem >> 2; kg = rem & 3; type = 3;
        src = p->w_out + (size_t)l * D * D; Nsrc = D; K = D; dst = (bf16_t*)(p->ws + OFF_WOUT) + (size_t)l * D * D; }
    const int n0 = ntile * 64, k0 = kg * 256;
    LAS float* tile = (LAS float*)lds;
    const int c4 = tid & 15, kk = tid >> 4;
    const int np = n0 + 4 * c4;
    int fcol;
    if (type == 0) { const int s = np & 255; fcol = (s >> 7) * DFF + 128 * (np >> 8) + 32 * ((s >> 5) & 3) + 8 * ((s >> 2) & 3) + 4 * ((s >> 4) & 1); }
    else if (type == 2) {
        if (np < 2048) { const int t8 = np >> 8, s = np & 255, R = s & 127; const int colbase = (t8 < 4) ? t8 * 256 : 1536 + (t8 - 4) * 256; fcol = colbase + 64 * (R >> 5) + 32 * (s >> 7) + (R & 31); }
        else fcol = 1024 + (np - 2048);
    } else fcol = np;
    __syncthreads();
    if (type == 3 && k0 >= 768) {
#pragma unroll 1
        for (int g = 0; g < 4; ++g)
#pragma unroll
            for (int hlf = 0; hlf < 2; ++hlf) {
                const int k = kk + 32 * hlf;
                const float* pw = p->pool_w + ((size_t)(l * 4 + g) * 64 + k) * 64;
                const float* sc = p->pool_scale + l * 256 + g * 64;
                const float* ws = src + (size_t)(768 + g * 64) * D + fcol;
                f32x4 v = (f32x4){0.f, 0.f, 0.f, 0.f};
                for (int d = 0; d < 64; ++d) v += *(const f32x4*)(ws + (size_t)d * D) * (pw[d] * sc[d]);
                LAS float* tp = tile + g * 4160 + k * 65 + 4 * c4;
                tp[0] = v[0]; tp[1] = v[1]; tp[2] = v[2]; tp[3] = v[3];
            }
    } else {
        f32x4 v[8];
#pragma unroll
        for (int q = 0; q < 8; ++q) v[q] = *(const f32x4*)(src + (size_t)(k0 + kk + 32 * q) * Nsrc + fcol);
#pragma unroll
        for (int q = 0; q < 8; ++q) {
            LAS float* tp = tile + (q >> 1) * 4160 + (kk + 32 * (q & 1)) * 65 + 4 * c4;
            tp[0] = v[q][0]; tp[1] = v[q][1]; tp[2] = v[q][2]; tp[3] = v[q][3];
        }
    }
    __syncthreads();
    const int n = tid >> 3, kseg = (tid & 7) * 8;
#pragma unroll
    for (int g = 0; g < 4; ++g) {
        float f[8];
#pragma unroll
        for (int i = 0; i < 8; ++i) f[i] = tile[g * 4160 + (kseg + i) * 65 + n];
        u32x4 w; w.x = cvt_pk_bf16(f[0], f[1]); w.y = cvt_pk_bf16(f[2], f[3]); w.z = cvt_pk_bf16(f[4], f[5]); w.w = cvt_pk_bf16(f[6], f[7]);
        *(u32x4*)(dst + (size_t)(n0 + n) * K + k0 + g * 64 + kseg) = w;
    }
}

__device__ __forceinline__ void rope_item() {
    float* cosT = (float*)(kargs()->ws + OFF_ROPE); float* sinT = cosT + 1024;
    for (int idx = threadIdx.x; idx < 1024; idx += 512) {
        const int pos = idx >> 4, f = idx & 15, fm = f & 3, fqd = f >> 2;
        double inv = (fm == 0) ? 1.0 : (fm == 1) ? 0.5623413251903491 : (fm == 2) ? 0.31622776601683794 : 0.1778279410038923;
        inv *= (fqd == 0) ? 1.0 : (fqd == 1) ? 0.1 : (fqd == 2) ? 0.01 : 0.001;
        const double a = (double)((float)pos * (float)inv);
        const double twopi = 6.283185307179586476925;
        const double nrev = __builtin_rint(a / twopi);
        const double x = a - nrev * twopi, x2 = x * x;
        double sn = 0.0, cs = 0.0, ts = x, tc = 1.0;
#pragma unroll 1
        for (int i = 0; i < 16; ++i) { cs += tc; sn += ts; tc = -tc * x2 / (double)((2 * i + 1) * (2 * i + 2)); ts = -ts * x2 / (double)((2 * i + 2) * (2 * i + 3)); }
        cosT[idx] = (float)cs; sinT[idx] = (float)sn;
    }
}

__device__ __forceinline__ void prep_rows(const float* xp, float* dp, const bf16_t* y0, const bf16_t* yc, bf16_t* ap, int n, const f32x4 (&nwv)[4], const f32x4 (&sc)[4], const f32x4 (&sh)[4], int lane) {
    for (int i = 0; i < n; ++i) {
        f32x4 x[4]; float ss = 0.f;
#pragma unroll
        for (int q = 0; q < 4; ++q) x[q] = *(const f32x4*)(xp + (size_t)i * D + 4 * lane + 256 * q);
        if (y0) {
#pragma unroll
            for (int q = 0; q < 4; ++q) { const u32x2 w = *(const u32x2*)(y0 + (size_t)i * D + 4 * lane + 256 * q); x[q] += (f32x4){bf_lo(w.x), bf_hi(w.x), bf_lo(w.y), bf_hi(w.y)}; }
        }
        if (yc) {
#pragma unroll
            for (int sp = 0; sp < 3; ++sp)
#pragma unroll
                for (int q = 0; q < 4; ++q) { const u32x2 w = *(const u32x2*)(yc + (size_t)sp * NCTX * D + (size_t)i * D + 4 * lane + 256 * q); x[q] += (f32x4){bf_lo(w.x), bf_hi(w.x), bf_lo(w.y), bf_hi(w.y)}; }
        }
#pragma unroll
        for (int q = 0; q < 4; ++q) ss += x[q][0] * x[q][0] + x[q][1] * x[q][1] + x[q][2] * x[q][2] + x[q][3] * x[q][3];
        if (dp) {
#pragma unroll
            for (int q = 0; q < 4; ++q) *(f32x4*)(dp + (size_t)i * D + 4 * lane + 256 * q) = x[q];
        }
        ss = wave_sum(ss, lane);
        const float rstd = rsqrtf(ss * (1.0f / 1024.0f) + 1e-6f);
#pragma unroll
        for (int q = 0; q < 4; ++q) {
            const f32x4 y = (x[q] * rstd * nwv[q]) * sc[q] + sh[q];
            u32x2 w; w.x = cvt_pk_bf16(y[0], y[1]); w.y = cvt_pk_bf16(y[2], y[3]);
            *(u32x2*)(ap + (size_t)i * D + 4 * lane + 256 * q) = w;
        }
    }
}
__device__ __forceinline__ void prep_phase(const float* src_lat, const float* src_ctx, float* dst_lat, float* dst_ctx, const bf16_t* Y0, const bf16_t* Yc, bool ctx_split,
                                           bf16_t* A, const float* nw, const float* modl, int shift_i, int scale_i, bool with_ctx) {
    const int tid = fresh_tid();
    const int lane = tid & 63, wv = tid >> 6, xl = blockIdx.x & 7, off = blockIdx.x >> 3;
    f32x4 nwv[4], sc[4], sh[4];
#pragma unroll
    for (int q = 0; q < 4; ++q) nwv[q] = *(const f32x4*)(nw + 4 * lane + 256 * q);
    {
        const int row0 = xl * 4096 + off * 128 + wv * 16, mr = row0 >> 11;
#pragma unroll
        for (int q = 0; q < 4; ++q) {
            sc[q] = *(const f32x4*)(modl + (size_t)mr * NMODC + scale_i * 1024 + 4 * lane + 256 * q) + 1.0f;
            sh[q] = *(const f32x4*)(modl + (size_t)mr * NMODC + shift_i * 1024 + 4 * lane + 256 * q);
        }
        prep_rows(src_lat + (size_t)row0 * D, nullptr, nullptr, nullptr, A + (size_t)row0 * D, 16, nwv, sc, sh, lane);
    }
    if (with_ctx) {
        const int crow0 = xl * 512 + off * 16 + wv * 2;
#pragma unroll
        for (int q = 0; q < 4; ++q) {
            sc[q] = *(const f32x4*)(modl + (size_t)16 * NMODC + scale_i * 1024 + 4 * lane + 256 * q) + 1.0f;
            sh[q] = *(const f32x4*)(modl + (size_t)16 * NMODC + shift_i * 1024 + 4 * lane + 256 * q);
        }
        prep_rows(src_ctx + (size_t)crow0 * D, ctx_split ? dst_ctx + (size_t)crow0 * D : nullptr, nullptr, ctx_split ? Yc + (size_t)crow0 * D : nullptr,
                  A + (size_t)(NLAT + crow0) * D, 2, nwv, sc, sh, lane);
    }
}

__device__ __forceinline__ void attn_item(LAS unsigned char* lds, const bf16_t* Q, const bf16_t* KB, const bf16_t* VT, bf16_t* MIX,
                                          int b, int h, int qrow0, int key0, int nkeys, float lam, float negM, const float* subw, float post_scale) {
    const int tid = fresh_tid(), lane = tid & 63, wave = tid >> 6, r = lane & 31, h2 = lane >> 5;
    f32x16 O[2][4];
#pragma unroll
    for (int i = 0; i < 2; ++i)
#pragma unroll
        for (int et = 0; et < 4; ++et)
#pragma unroll
            for (int j = 0; j < 16; ++j) O[i][et][j] = 0.f;
    float ls0 = 0.f, ls1 = 0.f;
    const char* kg = (const char*)(KB + ((size_t)(b * NKEYS + key0)) * 512 + h * 128);
    const char* vg = (const char*)(VT + ((size_t)(b * 512 + h * 128)) * NKEYS + key0);
    const int wu = __builtin_amdgcn_readfirstlane(wave);
    const int nt = nkeys >> 6;
#define ATT_STAGE(t_, bufo_) do { int ln = lane; asm volatile("" : "+v"(ln)); _Pragma("unroll") for (int _i = 0; _i < 2; ++_i) { const int pc = wu + 8 * _i; \
        const int key = pc * 4 + (ln >> 4), c = (ln & 15) ^ (key & 15); const unsigned kgo = (unsigned)(key * 1024 + c * 16); \
        const int e = pc * 8 + (ln >> 3), cv = (ln & 7) ^ ((e >> 1) & 7); const unsigned vgo = (unsigned)(e * (NKEYS * 2) + cv * 16); \
        __builtin_amdgcn_global_load_lds((const unsigned*)(kg + (size_t)(t_) * 65536 + kgo), (LAS unsigned*)(lds + (bufo_) + pc * 1024), 16, 0, 0); \
        __builtin_amdgcn_global_load_lds((const unsigned*)(vg + (size_t)(t_) * 128 + vgo), (LAS unsigned*)(lds + (bufo_) + 16384 + pc * 1024), 16, 0, 0); } } while (0)
    __syncthreads();
    {
        const char* qg = (const char*)(Q + (size_t)qrow0 * 512 + h * 128);
#pragma unroll
        for (int i = 0; i < 8; ++i) {
            const int pq = wu * 8 + i, row = pq * 4 + (lane >> 4), c = (lane & 15) ^ (row & 15);
            __builtin_amdgcn_global_load_lds((const unsigned*)(qg + (size_t)row * 1024 + c * 16), (LAS unsigned*)(lds + 65536 + pq * 1024), 16, 0, 0);
        }
    }
    ATT_STAGE(0, 0);
    asm volatile("s_waitcnt vmcnt(0)" ::: "memory");
    __syncthreads();
    const int rs = (r & 0x13) | ((r & 4) << 1) | ((r & 8) >> 1);
    const int qrow = wave * 32 + r, qx = qrow & 15;
    const int kx = rs & 15;
    const LAS unsigned char* qbase = lds + 65536 + qrow * 256;
#define SB() __builtin_amdgcn_sched_barrier(0)
#define LD_QK(i_, kb_, kf_, qf_) do { _Pragma("unroll") for (int ks = 0; ks < 4; ++ks) { \
        kf_[ks] = *(const LAS bf16x8*)(Kb + ((kb_) * 32 + rs) * 256 + ((((i_) * 8 + ks * 2 + h2) ^ kx) << 4)); \
        qf_[ks] = *(const LAS bf16x8*)(qbase + ((((i_) * 8 + ks * 2 + h2) ^ qx) << 4)); } } while (0)
#define MM_S(Sv_, kf_, qf_) do { _Pragma("unroll") for (int j = 0; j < 16; ++j) Sv_[j] = negM; \
        _Pragma("unroll") for (int ks = 0; ks < 4; ++ks) Sv_ = __builtin_amdgcn_mfma_f32_32x32x16_bf16(kf_[ks], qf_[ks], Sv_, 0, 0, 0); } while (0)
#define EXP_P(Sv_, ls_, pf_) do { float psum = 0.f; _Pragma("unroll") for (int j = 0; j < 16; ++j) { Sv_[j] = __builtin_amdgcn_exp2f(Sv_[j]); psum += Sv_[j]; } ls_ += psum; \
        _Pragma("unroll") for (int sq = 0; sq < 2; ++sq) { u32x4 w; w.x = cvt_pk_bf16(Sv_[8 * sq + 0], Sv_[8 * sq + 1]); w.y = cvt_pk_bf16(Sv_[8 * sq + 2], Sv_[8 * sq + 3]); \
            w.z = cvt_pk_bf16(Sv_[8 * sq + 4], Sv_[8 * sq + 5]); w.w = cvt_pk_bf16(Sv_[8 * sq + 6], Sv_[8 * sq + 7]); pf_[sq] = __builtin_bit_cast(bf16x8, w); } } while (0)
#define LD_V(hf_, kb_, vf_) do { _Pragma("unroll") for (int el = 0; el < 2; ++el) { const int e = ((hf_) * 2 + el) * 32 + r, ex = (e >> 1) & 7; \
        _Pragma("unroll") for (int sq = 0; sq < 2; ++sq) vf_[el][sq] = *(const LAS bf16x8*)(Vb + e * 128 + ((((kb_) * 4 + sq * 2 + h2) ^ ex) << 4)); } } while (0)
#define MM_PV(hf_, vf_) do { _Pragma("unroll") for (int el = 0; el < 2; ++el) _Pragma("unroll") for (int sq = 0; sq < 2; ++sq) { \
        O[0][(hf_) * 2 + el] = __builtin_amdgcn_mfma_f32_32x32x16_bf16(vf_[el][sq], pf0[sq], O[0][(hf_) * 2 + el], 0, 0, 0); \
        O[1][(hf_) * 2 + el] = __builtin_amdgcn_mfma_f32_32x32x16_bf16(vf_[el][sq], pf1[sq], O[1][(hf_) * 2 + el], 0, 0, 0); } } while (0)
    for (int t = 0; t < nt; ++t) {
        const bool more = (t + 1 < nt);
        if (more) ATT_STAGE(t + 1, ((t + 1) & 1) * 32768);
        const LAS unsigned char* Kb = lds + (t & 1) * 32768;
        const LAS unsigned char* Vb = Kb + 16384;
        bf16x8 kfa[4], qfa[4], va[2][2], pf0[2], pf1[2];
        f32x16 S0, S1;
#pragma unroll 1
        for (int kb = 0; kb < 2; ++kb) {
            LD_QK(0, kb, kfa, qfa);
            SB(); MM_S(S0, kfa, qfa);
            SB(); LD_QK(1, kb, kfa, qfa);
            SB(); MM_S(S1, kfa, qfa); EXP_P(S0, ls0, pf0);
            SB(); LD_V(0, kb, va); EXP_P(S1, ls1, pf1);
            SB(); MM_PV(0, va); LD_V(1, kb, va);
            SB(); MM_PV(1, va);
        }
        SB();
        asm volatile("s_waitcnt vmcnt(0)" ::: "memory");
        __syncthreads();
    }
#undef SB
#undef LD_QK
#undef MM_S
#undef EXP_P
#undef LD_V
#undef MM_PV
    const int tid2 = fresh_tid(), lane2 = tid2 & 63, wave2 = tid2 >> 6, r2 = lane2 & 31, h2b = lane2 >> 5;
    ls0 += shx(ls0, 32, lane2); ls1 += shx(ls1, 32, lane2);
    const float inv1 = 1.0f / ls0, inv2 = lam / ls1;
    float ss = 0.f;
#pragma unroll
    for (int et = 0; et < 4; ++et)
#pragma unroll
        for (int j = 0; j < 16; ++j) { const float o = O[0][et][j] * inv1 - O[1][et][j] * inv2; O[0][et][j] = o; ss += o * o; }
    ss += shx(ss, 32, lane2);
    float li_ = post_scale; asm volatile("" : "+s"(li_));
    const float rstd = rsqrtf(ss * (1.0f / 128.0f) + 1e-6f) * (1.0f - li_);
    bf16_t* op = MIX + (size_t)(qrow0 + wave2 * 32 + r2) * 1024 + h * 128 + 4 * h2b;
#pragma unroll
    for (int et = 0; et < 4; ++et)
#pragma unroll
        for (int g4 = 0; g4 < 4; ++g4) {
            const int e0 = 32 * et + 8 * g4;
            const f32x4 w4 = *(const f32x4*)(subw + e0 + 4 * h2b);
            u32x2 w; w.x = cvt_pk_bf16(O[0][et][4 * g4 + 0] * rstd * w4[0], O[0][et][4 * g4 + 1] * rstd * w4[1]);
            w.y = cvt_pk_bf16(O[0][et][4 * g4 + 2] * rstd * w4[2], O[0][et][4 * g4 + 3] * rstd * w4[3]);
            *(u32x2*)(op + e0) = w;
        }
}

__device__ __forceinline__ void ew_rows(const bf16_t* EW, bf16_t* MIX, const float* convw, int row0, int nrows) {
    const int tid = fresh_tid();
    for (int task = tid; task < nrows * 32; task += 512) {
        const int row = row0 + (task >> 5), c0 = (task & 31) * 8;
        int t, L; if (row < NLAT) { t = row & (SEQ - 1); L = SEQ; } else { t = (row - NLAT) & (LCTX - 1); L = LCTX; }
        const bf16_t* er = EW + (size_t)row * 1024;
        u32x4 cc[3], cx[3]; f32x4 wa[3], wb[3];
#pragma unroll
        for (int i = 0; i < 3; ++i) {
            const int dt = i - 1; const bool ok = (t + dt >= 0) && (t + dt < L);
            const bf16_t* rp = er + (ok ? dt : 0) * 1024;
            cc[i] = *(const u32x4*)(rp + 256 + c0); cx[i] = *(const u32x4*)(rp + 512 + c0);
            const float m = ok ? 1.0f : 0.0f;
            wa[i] = *(const f32x4*)(convw + i * 256 + c0) * m; wb[i] = *(const f32x4*)(convw + i * 256 + c0 + 4) * m;
        }
        const u32x4 cb = *(const u32x4*)(er + c0);
        float accv[8];
#pragma unroll
        for (int j = 0; j < 8; ++j) accv[j] = 0.f;
#pragma unroll
        for (int i = 0; i < 3; ++i) {
            accv[0] += bf_lo(cc[i].x) * bf_lo(cx[i].x) * wa[i][0]; accv[1] += bf_hi(cc[i].x) * bf_hi(cx[i].x) * wa[i][1];
            accv[2] += bf_lo(cc[i].y) * bf_lo(cx[i].y) * wa[i][2]; accv[3] += bf_hi(cc[i].y) * bf_hi(cx[i].y) * wa[i][3];
            accv[4] += bf_lo(cc[i].z) * bf_lo(cx[i].z) * wb[i][0]; accv[5] += bf_hi(cc[i].z) * bf_hi(cx[i].z) * wb[i][1];
            accv[6] += bf_lo(cc[i].w) * bf_lo(cx[i].w) * wb[i][2]; accv[7] += bf_hi(cc[i].w) * bf_hi(cx[i].w) * wb[i][3];
        }
        u32x4 w;
        w.x = cvt_pk_bf16(bf_lo(cb.x) * accv[0], bf_hi(cb.x) * accv[1]); w.y = cvt_pk_bf16(bf_lo(cb.y) * accv[2], bf_hi(cb.y) * accv[3]);
        w.z = cvt_pk_bf16(bf_lo(cb.z) * accv[4], bf_hi(cb.z) * accv[5]); w.w = cvt_pk_bf16(bf_lo(cb.w) * accv[6], bf_hi(cb.w) * accv[7]);
        *(u32x4*)(MIX + (size_t)row * 1024 + 512 + c0) = w;
    }
    for (int task = tid; task < nrows * 32; task += 512) {
        const int row = row0 + (task >> 5), ps = task & 31, c0 = ps * 8, half = 1 << (ps >> 3);
        int t, L; if (row < NLAT) { t = row & (SEQ - 1); L = SEQ; } else { t = (row - NLAT) & (LCTX - 1); L = LCTX; }
        const bf16_t* er = EW + (size_t)row * 1024 + 768 + c0;
        const int lo = (t - half > 0) ? t - half : 0, hi = (t + half < L) ? t + half : L;
        u32x4 v[16];
#pragma unroll
        for (int i = 0; i < 16; ++i) { const int tt = t + i - 8; const bool ok = (tt >= lo) && (tt < hi); v[i] = *(const u32x4*)(er + (ok ? (i - 8) : 0) * 1024); if (!ok) v[i] = (u32x4){0u, 0u, 0u, 0u}; }
        const u32x4 sv = *(const u32x4*)(er);
        float sm[8];
#pragma unroll
        for (int j = 0; j < 8; ++j) sm[j] = 0.f;
#pragma unroll
        for (int i = 0; i < 16; ++i) {
            sm[0] += bf_lo(v[i].x); sm[1] += bf_hi(v[i].x); sm[2] += bf_lo(v[i].y); sm[3] += bf_hi(v[i].y);
            sm[4] += bf_lo(v[i].z); sm[5] += bf_hi(v[i].z); sm[6] += bf_lo(v[i].w); sm[7] += bf_hi(v[i].w);
        }
        const float ic = 1.0f / (float)(hi - lo);
        u32x4 w;
        w.x = cvt_pk_bf16(sm[0] * ic - bf_lo(sv.x), sm[1] * ic - bf_hi(sv.x)); w.y = cvt_pk_bf16(sm[2] * ic - bf_lo(sv.y), sm[3] * ic - bf_hi(sv.y));
        w.z = cvt_pk_bf16(sm[4] * ic - bf_lo(sv.z), sm[5] * ic - bf_hi(sv.z)); w.w = cvt_pk_bf16(sm[6] * ic - bf_lo(sv.w), sm[7] * ic - bf_hi(sv.w));
        *(u32x4*)(MIX + (size_t)row * 1024 + 768 + c0) = w;
    }
}


#define XB_TMO      128
#define XB_XCNT(j)  (256  + 64 * (j))
#define XB_XSUB(j)  (1280 + 64 * (j))
#define XB_XGEN(j)  (2304 + 64 * (j))
#define XB_TOP      3328
#define XB_TOPGEN   3392
#define XCD_BAR_WORDS 3456
#define XB_SPIN_CAP (1u << 22)
__device__ __forceinline__ unsigned xb_ld(unsigned* p)              { return __hip_atomic_load(p, __ATOMIC_RELAXED, __HIP_MEMORY_SCOPE_AGENT); }
__device__ __forceinline__ unsigned xb_add(unsigned* p, unsigned v) { return __hip_atomic_fetch_add(p, v, __ATOMIC_RELAXED, __HIP_MEMORY_SCOPE_AGENT); }
__device__ __forceinline__ unsigned xb_xcc_id() { return (unsigned)__builtin_amdgcn_s_getreg((3 << 11) | 20) & 0xFu; }
#define XB_SPIN(cond, bar) do { unsigned _sp = 0; while (cond) { __builtin_amdgcn_s_sleep(1); \
    if ((++_sp & 255u) == 0u) { if (xb_ld(&(bar)[XB_TMO])) break; if (_sp > XB_SPIN_CAP) { atomicAdd(&(bar)[XB_TMO], 1u); break; } } } } while (0)
struct XcdBarrier { unsigned* bar; unsigned x; volatile LAS unsigned* st; };
__device__ __forceinline__ XcdBarrier xcd_barrier_post(unsigned* bar, volatile LAS unsigned* st) {
    XcdBarrier b; b.bar = bar; b.x = xb_xcc_id(); b.st = st;
    if (threadIdx.x == 0) (void)xb_add(&bar[XB_XCNT(b.x)], 1u);
    return b;
}
__device__ __forceinline__ void xcd_barrier_complete(unsigned* bar, unsigned x, unsigned& nloc, unsigned& nx) {
    const unsigned G = gridDim.x * gridDim.y * gridDim.z;
    unsigned sum, cnt, mine, sp = 0u;
    for (;;) {
        sum = 0u; cnt = 0u; mine = 0u;
#pragma unroll
        for (unsigned j = 0; j < 16; ++j) { const unsigned c = xb_ld(&bar[XB_XCNT(j)]); sum += c; cnt += (c > 0u) ? 1u : 0u; mine = (j == x) ? c : mine; }
        if (sum == G) break;
        __builtin_amdgcn_s_sleep(1);
        if ((++sp & 255u) == 0u) { if (xb_ld(&bar[XB_TMO])) break; if (sp > XB_SPIN_CAP) { atomicAdd(&bar[XB_TMO], 1u); break; } }
    }
    nloc = mine > 0u ? mine : 1u; nx = cnt > 0u ? cnt : 1u;
}
__device__ __forceinline__ void xcd_barrier(const XcdBarrier& b) {
    asm volatile("s_waitcnt vmcnt(0)" ::: "memory");
    __syncthreads();
    if (threadIdx.x == 0) {
        unsigned* bar = b.bar;
        __builtin_amdgcn_s_waitcnt(0);
        unsigned nloc = b.st[0], nx = b.st[1];
        if (nloc == 0u) { xcd_barrier_complete(bar, b.x, nloc, nx); b.st[0] = nloc; b.st[1] = nx; }
        const unsigned old = xb_add(&bar[XB_XSUB(b.x)], 1u);
        const unsigned gen = old / nloc;
        if (old + 1u == (gen + 1u) * nloc) {
            __builtin_amdgcn_fence(__ATOMIC_RELEASE, "agent");
            asm volatile("s_waitcnt vmcnt(0)" ::: "memory");
            const unsigned og = xb_add(&bar[XB_TOP], 1u);
            const unsigned tg = og / nx;
            if (og + 1u == (tg + 1u) * nx) xb_add(&bar[XB_TOPGEN], 1u);
            else XB_SPIN(xb_ld(&bar[XB_TOPGEN]) == tg, bar);
            __builtin_amdgcn_fence(__ATOMIC_ACQUIRE, "agent");
            xb_add(&bar[XB_XGEN(b.x)], 1u);
            asm volatile("s_waitcnt vmcnt(0)" ::: "memory");
        } else {
            XB_SPIN(xb_ld(&bar[XB_XGEN(b.x)]) == gen, bar);
            __builtin_amdgcn_fence(__ATOMIC_ACQUIRE, "agent");
            asm volatile("s_waitcnt vmcnt(0)" ::: "memory");
        }
    }
    __syncthreads();
}

#define GB_CNT(x) (4096 + 64 * (x))
#define GB_GEN(x) (4096 + 512 + 64 * (x))
__device__ __forceinline__ void group_barrier(unsigned* bar, int label) {
    asm volatile("s_waitcnt vmcnt(0)" ::: "memory");
    __syncthreads();
    if (threadIdx.x == 0) {
        __builtin_amdgcn_s_waitcnt(0);
        __builtin_amdgcn_fence(__ATOMIC_RELEASE, "agent");
        asm volatile("s_waitcnt vmcnt(0)" ::: "memory");
        const unsigned old = xb_add(&bar[GB_CNT(label)], 1u);
        const unsigned gen = old >> 5;
        if (old + 1u == ((gen + 1u) << 5)) xb_add(&bar[GB_GEN(label)], 1u);
        else XB_SPIN(xb_ld(&bar[GB_GEN(label)]) == gen, bar);
        __builtin_amdgcn_fence(__ATOMIC_ACQUIRE, "agent");
        asm volatile("s_waitcnt vmcnt(0)" ::: "memory");
    }
    __syncthreads();
}

__global__ void __launch_bounds__(512, 2) hymba_mega(Params p_unused) {
    extern __shared__ __attribute__((aligned(16))) unsigned char lds_raw[];
    LAS unsigned char* lds = (LAS unsigned char*)lds_raw;
    cg::grid_group grid = cg::this_grid();
    const int G = gridDim.x, bid = blockIdx.x;
#define WSP(T, off) ((T*)(q->ws + (off)))
    volatile LAS unsigned* xst = (volatile LAS unsigned*)(lds + 131072 + 8192);
    if (threadIdx.x < 4) xst[threadIdx.x] = 0u;
    __syncthreads();
    const XcdBarrier xbar = xcd_barrier_post((unsigned*)(kargs()->ws + OFF_BAR), xst);

    for (int rep = 0; rep < REP_P0; ++rep)
    for (int item = bid; item < 288 + 5120 + 1; item += G) {
        if (item < 288) mod_item(lds, item);
        else if (item < 288 + 5120) conv_tile(lds, item - 288);
        else rope_item();
    }
    grid.sync();

#pragma unroll 1
    for (int l = 0; l < DEPTH; ++l) {
        const bool lastl = (l == DEPTH - 1);
        { const KArgP q = kargs();
          if (l == 0) prep_phase(q->x, q->ctx, nullptr, nullptr, nullptr, nullptr, false, WSP(bf16_t, OFF_A), q->norm_w, WSP(float, OFF_MOD), 0, 1, true);
          else prep_phase(q->out, WSP(float, OFF_HC), nullptr, WSP(float, OFF_HC), nullptr, WSP(bf16_t, OFF_YC), true, WSP(bf16_t, OFF_A), q->norm_w + (l * 3 + 0) * D, WSP(float, OFF_MOD) + (size_t)l * 17 * NMODC, 0, 1, true); }
        GRID_SYNC();
        { const KArgP q = kargs();
          Sched1 S{144, 22, G, bid, (const char*)WSP(bf16_t, OFF_A), (const char*)(WSP(bf16_t, OFF_WGU) + (size_t)(l * 2 + 0) * NGU * D), (size_t)256 * D * 2, 16}; EpiSwiGLU E{WSP(bf16_t, OFF_HID)};
          gemm_phase(lds, D, S, E, stagger_ticks(S.nM * 22, bid, 16)); }
        GRID_SYNC();
        { const KArgP q = kargs();
          SchedR S{bid, true, (const char*)WSP(bf16_t, OFF_HID), (const char*)(WSP(bf16_t, OFF_WDN) + (size_t)(l * 2 + 0) * D * DFF), (size_t)256 * DFF * 2, 44};
          EpiResid E{(l == 0) ? q->x : q->out, (l == 0) ? q->ctx : WSP(float, OFF_HC), q->out, WSP(float, OFF_HC), WSP(float, OFF_MOD) + (size_t)l * 17 * NMODC + 2 * D, 0.5f, WSP(bf16_t, OFF_YC)};
          gemm_phase(lds, DFF, S, E, 0); }
        group_barrier(xbar.bar, bid & 7);
        { const KArgP q = kargs();
          prep_phase(q->out, WSP(float, OFF_HC), nullptr, WSP(float, OFF_HC), nullptr, WSP(bf16_t, OFF_YC), true,
                     WSP(bf16_t, OFF_A), q->norm_w + (l * 3 + 1) * D, WSP(float, OFF_MOD) + (size_t)l * 17 * NMODC, 3, 4, true); }
        GRID_SYNC();
        { const KArgP q = kargs();
          SchedIn S{G, bid, (const char*)WSP(bf16_t, OFF_A), (const char*)(WSP(bf16_t, OFF_WIN) + (size_t)l * INC * D), (size_t)256 * D * 2};
          { const int t = fresh_tid(); *(LAS f32x4*)(lds + 131072 + t * 16) = *(const f32x4*)(WSP(float, OFF_ROPE) + t * 4); __syncthreads(); }
          EpiIn E{WSP(bf16_t, OFF_Q), WSP(bf16_t, OFF_KB), WSP(bf16_t, OFF_VT), WSP(bf16_t, OFF_EW), q->q_norm_w + l * 64, q->k_norm_w + l * 64, (const LAS float*)(lds + 131072)};
          gemm_phase(lds, D, S, E, stagger_ticks(1440, bid, 16)); }
        GRID_SYNC();
        {
            const KArgP q = kargs();
            const float lam_init = 0.8f - 0.6f * __expf(-0.3f * (float)l);
            const float* lq = q->lambda_qk + l * 256; const int lane = fresh_tid() & 63;
            const float sa = wave_sum(lq[lane] * lq[64 + lane], lane), sb = wave_sum(lq[128 + lane] * lq[192 + lane], lane);
            const float lam = uniformf(__expf(sa) - __expf(sb) + lam_init);
            const float mq = wave_max(fabsf(q->q_norm_w[l * 64 + lane]), lane), mk = wave_max(fabsf(q->k_norm_w[l * 64 + lane]), lane);
            const float negM = uniformf(-(8.0f * LOG2E * mq * mk));
            const float post_scale = uniformf(lam_init);
            const int n_ctx = lastl ? 0 : 64;
            const int n_items = 512 + n_ctx;
            { const int rpw = lastl ? (NLAT / 256) : (NROWS / 256); ew_rows(WSP(bf16_t, OFF_EW), WSP(bf16_t, OFF_A), q->conv_w + l * 768, bid * rpw, rpw); }
            for (int rep = 0; rep < REP_MIX; ++rep)
            for (int item = bid; item < n_items; item += G) {
                if (item < 512 + n_ctx) {
                    int b, h, qrow0, key0, nkeys;
                    if (item < 512) { const int u = ((item & 7) << 6) + ((item >> 8) << 5) + ((item & 255) >> 3);
                        b = u >> 5; h = (u >> 3) & 3; qrow0 = b * SEQ + (u & 7) * 256; key0 = 0; nkeys = NKEYS; }
                    else { const int it = item - 512; b = it >> 2; h = it & 3; qrow0 = NLAT + b * LCTX; key0 = SEQ; nkeys = LCTX; }
                    attn_item(lds, WSP(bf16_t, OFF_Q), WSP(bf16_t, OFF_KB), WSP(bf16_t, OFF_VT), WSP(bf16_t, OFF_A), b, h, qrow0, key0, nkeys, lam, negM, q->subln_w + l * 128, post_scale);
                }
            }
        }
        GRID_SYNC();
        const int nMr = lastl ? 128 : 144;
        { const KArgP q = kargs();
          SchedR S{bid, !lastl, (const char*)WSP(bf16_t, OFF_A), (const char*)(WSP(bf16_t, OFF_WOUT) + (size_t)l * D * D), (size_t)256 * D * 2, 16};
          EpiResid E{q->out, WSP(float, OFF_HC), q->out, WSP(float, OFF_HC), WSP(float, OFF_MOD) + (size_t)l * 17 * NMODC + 5 * D, 1.0f, WSP(bf16_t, OFF_YC)};
          gemm_phase(lds, D, S, E, 0); }
        group_barrier(xbar.bar, bid & 7);
        { const KArgP q = kargs();
          prep_phase(q->out, WSP(float, OFF_HC), nullptr, WSP(float, OFF_HC), nullptr, WSP(bf16_t, OFF_YC), !lastl,
                     WSP(bf16_t, OFF_A), q->norm_w + (l * 3 + 2) * D, WSP(float, OFF_MOD) + (size_t)l * 17 * NMODC, 6, 7, !lastl); }
        GRID_SYNC();
        { const KArgP q = kargs();
          Sched1 S{nMr, 22, G, bid, (const char*)WSP(bf16_t, OFF_A), (const char*)(WSP(bf16_t, OFF_WGU) + (size_t)(l * 2 + 1) * NGU * D), (size_t)256 * D * 2, 16}; EpiSwiGLU E{WSP(bf16_t, OFF_HID)};
          gemm_phase(lds, D, S, E, stagger_ticks(S.nM * 22, bid, 16)); }
        GRID_SYNC();
        if (!lastl) {
          const KArgP q = kargs();
          SchedR S{bid, true, (const char*)WSP(bf16_t, OFF_HID), (const char*)(WSP(bf16_t, OFF_WDN) + (size_t)(l * 2 + 1) * D * DFF), (size_t)256 * DFF * 2, 44};
          EpiResid E{q->out, WSP(float, OFF_HC), q->out, WSP(float, OFF_HC), WSP(float, OFF_MOD) + (size_t)l * 17 * NMODC + 8 * D, 0.5f, WSP(bf16_t, OFF_YC)};
          gemm_phase(lds, DFF, S, E, 0);
          group_barrier(xbar.bar, bid & 7);
        } else {
          const KArgP q = kargs();
          Sched1 S{128, 4, G, bid, (const char*)WSP(bf16_t, OFF_HID), (const char*)(WSP(bf16_t, OFF_WDN) + (size_t)(l * 2 + 1) * D * DFF), (size_t)256 * DFF * 2, 44};
          EpiResid E{q->out, WSP(float, OFF_HC), q->out, WSP(float, OFF_HC), WSP(float, OFF_MOD) + (size_t)l * 17 * NMODC + 8 * D, 0.5f, nullptr};
          gemm_phase(lds, DFF, S, E, 0);
        }
    }
#undef WSP
}

extern "C" void kernel_launch(void* const* d_in, const int* in_sizes, int n_in, void* d_out, int out_size, void* d_ws, size_t ws_size, hipStream_t stream) {
    static int grid_blocks = 0;
    if (!grid_blocks) {
        int dev = 0, cus = 0, per_cu = 0;
        hipGetDevice(&dev);
        hipDeviceGetAttribute(&cus, hipDeviceAttributeMultiprocessorCount, dev);
        hipFuncSetAttribute((const void*)hymba_mega, hipFuncAttributeMaxDynamicSharedMemorySize, LDS_BYTES);
        hipOccupancyMaxActiveBlocksPerMultiprocessor(&per_cu, (const void*)hymba_mega, 512, LDS_BYTES);
        if (per_cu < 1) per_cu = 1;
        if (per_cu > 1) per_cu = 1;
        grid_blocks = 256;
        if (ws_size < WS_END) fprintf(stderr, "kernel_launch: workspace too small: %zu < %zu\n", ws_size, (size_t)WS_END);
    }
    Params p{};
    p.x = (const float*)d_in[0]; p.c = (const float*)d_in[1]; p.ctx = (const float*)d_in[2]; p.c_ctx = (const float*)d_in[3];
    p.norm_w = (const float*)d_in[4]; p.w_mod = (const float*)d_in[5]; p.b_mod = (const float*)d_in[6];
    p.w_gu1 = (const float*)d_in[7]; p.w_dn1 = (const float*)d_in[8]; p.w_gu2 = (const float*)d_in[9]; p.w_dn2 = (const float*)d_in[10];
    p.w_in = (const float*)d_in[11]; p.w_out = (const float*)d_in[12]; p.q_norm_w = (const float*)d_in[13]; p.k_norm_w = (const float*)d_in[14];
    p.lambda_qk = (const float*)d_in[15]; p.subln_w = (const float*)d_in[16]; p.conv_w = (const float*)d_in[17]; p.pool_w = (const float*)d_in[18]; p.pool_scale = (const float*)d_in[19];
    p.out = (float*)d_out; p.ws = (unsigned char*)d_ws;
    (void)hipMemsetAsync((unsigned char*)d_ws + OFF_BAR, 0, 32768, stream);
    void* args[] = {&p};
    hipError_t e = hipLaunchCooperativeKernel((const void*)hymba_mega, dim3(grid_blocks), dim3(512), args, LDS_BYTES, stream);
    if (e != hipSuccess) fprintf(stderr, "cooperative launch failed: %s (grid %d)\n", hipGetErrorString(e), grid_blocks);
}
```

```cpp
#include <hip/hip_runtime.h>
#include <hip/hip_cooperative_groups.h>
#include <cstdio>
namespace cg = cooperative_groups;

#define LAS __attribute__((address_space(3)))
typedef unsigned short bf16_t;
typedef short bf16x8 __attribute__((ext_vector_type(8)));
typedef float f32x4 __attribute__((ext_vector_type(4)));
typedef float f32x16 __attribute__((ext_vector_type(16)));
typedef unsigned u32x4 __attribute__((ext_vector_type(4)));
typedef unsigned u32x2 __attribute__((ext_vector_type(2)));

constexpr int D = 1024, NB = 16, SEQ = 2048, LCTX = 256, NLAT = NB * SEQ, NCTX = NB * LCTX, NROWS = NLAT + NCTX;
constexpr int DFF = 2816, NGU = 2 * DFF, INC = 2560, NKEYS = SEQ + LCTX, DEPTH = 4, NMODC = 9 * D;
constexpr int LDS_BYTES = 131072 + 8192 + 16;
constexpr float LOG2E = 1.4426950408889634f;
#ifndef REP_SYNC
#define REP_SYNC 1
#endif
#ifndef REP_PREP
#define REP_PREP 1
#endif
#ifndef REP_MIX
#define REP_MIX 1
#endif
#ifndef REP_P0
#define REP_P0 1
#endif
#define GRID_SYNC() do { for (int _r = 0; _r < REP_SYNC; ++_r) xcd_barrier(xbar); } while (0)

constexpr size_t OFF_WGU = 0;
constexpr size_t OFF_WDN = OFF_WGU + (size_t)8 * NGU * D * 2;
constexpr size_t OFF_WIN = OFF_WDN + (size_t)8 * D * DFF * 2;
constexpr size_t OFF_WOUT = OFF_WIN + (size_t)4 * INC * D * 2;
constexpr size_t OFF_MOD = OFF_WOUT + (size_t)4 * D * D * 2;
constexpr size_t OFF_ROPE = OFF_MOD + (size_t)4 * 17 * NMODC * 4;
constexpr size_t OFF_HC = OFF_ROPE + 8192;
constexpr size_t OFF_A = OFF_HC + (size_t)NCTX * D * 4;
constexpr size_t OFF_HID = OFF_A + (size_t)NROWS * D * 2;
constexpr size_t OFF_Q = OFF_HID;
constexpr size_t OFF_KB = OFF_Q + (size_t)NROWS * 512 * 2;
constexpr size_t OFF_VT = OFF_KB + (size_t)NROWS * 512 * 2;
constexpr size_t OFF_EW = OFF_VT + (size_t)NROWS * 512 * 2;
constexpr size_t OFF_Y0 = OFF_HID + (size_t)NROWS * DFF * 2;
constexpr size_t OFF_YC = OFF_Y0;
constexpr size_t OFF_BAR = OFF_YC + (size_t)3 * NCTX * D * 2;
constexpr size_t WS_END = OFF_BAR + 16384;
static_assert(OFF_EW + (size_t)NROWS * 1024 * 2 <= OFF_BAR, "alias region");

struct Params {
    const float *x, *c, *ctx, *c_ctx, *norm_w, *w_mod, *b_mod, *w_gu1, *w_dn1, *w_gu2, *w_dn2, *w_in, *w_out, *q_norm_w, *k_norm_w, *lambda_qk, *subln_w, *conv_w, *pool_w, *pool_scale;
    float* out; unsigned char* ws;
};

typedef const Params __attribute__((address_space(4)))* KArgP;
__device__ __forceinline__ KArgP kargs() { KArgP q = (KArgP)__builtin_amdgcn_kernarg_segment_ptr(); asm volatile("" : "+s"(q)); return q; }
__device__ __forceinline__ unsigned cvt_pk_bf16(float lo, float hi) { unsigned r; asm volatile("v_cvt_pk_bf16_f32 %0, %1, %2" : "=v"(r) : "v"(lo), "v"(hi)); return r; }
__device__ __forceinline__ int fresh_tid() { int t = threadIdx.x; asm volatile("" : "+v"(t)); return t; }
__device__ __forceinline__ float uniformf(float v) { return __int_as_float(__builtin_amdgcn_readfirstlane(__float_as_int(v))); }
__device__ __forceinline__ float bf_lo(unsigned w) { return __uint_as_float(w << 16); }
__device__ __forceinline__ float bf_hi(unsigned w) { return __uint_as_float(w & 0xffff0000u); }
__device__ __forceinline__ float shx(float v, int mask, int lane) { return __int_as_float(__builtin_amdgcn_ds_bpermute((lane ^ mask) << 2, __float_as_int(v))); }
__device__ __forceinline__ float wave_sum(float v, int lane) {
#pragma unroll
    for (int o = 32; o >= 1; o >>= 1) v += shx(v, o, lane);
    return v;
}
__device__ __forceinline__ float wave_max(float v, int lane) {
#pragma unroll
    for (int o = 32; o >= 1; o >>= 1) v = fmaxf(v, shx(v, o, lane));
    return v;
}

constexpr int BM = 256, BK = 64, HALF = 128, HTB = HALF * BK * 2;
__device__ __forceinline__ int lds_byte(int r, int c) { const int st = (r >> 4) * 2 + (c >> 5), rr = r & 15, cc = c & 31, ob = rr * 64 + cc * 2; return st * 1024 + (ob ^ (((ob >> 9) & 1) << 5)); }
__device__ __forceinline__ void stage_rc(int b, int& R, int& C) { const int st = b / 1024, sb = b % 1024, swz = sb ^ (((sb >> 9) & 1) << 5); R = (st >> 1) * 16 + swz / 64; C = (st & 1) * 32 + (swz % 64) / 2; }

struct GUnit { int pm, pn, kind, nt; const char* a; const char* b; };

__device__ __forceinline__ int unit_index(int i, int c_, int U) {
    int c = c_; asm volatile("" : "+s"(c));
    const int x = c & 7, off = c >> 3;
    const int R = (U + 255) >> 8, nx = (U - ((R - 1) << 8)) >> 5;
    const int start = (x < nx) ? x * R * 32 : nx * R * 32 + (x - nx) * (R - 1) * 32;
    const int mine = (x < nx) ? R : R - 1;
    return (i < mine) ? start + i * 32 + off : -1;
}
__device__ __forceinline__ void tile_of(int wgid, int nM, int nN, int& pm, int& pn) {
    const int nig = 8 * nN, gid = wgid / nig, fm = gid * 8, gsz = (nM - fm) < 8 ? (nM - fm) : 8;
    pm = fm + ((wgid % nig) % gsz); pn = (wgid % nig) / gsz;
}
__device__ __forceinline__ int stagger_ticks(int total_units, int c_, int nt) {
    int c = c_; asm volatile("" : "+s"(c));
    const int x = c & 7;
    const int R = (total_units + 255) >> 8, nx = (total_units - ((R - 1) << 8)) >> 5;
    if (x < nx || nx == 8) return 0;
    return (int)((float)(x - nx + 1) * (float)(nt * 140) * __builtin_amdgcn_rcpf((float)(8 - nx + 1)));
}
__device__ __forceinline__ void stagger_wait(int ticks) {
    if (ticks <= 0) return;
    const unsigned long long t0 = __builtin_amdgcn_s_memrealtime();
    while ((long long)(__builtin_amdgcn_s_memrealtime() - t0) < (long long)ticks) __builtin_amdgcn_s_sleep(16);
}
struct Sched1 {
    int nM, nN, G, c; const char* A; const char* Bt; size_t tstep; int nt;
    __device__ __forceinline__ bool next(int i, GUnit& u) const {
        const int L = unit_index(i, c, nM * nN); if (L < 0) return false;
        tile_of(L, nM, nN, u.pm, u.pn); u.kind = 0; u.nt = nt; u.a = A + (size_t)u.pm * tstep; u.b = Bt + (size_t)u.pn * tstep; return true;
    }
};
struct SchedIn {
    int G, c; const char* A; const char* Win; size_t tstep;
    __device__ __forceinline__ bool next(int i, GUnit& u) const {
        const int L = unit_index(i, c, 1440);
        if (L < 0) return false;
        u.nt = 16;
        if (L < 1152) { tile_of(L, 144, 8, u.pm, u.pn); u.kind = 0; u.a = A + (size_t)u.pm * tstep; u.b = Win + (size_t)u.pn * tstep; return true; }
        if (L < 1440) { tile_of(L - 1152, 2, 144, u.pm, u.pn); u.kind = 1; u.a = Win + (size_t)(8 + u.pm) * tstep; u.b = A + (size_t)u.pn * tstep; return true; }
        return false;
    }
};

struct SchedR {
    int c; bool has_ctx; const char* A; const char* Bt; size_t tstep; int NT;
    __device__ __forceinline__ bool next(int i, GUnit& u) const {
        if (i < 2) { const int L = unit_index(i, c, 512); tile_of(L, 128, 4, u.pm, u.pn); u.kind = 0; u.nt = NT; u.a = A + (size_t)u.pm * tstep; u.b = Bt + (size_t)u.pn * tstep; return true; }
        if (i == 2 && has_ctx) {
            int cc = c; asm volatile("" : "+s"(cc));
            const int Lc = (cc & 7) * 32 + (cc >> 3), ct = Lc >> 2, sp = Lc & 3;
            u.pm = 128 + (ct >> 2); u.pn = ct & 3; u.kind = sp;
            int ks;
            if (NT == 44) { ks = sp * 12 - (sp == 3 ? 2 : 0); u.nt = (sp < 2) ? 12 : 10; } else { ks = sp * (NT >> 2); u.nt = NT >> 2; }
            u.a = A + (size_t)u.pm * tstep + (size_t)ks * 128; u.b = Bt + (size_t)u.pn * tstep + (size_t)ks * 128; return true;
        }
        return false;
    }
};

struct EpiSwiGLU {
    bf16_t* hid;
    __device__ __forceinline__ void operator()(const f32x4 (&acc)[2][2][4][2], const GUnit& u, int wr, int wc, int fr, int fq) const {
        const int row0 = u.pm * BM + wr * 64 + fr;
        const int col0 = u.pn * 128 + wc * 32 + 8 * fq;
#pragma unroll
        for (int ai = 0; ai < 2; ++ai)
#pragma unroll
            for (int m = 0; m < 4; ++m) {
                float v[8];
#pragma unroll
                for (int n = 0; n < 2; ++n)
#pragma unroll
                    for (int j = 0; j < 4; ++j) {
                        const float g = acc[ai][0][m][n][j], uu = acc[ai][1][m][n][j];
                        const float sg = g * __builtin_amdgcn_rcpf(1.0f + __builtin_amdgcn_exp2f(-g * LOG2E));
                        v[n * 4 + j] = sg * uu;
                    }
                u32x4 w; w.x = cvt_pk_bf16(v[0], v[1]); w.y = cvt_pk_bf16(v[2], v[3]); w.z = cvt_pk_bf16(v[4], v[5]); w.w = cvt_pk_bf16(v[6], v[7]);
                *(u32x4*)(hid + (size_t)(row0 + ai * HALF + m * 16) * DFF + col0) = w;
            }
    }
};
struct EpiResid {
    const float* src_lat; const float* src_ctx; float* dst_lat; float* dst_ctx; const float* gate; float coef; bf16_t* Yc;
    __device__ __forceinline__ void operator()(const f32x4 (&acc)[2][2][4][2], const GUnit& u, int wr, int wc, int fr, int fq) const {
        if (u.kind != 0) {
            const int pmc = u.pm - 128; const int colc = u.pn * BM + wc * 32 + 4 * fq;
            bf16_t* yb = Yc + ((size_t)(u.kind - 1) * NCTX + (size_t)pmc * 256) * D;
            f32x4 gq[2][2];
#pragma unroll
            for (int bj = 0; bj < 2; ++bj)
#pragma unroll
                for (int n = 0; n < 2; ++n) gq[bj][n] = *(const f32x4*)(gate + (size_t)16 * NMODC + colc + bj * HALF + n * 16) * coef;
#pragma unroll
            for (int ai = 0; ai < 2; ++ai)
#pragma unroll
                for (int m = 0; m < 4; ++m) {
                    bf16_t* rowp = yb + (size_t)(wr * 64 + fr + ai * HALF + m * 16) * D + colc;
#pragma unroll
                    for (int bj = 0; bj < 2; ++bj)
#pragma unroll
                        for (int n = 0; n < 2; ++n) {
                            const f32x4 a = gq[bj][n] * acc[ai][bj][m][n]; u32x2 w; w.x = cvt_pk_bf16(a[0], a[1]); w.y = cvt_pk_bf16(a[2], a[3]);
                            *(u32x2*)(rowp + bj * HALF + n * 16) = w;
                        }
                }
            return;
        }
        const int pm = u.pm; const bool lat = pm < 128;
        const float* sp = lat ? src_lat + (size_t)pm * 256 * D : src_ctx + (size_t)(pm - 128) * 256 * D;
        float* dp = lat ? dst_lat + (size_t)pm * 256 * D : dst_ctx + (size_t)(pm - 128) * 256 * D;
        const int modrow = lat ? (pm >> 3) : 16;
        const int col0 = u.pn * BM + wc * 32 + 4 * fq;
        f32x4 gv[2][2];
#pragma unroll
        for (int bj = 0; bj < 2; ++bj)
#pragma unroll
            for (int n = 0; n < 2; ++n) gv[bj][n] = *(const f32x4*)(gate + (size_t)modrow * NMODC + col0 + bj * HALF + n * 16) * coef;
#pragma unroll
        for (int ai = 0; ai < 2; ++ai)
#pragma unroll
            for (int mp = 0; mp < 2; ++mp) {
                f32x4 rv[2][2][2];
#pragma unroll
                for (int mm = 0; mm < 2; ++mm)
#pragma unroll
                    for (int bj = 0; bj < 2; ++bj)
#pragma unroll
                        for (int n = 0; n < 2; ++n)
                            rv[mm][bj][n] = *(const f32x4*)(sp + (size_t)(wr * 64 + fr + ai * HALF + (mp * 2 + mm) * 16) * D + col0 + bj * HALF + n * 16);
#pragma unroll
                for (int mm = 0; mm < 2; ++mm)
#pragma unroll
                    for (int bj = 0; bj < 2; ++bj)
#pragma unroll
                        for (int n = 0; n < 2; ++n)
                            *(f32x4*)(dp + (size_t)(wr * 64 + fr + ai * HALF + (mp * 2 + mm) * 16) * D + col0 + bj * HALF + n * 16) = rv[mm][bj][n] + gv[bj][n] * acc[ai][bj][mp * 2 + mm][n];
            }
    }
};
struct EpiY {
    bf16_t* Y0; bf16_t* Yc; const float* gate; float coef;
    __device__ __forceinline__ void operator()(const f32x4 (&acc)[2][2][4][2], const GUnit& u, int wr, int wc, int fr_, int fq_) const {
        int fr = fr_, fq = fq_; asm volatile("" : "+v"(fr), "+v"(fq));
        const int pm = u.pm; const int modrow = (pm < 128) ? (pm >> 3) : 16;
        const int col0 = u.pn * BM + wc * 32 + 4 * fq;
        bf16_t* yb = (u.kind == 0) ? Y0 + (size_t)pm * 256 * D : Yc + ((size_t)(u.kind - 1) * NCTX + (size_t)(pm - 128) * 256) * D;
        f32x4 gv[2][2];
#pragma unroll
        for (int bj = 0; bj < 2; ++bj)
#pragma unroll
            for (int n = 0; n < 2; ++n) gv[bj][n] = *(const f32x4*)(gate + (size_t)modrow * NMODC + col0 + bj * HALF + n * 16) * coef;
#pragma unroll
        for (int ai = 0; ai < 2; ++ai)
#pragma unroll
            for (int m = 0; m < 4; ++m) {
                bf16_t* rowp = yb + (size_t)(wr * 64 + fr + ai * HALF + m * 16) * D + col0;
#pragma unroll
                for (int bj = 0; bj < 2; ++bj)
#pragma unroll
                    for (int n = 0; n < 2; ++n) {
                        const f32x4 a = gv[bj][n] * acc[ai][bj][m][n]; u32x2 w; w.x = cvt_pk_bf16(a[0], a[1]); w.y = cvt_pk_bf16(a[2], a[3]);
                        *(u32x2*)(rowp + bj * HALF + n * 16) = w;
                    }
            }
    }
};
struct EpiIn {
    bf16_t *Q, *KB, *VT, *EW; const float *qw, *kw; const LAS float* ropeL;
    __device__ __forceinline__ void operator()(const f32x4 (&acc)[2][2][4][2], const GUnit& u, int wr, int wc, int fr, int fq) const {
        const int pm = u.pm, pn = u.pn;
        if (u.kind == 1) {
            int b, key0; if (pn < 128) { b = pn >> 3; key0 = (pn & 7) * 256; } else { b = pn - 128; key0 = SEQ; }
#pragma unroll
            for (int ai = 0; ai < 2; ++ai)
#pragma unroll
                for (int m = 0; m < 4; ++m) {
                    const int vcol = pm * 256 + ai * HALF + wr * 64 + m * 16 + fr;
                    bf16_t* rowp = VT + (size_t)(b * 512 + vcol) * NKEYS + key0 + wc * 32 + 4 * fq;
#pragma unroll
                    for (int bj = 0; bj < 2; ++bj)
#pragma unroll
                        for (int n = 0; n < 2; ++n) {
                            const f32x4 a = acc[ai][bj][m][n]; u32x2 w; w.x = cvt_pk_bf16(a[0], a[1]); w.y = cvt_pk_bf16(a[2], a[3]);
                            *(u32x2*)(rowp + bj * HALF + n * 16) = w;
                        }
                }
            return;
        }
        const bool lat = pm < 128;
        const int rl0 = wr * 64 + fr;
        if (pn >= 4) {
#pragma unroll
            for (int ai = 0; ai < 2; ++ai)
#pragma unroll
                for (int m = 0; m < 4; ++m) {
                    bf16_t* rowp = EW + (size_t)(pm * 256 + rl0 + ai * HALF + m * 16) * 1024 + (pn - 4) * 256 + wc * 64 + 4 * fq;
#pragma unroll
                    for (int bj = 0; bj < 2; ++bj)
#pragma unroll
                        for (int n = 0; n < 2; ++n) {
                            const f32x4 a = acc[ai][bj][m][n]; u32x2 w; w.x = cvt_pk_bf16(a[0], a[1]); w.y = cvt_pk_bf16(a[2], a[3]);
                            *(u32x2*)(rowp + bj * 32 + n * 16) = w;
                        }
                }
            return;
        }
        const bool isq = pn < 2;
        const float* w = isq ? qw : kw;
        f32x4 wv[2][2];
#pragma unroll
        for (int bj = 0; bj < 2; ++bj)
#pragma unroll
            for (int n = 0; n < 2; ++n) wv[bj][n] = *(const f32x4*)(w + bj * 32 + n * 16 + 4 * fq);
        const float osc = isq ? 0.125f * LOG2E : 1.0f;
        bf16_t* dst; size_t drow0;
        if (isq) { dst = Q; drow0 = (size_t)pm * 256; }
        else { dst = KB; drow0 = lat ? (size_t)(pm >> 3) * NKEYS + (size_t)(pm & 7) * 256 : (size_t)(pm - 128) * NKEYS + SEQ; }
        const int colb = (pn & 1) * 256 + wc * 64 + 4 * fq;
#pragma unroll
        for (int ai = 0; ai < 2; ++ai)
#pragma unroll
            for (int m = 0; m < 4; ++m) {
                const int rl = rl0 + ai * HALF + m * 16;
                float ss = 0.f;
#pragma unroll
                for (int bj = 0; bj < 2; ++bj)
#pragma unroll
                    for (int n = 0; n < 2; ++n) { const f32x4 a = acc[ai][bj][m][n]; ss += a[0] * a[0] + a[1] * a[1] + a[2] * a[2] + a[3] * a[3]; }
                ss += shx(ss, 16, fq * 16 + fr); ss += shx(ss, 32, fq * 16 + fr);
                const float rs = rsqrtf(ss * (1.0f / 64.0f) + 1e-6f) * osc;
                f32x4 y[2][2];
#pragma unroll
                for (int bj = 0; bj < 2; ++bj)
#pragma unroll
                    for (int n = 0; n < 2; ++n) y[bj][n] = acc[ai][bj][m][n] * rs * wv[bj][n];
                if (lat) {
                    const int s = (pm & 7) * 256 + rl;
#pragma unroll
                    for (int bj = 0; bj < 2; ++bj) {
                        const int pos = bj ? (s & 63) : (s >> 6);
                        const f32x4 c4 = *(const LAS f32x4*)(ropeL + pos * 16 + 4 * fq), s4 = *(const LAS f32x4*)(ropeL + 1024 + pos * 16 + 4 * fq);
                        const f32x4 x1 = y[bj][0], x2 = y[bj][1];
                        y[bj][0] = x1 * c4 - x2 * s4; y[bj][1] = x1 * s4 + x2 * c4;
                    }
                }
                bf16_t* rowp = dst + (drow0 + rl) * 512 + colb;
#pragma unroll
                for (int bj = 0; bj < 2; ++bj)
#pragma unroll
                    for (int n = 0; n < 2; ++n) {
                        const f32x4 a = y[bj][n]; u32x2 ww; ww.x = cvt_pk_bf16(a[0], a[1]); ww.y = cvt_pk_bf16(a[2], a[3]);
                        *(u32x2*)(rowp + bj * 32 + n * 16) = ww;
                    }
            }
    }
};

template <class Sched, class Epi>
__device__ __forceinline__ void gemm_phase(LAS unsigned char* lds, const int K, const Sched& S, const Epi& E, const int delay_ticks) {
    const int tid = fresh_tid(), wid = __builtin_amdgcn_readfirstlane(tid >> 6), lane = tid & 63, wr = wid >> 2, wc = wid & 3, fr = lane & 15, fq = lane >> 4;
    unsigned voff[2];
#pragma unroll
    for (int i = 0; i < 2; ++i) { int R, C; stage_rc(tid * 16 + i * 8192, R, C); voff[i] = (unsigned)(R * K + C) * 2u; }
    const size_t kstep = (size_t)(BK * 2);
    const size_t hstep = (size_t)HALF * K * 2;
    const unsigned ldsw = (unsigned)wid * 1024u;
    const int aoff = lds_byte(wr * 64 + fr, fq * 8), boff = lds_byte(wc * 32 + fr, fq * 8);
#define PG8_SA(b, h) (((b) * 2 + (h)) * HTB)
#define PG8_SB(b, h) ((4 + (b) * 2 + (h)) * HTB)
#define PG8_STAGE(bufoff, gbase) do { _Pragma("unroll") for (int _i = 0; _i < 2; ++_i) \
        __builtin_amdgcn_global_load_lds((const unsigned*)((const char*)(gbase) + voff[_i]), (LAS unsigned*)(lds + (bufoff) + ldsw + _i * 8192), 16, 0, 0); } while (0)
#define PG8_LDA(dst, b, h) do { _Pragma("unroll") for (int m = 0; m < 4; ++m) _Pragma("unroll") for (int k = 0; k < 2; ++k) dst[m][k] = *(const LAS bf16x8*)(lds + PG8_SA(b, h) + aoff + m * 2048 + k * 1024); } while (0)
#define PG8_LDB(dst, b, h) do { _Pragma("unroll") for (int n = 0; n < 2; ++n) _Pragma("unroll") for (int k = 0; k < 2; ++k) dst[n][k] = *(const LAS bf16x8*)(lds + PG8_SB(b, h) + boff + n * 2048 + k * 1024); } while (0)
#define PG8_MMA(ai, bj, At, Bt) do { __builtin_amdgcn_s_setprio(1); _Pragma("unroll") for (int m = 0; m < 4; ++m) _Pragma("unroll") for (int n = 0; n < 2; ++n) _Pragma("unroll") for (int k = 0; k < 2; ++k) \
        acc[ai][bj][m][n] = __builtin_amdgcn_mfma_f32_16x16x32_bf16(Bt[n][k], At[m][k], acc[ai][bj][m][n], 0, 0, 0); __builtin_amdgcn_s_setprio(0); } while (0)
#define PG8_WAIT_V(n) asm volatile("s_waitcnt vmcnt(" #n ")" ::: "memory")
#define PG8_WAIT_L(n) asm volatile("s_waitcnt lgkmcnt(" #n ")" ::: "memory")
#define PG8_BAR __builtin_amdgcn_s_barrier()
#define PG8_SCHED __builtin_amdgcn_sched_barrier(0)
    GUnit cur, nxt; int ui = 0;
    if (!S.next(0, cur)) return;
    (void)delay_ticks;
    f32x4 acc[2][2][4][2];
#pragma unroll
    for (int a = 0; a < 2; ++a)
#pragma unroll
        for (int b = 0; b < 2; ++b)
#pragma unroll
            for (int m = 0; m < 4; ++m)
#pragma unroll
                for (int n = 0; n < 2; ++n) acc[a][b][m][n] = (f32x4){0.f, 0.f, 0.f, 0.f};
    bf16x8 At[4][2], B0[2][2], B1[2][2];
    const char* cA = cur.a; const char* cB = cur.b;
    PG8_STAGE(PG8_SB(0, 0), cB); PG8_STAGE(PG8_SA(0, 0), cA); PG8_STAGE(PG8_SB(0, 1), cB + hstep); PG8_STAGE(PG8_SA(0, 1), cA + hstep);
    if (wr == 1) PG8_BAR;
    PG8_WAIT_V(4); PG8_BAR;
    PG8_STAGE(PG8_SB(1, 0), cB + kstep); PG8_STAGE(PG8_SA(1, 0), cA + kstep); PG8_STAGE(PG8_SB(1, 1), cB + hstep + kstep);
    PG8_WAIT_V(6); PG8_BAR;
    for (;;) {
        const bool has_next = S.next(ui + 1, nxt);
        const char* nA = has_next ? nxt.a : cA; const char* nB = has_next ? nxt.b : cB;
        const int cnt = cur.nt;
        for (int t = 0; t < cnt; t += 2) {
            const bool last = (t == cnt - 2);
            const char* a1 = cA + (size_t)(t + 1) * kstep;
            const char* a2 = last ? nA : cA + (size_t)(t + 2) * kstep; const char* b2 = last ? nB : cB + (size_t)(t + 2) * kstep;
            const char* a3 = a2 + kstep; const char* b3 = b2 + kstep;
            PG8_LDB(B0, 0, 0); PG8_SCHED; PG8_LDA(At, 0, 0); PG8_STAGE(PG8_SA(1, 1), a1 + hstep);
            PG8_WAIT_L(8); PG8_BAR; PG8_WAIT_L(0); PG8_MMA(0, 0, At, B0); PG8_BAR; PG8_SCHED;
            PG8_LDB(B1, 0, 1); PG8_STAGE(PG8_SB(0, 0), b2);
            PG8_BAR; PG8_WAIT_L(0); PG8_MMA(0, 1, At, B1); PG8_BAR;
            PG8_LDA(At, 0, 1); PG8_STAGE(PG8_SA(0, 0), a2);
            PG8_BAR; PG8_WAIT_L(0); PG8_MMA(1, 0, At, B0); PG8_BAR; PG8_SCHED;
            PG8_STAGE(PG8_SB(0, 1), b2 + hstep);
            PG8_WAIT_V(6); PG8_BAR; PG8_MMA(1, 1, At, B1); PG8_BAR;
            PG8_LDB(B0, 1, 0); PG8_SCHED; PG8_LDA(At, 1, 0); PG8_STAGE(PG8_SA(0, 1), a2 + hstep);
            PG8_WAIT_L(8); PG8_BAR; PG8_WAIT_L(0); PG8_MMA(0, 0, At, B0); PG8_BAR; PG8_SCHED;
            PG8_LDB(B1, 1, 1); PG8_STAGE(PG8_SB(1, 0), b3);
            PG8_BAR; PG8_WAIT_L(0); PG8_MMA(0, 1, At, B1); PG8_BAR;
            PG8_LDA(At, 1, 1); PG8_STAGE(PG8_SA(1, 0), a3);
            PG8_BAR; PG8_WAIT_L(0); PG8_MMA(1, 0, At, B0); PG8_BAR; PG8_SCHED;
            PG8_STAGE(PG8_SB(1, 1), b3 + hstep);
            PG8_WAIT_V(6); PG8_BAR; PG8_MMA(1, 1, At, B1); PG8_BAR;
        }
        E(acc, cur, wr, wc, fr, fq);
        if (!has_next) break;
#pragma unroll
        for (int a = 0; a < 2; ++a)
#pragma unroll
            for (int b = 0; b < 2; ++b)
#pragma unroll
                for (int m = 0; m < 4; ++m)
#pragma unroll
                    for (int n = 0; n < 2; ++n) acc[a][b][m][n] = (f32x4){0.f, 0.f, 0.f, 0.f};
        cur = nxt; cA = nA; cB = nB; ++ui;
    }
    PG8_WAIT_V(0);
    if (wr == 0) PG8_BAR;
    PG8_BAR;
#undef PG8_SA
#undef PG8_SB
#undef PG8_STAGE
#undef PG8_LDA
#undef PG8_LDB
#undef PG8_MMA
#undef PG8_WAIT_V
#undef PG8_WAIT_L
#undef PG8_BAR
#undef PG8_SCHED
}

__device__ __forceinline__ void mod_item(LAS unsigned char* lds, int item) {
    const KArgP pp = kargs(); const float* p_c = pp->c; const float* p_cctx = pp->c_ctx; const float* p_wmod = pp->w_mod; const float* p_bmod = pp->b_mod; unsigned char* p_ws = pp->ws;
    const int tid = fresh_tid(), lane = tid & 63, wave = tid >> 6;
    const int l = item / 72, n0 = (item % 72) * 128;
    LAS float* sil = (LAS float*)lds;
    __syncthreads();
    for (int idx = tid; idx < 17 * 1024; idx += 512) {
        const int r = idx >> 10, k = idx & 1023;
        const float v = (r < 16) ? p_c[r * 1024 + k] : p_cctx[k];
        sil[k * 20 + r] = v / (1.0f + __expf(-v));
    }
    __syncthreads();
    const int cgp = tid & 31, ksl = tid >> 5;
    f32x4 acc[17];
#pragma unroll
    for (int r = 0; r < 17; ++r) acc[r] = (f32x4){0.f, 0.f, 0.f, 0.f};
    const float* wp = p_wmod + ((size_t)l * 1024 + (size_t)ksl * 64) * NMODC + n0 + 4 * cgp;
#pragma unroll 4
    for (int kk = 0; kk < 64; ++kk) {
        const f32x4 w = *(const f32x4*)(wp + (size_t)kk * NMODC);
        const LAS float* sp = sil + (ksl * 64 + kk) * 20;
        const f32x4 s0 = *(const LAS f32x4*)(sp), s1 = *(const LAS f32x4*)(sp + 4), s2 = *(const LAS f32x4*)(sp + 8), s3 = *(const LAS f32x4*)(sp + 12);
        const float s16 = sp[16];
#pragma unroll
        for (int j = 0; j < 4; ++j) { acc[j] += w * s0[j]; acc[4 + j] += w * s1[j]; acc[8 + j] += w * s2[j]; acc[12 + j] += w * s3[j]; }
        acc[16] += w * s16;
    }
#pragma unroll
    for (int r = 0; r < 17; ++r)
#pragma unroll
        for (int j = 0; j < 4; ++j) acc[r][j] += shx(acc[r][j], 32, lane);
    __syncthreads();
    LAS float* red = (LAS float*)lds;
    if (lane < 32) {
#pragma unroll
        for (int r = 0; r < 17; ++r) *(LAS f32x4*)(red + (wave * 17 + r) * 128 + 4 * cgp) = acc[r];
    }
    __syncthreads();
    float* modp = (float*)(p_ws + OFF_MOD);
    for (int o = tid; o < 17 * 128; o += 512) {
        const int r = o >> 7, cc = o & 127;
        float s = p_bmod[l * NMODC + n0 + cc];
#pragma unroll
        for (int w = 0; w < 8; ++w) s += red[(w * 17 + r) * 128 + cc];
        modp[((size_t)l * 17 + r) * NMODC + n0 + cc] = s;
    }
    __syncthreads();
}

__device__ __forceinline__ void conv_tile(LAS unsigned char* lds, int idx) {
    const KArgP p = kargs();
    const int tid = fresh_tid();
    const float* src; bf16_t* dst; int Nsrc, K, ntile, kg, type, l;
    if (idx < 2816) { const int mat = idx / 352, rem = idx % 352; ntile = rem >> 2; kg = rem & 3; l = mat >> 1; type = 0;
        src = ((mat & 1) ? p->w_gu2 : p->w_gu1) + (size_t)l * D * NGU; Nsrc = NGU; K = D; dst = (bf16_t*)(p->ws + OFF_WGU) + (size_t)mat * NGU * D; }
    else if (idx < 2816 + 1408) { const int i2 = idx - 2816; const int mat = i2 / 176, rem = i2 % 176; ntile = rem / 11; kg = rem % 11; l = mat >> 1; type = 1;
        src = ((mat & 1) ? p->w_dn2 : p->w_dn1) + (size_t)l * DFF * D; Nsrc = D; K = DFF; dst = (bf16_t*)(p->ws + OFF_WDN) + (size_t)mat * D * DFF; }
    else if (idx < 2816 + 1408 + 640) { const int i2 = idx - 4224; l = i2 / 160; const int rem = i2 % 160; ntile = rem >> 2; kg = rem & 3; type = 2;
        src = p->w_in + (size_t)l * D * INC; Nsrc = INC; K = D; dst = (bf16_t*)(p->ws + OFF_WIN) + (size_t)l * INC * D; }
    else { const int i2 = idx - 4864; l = i2 >> 6; const int rem = i2 & 63; ntile = rem >> 2; kg = rem & 3; type = 3;
        src = p->w_out + (size_t)l * D * D; Nsrc = D; K = D; dst = (bf16_t*)(p->ws + OFF_WOUT) + (size_t)l * D * D; }
    const int n0 = ntile * 64, k0 = kg * 256;
    LAS float* tile = (LAS float*)lds;
    const int c4 = tid & 15, kk = tid >> 4;
    const int np = n0 + 4 * c4;
    int fcol;
    if (type == 0) { const int s = np & 255; fcol = (s >> 7) * DFF + 128 * (np >> 8) + 32 * ((s >> 5) & 3) + 8 * ((s >> 2) & 3) + 4 * ((s >> 4) & 1); }
    else if (type == 2) {
        if (np < 2048) { const int t8 = np >> 8, s = np & 255, R = s & 127; const int colbase = (t8 < 4) ? t8 * 256 : 1536 + (t8 - 4) * 256; fcol = colbase + 64 * (R >> 5) + 32 * (s >> 7) + (R & 31); }
        else fcol = 1024 + (np - 2048);
    } else fcol = np;
    __syncthreads();
    if (type == 3 && k0 >= 768) {
#pragma unroll 1
        for (int g = 0; g < 4; ++g)
#pragma unroll
            for (int hlf = 0; hlf < 2; ++hlf) {
                const int k = kk + 32 * hlf;
                const float* pw = p->pool_w + ((size_t)(l * 4 + g) * 64 + k) * 64;
                const float* sc = p->pool_scale + l * 256 + g * 64;
                const float* ws = src + (size_t)(768 + g * 64) * D + fcol;
                f32x4 v = (f32x4){0.f, 0.f, 0.f, 0.f};
                for (int d = 0; d < 64; ++d) v += *(const f32x4*)(ws + (size_t)d * D) * (pw[d] * sc[d]);
                LAS float* tp = tile + g * 4160 + k * 65 + 4 * c4;
                tp[0] = v[0]; tp[1] = v[1]; tp[2] = v[2]; tp[3] = v[3];
            }
    } else {
        f32x4 v[8];
#pragma unroll
        for (int q = 0; q < 8; ++q) v[q] = *(const f32x4*)(src + (size_t)(k0 + kk + 32 * q) * Nsrc + fcol);
#pragma unroll
        for (int q = 0; q < 8; ++q) {
            LAS float* tp = tile + (q >> 1) * 4160 + (kk + 32 * (q & 1)) * 65 + 4 * c4;
            tp[0] = v[q][0]; tp[1] = v[q][1]; tp[2] = v[q][2]; tp[3] = v[q][3];
        }
    }
    __syncthreads();
    const int n = tid >> 3, kseg = (tid & 7) * 8;
#pragma unroll
    for (int g = 0; g < 4; ++g) {
        float f[8];
#pragma unroll
        for (int i = 0; i < 8; ++i) f[i] = tile[g * 4160 + (kseg + i) * 65 + n];
        u32x4 w; w.x = cvt_pk_bf16(f[0], f[1]); w.y = cvt_pk_bf16(f[2], f[3]); w.z = cvt_pk_bf16(f[4], f[5]); w.w = cvt_pk_bf16(f[6], f[7]);
        *(u32x4*)(dst + (size_t)(n0 + n) * K + k0 + g * 64 + kseg) = w;
    }
}

__device__ __forceinline__ void rope_item() {
    float* cosT = (float*)(kargs()->ws + OFF_ROPE); float* sinT = cosT + 1024;
    for (int idx = threadIdx.x; idx < 1024; idx += 512) {
        const int pos = idx >> 4, f = idx & 15, fm = f & 3, fqd = f >> 2;
        double inv = (fm == 0) ? 1.0 : (fm == 1) ? 0.5623413251903491 : (fm == 2) ? 0.31622776601683794 : 0.1778279410038923;
        inv *= (fqd == 0) ? 1.0 : (fqd == 1) ? 0.1 : (fqd == 2) ? 0.01 : 0.001;
        const double a = (double)((float)pos * (float)inv);
        const double twopi = 6.283185307179586476925;
        const double nrev = __builtin_rint(a / twopi);
        const double x = a - nrev * twopi, x2 = x * x;
        double sn = 0.0, cs = 0.0, ts = x, tc = 1.0;
#pragma unroll 1
        for (int i = 0; i < 16; ++i) { cs += tc; sn += ts; tc = -tc * x2 / (double)((2 * i + 1) * (2 * i + 2)); ts = -ts * x2 / (double)((2 * i + 2) * (2 * i + 3)); }
        cosT[idx] = (float)cs; sinT[idx] = (float)sn;
    }
}

__device__ __forceinline__ void prep_rows(const float* xp, float* dp, const bf16_t* y0, const bf16_t* yc, bf16_t* ap, int n, const f32x4 (&nwv)[4], const f32x4 (&sc)[4], const f32x4 (&sh)[4], int lane) {
    for (int i = 0; i < n; ++i) {
        f32x4 x[4]; float ss = 0.f;
#pragma unroll
        for (int q = 0; q < 4; ++q) x[q] = *(const f32x4*)(xp + (size_t)i * D + 4 * lane + 256 * q);
        if (y0) {
#pragma unroll
            for (int q = 0; q < 4; ++q) { const u32x2 w = *(const u32x2*)(y0 + (size_t)i * D + 4 * lane + 256 * q); x[q] += (f32x4){bf_lo(w.x), bf_hi(w.x), bf_lo(w.y), bf_hi(w.y)}; }
        }
        if (yc) {
#pragma unroll
            for (int sp = 0; sp < 3; ++sp)
#pragma unroll
                for (int q = 0; q < 4; ++q) { const u32x2 w = *(const u32x2*)(yc + (size_t)sp * NCTX * D + (size_t)i * D + 4 * lane + 256 * q); x[q] += (f32x4){bf_lo(w.x), bf_hi(w.x), bf_lo(w.y), bf_hi(w.y)}; }
        }
#pragma unroll
        for (int q = 0; q < 4; ++q) ss += x[q][0] * x[q][0] + x[q][1] * x[q][1] + x[q][2] * x[q][2] + x[q][3] * x[q][3];
        if (dp) {
#pragma unroll
            for (int q = 0; q < 4; ++q) *(f32x4*)(dp + (size_t)i * D + 4 * lane + 256 * q) = x[q];
        }
        ss = wave_sum(ss, lane);
        const float rstd = rsqrtf(ss * (1.0f / 1024.0f) + 1e-6f);
#pragma unroll
        for (int q = 0; q < 4; ++q) {
            const f32x4 y = (x[q] * rstd * nwv[q]) * sc[q] + sh[q];
            u32x2 w; w.x = cvt_pk_bf16(y[0], y[1]); w.y = cvt_pk_bf16(y[2], y[3]);
            *(u32x2*)(ap + (size_t)i * D + 4 * lane + 256 * q) = w;
        }
    }
}
__device__ __forceinline__ void prep_phase(const float* src_lat, const float* src_ctx, float* dst_lat, float* dst_ctx, const bf16_t* Y0, const bf16_t* Yc, bool ctx_split,
                                           bf16_t* A, const float* nw, const float* modl, int shift_i, int scale_i, bool with_ctx) {
    const int tid = fresh_tid();
    const int lane = tid & 63, gw = blockIdx.x * 8 + (tid >> 6);
    f32x4 nwv[4], sc[4], sh[4];
#pragma unroll
    for (int q = 0; q < 4; ++q) nwv[q] = *(const f32x4*)(nw + 4 * lane + 256 * q);
    {
        const int row0 = gw * 16, mr = row0 >> 11;
#pragma unroll
        for (int q = 0; q < 4; ++q) {
            sc[q] = *(const f32x4*)(modl + (size_t)mr * NMODC + scale_i * 1024 + 4 * lane + 256 * q) + 1.0f;
            sh[q] = *(const f32x4*)(modl + (size_t)mr * NMODC + shift_i * 1024 + 4 * lane + 256 * q);
        }
        prep_rows(src_lat + (size_t)row0 * D, nullptr, nullptr, nullptr, A + (size_t)row0 * D, 16, nwv, sc, sh, lane);
    }
    if (with_ctx) {
        const int crow0 = gw * 2;
#pragma unroll
        for (int q = 0; q < 4; ++q) {
            sc[q] = *(const f32x4*)(modl + (size_t)16 * NMODC + scale_i * 1024 + 4 * lane + 256 * q) + 1.0f;
            sh[q] = *(const f32x4*)(modl + (size_t)16 * NMODC + shift_i * 1024 + 4 * lane + 256 * q);
        }
        prep_rows(src_ctx + (size_t)crow0 * D, ctx_split ? dst_ctx + (size_t)crow0 * D : nullptr, nullptr, ctx_split ? Yc + (size_t)crow0 * D : nullptr,
                  A + (size_t)(NLAT + crow0) * D, 2, nwv, sc, sh, lane);
    }
}

__device__ __forceinline__ void attn_item(LAS unsigned char* lds, const bf16_t* Q, const bf16_t* KB, const bf16_t* VT, bf16_t* MIX,
                                          int b, int h, int qrow0, int key0, int nkeys, float lam, float negM, const float* subw, float post_scale) {
    const int tid = fresh_tid(), lane = tid & 63, wave = tid >> 6, r = lane & 31, h2 = lane >> 5;
    f32x16 O[2][4];
#pragma unroll
    for (int i = 0; i < 2; ++i)
#pragma unroll
        for (int et = 0; et < 4; ++et)
#pragma unroll
            for (int j = 0; j < 16; ++j) O[i][et][j] = 0.f;
    float ls0 = 0.f, ls1 = 0.f;
    const char* kg = (const char*)(KB + ((size_t)(b * NKEYS + key0)) * 512 + h * 128);
    const char* vg = (const char*)(VT + ((size_t)(b * 512 + h * 128)) * NKEYS + key0);
    const int wu = __builtin_amdgcn_readfirstlane(wave);
    const int nt = nkeys >> 6;
#define ATT_STAGE(t_, bufo_) do { int ln = lane; asm volatile("" : "+v"(ln)); _Pragma("unroll") for (int _i = 0; _i < 2; ++_i) { const int pc = wu + 8 * _i; \
        const int key = pc * 4 + (ln >> 4), c = (ln & 15) ^ (key & 15); const unsigned kgo = (unsigned)(key * 1024 + c * 16); \
        const int e = pc * 8 + (ln >> 3), cv = (ln & 7) ^ ((e >> 1) & 7); const unsigned vgo = (unsigned)(e * (NKEYS * 2) + cv * 16); \
        __builtin_amdgcn_global_load_lds((const unsigned*)(kg + (size_t)(t_) * 65536 + kgo), (LAS unsigned*)(lds + (bufo_) + pc * 1024), 16, 0, 0); \
        __builtin_amdgcn_global_load_lds((const unsigned*)(vg + (size_t)(t_) * 128 + vgo), (LAS unsigned*)(lds + (bufo_) + 16384 + pc * 1024), 16, 0, 0); } } while (0)
    __syncthreads();
    {
        const char* qg = (const char*)(Q + (size_t)qrow0 * 512 + h * 128);
#pragma unroll
        for (int i = 0; i < 8; ++i) {
            const int pq = wu * 8 + i, row = pq * 4 + (lane >> 4), c = (lane & 15) ^ (row & 15);
            __builtin_amdgcn_global_load_lds((const unsigned*)(qg + (size_t)row * 1024 + c * 16), (LAS unsigned*)(lds + 65536 + pq * 1024), 16, 0, 0);
        }
    }
    ATT_STAGE(0, 0);
    asm volatile("s_waitcnt vmcnt(0)" ::: "memory");
    __syncthreads();
    const int rs = (r & 0x13) | ((r & 4) << 1) | ((r & 8) >> 1);
    const int qrow = wave * 32 + r, qx = qrow & 15;
    const int kx = rs & 15;
    const LAS unsigned char* qbase = lds + 65536 + qrow * 256;
#define SB() __builtin_amdgcn_sched_barrier(0)
#define LD_QK(i_, kb_, kf_, qf_) do { _Pragma("unroll") for (int ks = 0; ks < 4; ++ks) { \
        kf_[ks] = *(const LAS bf16x8*)(Kb + ((kb_) * 32 + rs) * 256 + ((((i_) * 8 + ks * 2 + h2) ^ kx) << 4)); \
        qf_[ks] = *(const LAS bf16x8*)(qbase + ((((i_) * 8 + ks * 2 + h2) ^ qx) << 4)); } } while (0)
#define MM_S(Sv_, kf_, qf_) do { _Pragma("unroll") for (int j = 0; j < 16; ++j) Sv_[j] = negM; \
        _Pragma("unroll") for (int ks = 0; ks < 4; ++ks) Sv_ = __builtin_amdgcn_mfma_f32_32x32x16_bf16(kf_[ks], qf_[ks], Sv_, 0, 0, 0); } while (0)
#define EXP_P(Sv_, ls_, pf_) do { float psum = 0.f; _Pragma("unroll") for (int j = 0; j < 16; ++j) { Sv_[j] = __builtin_amdgcn_exp2f(Sv_[j]); psum += Sv_[j]; } ls_ += psum; \
        _Pragma("unroll") for (int sq = 0; sq < 2; ++sq) { u32x4 w; w.x = cvt_pk_bf16(Sv_[8 * sq + 0], Sv_[8 * sq + 1]); w.y = cvt_pk_bf16(Sv_[8 * sq + 2], Sv_[8 * sq + 3]); \
            w.z = cvt_pk_bf16(Sv_[8 * sq + 4], Sv_[8 * sq + 5]); w.w = cvt_pk_bf16(Sv_[8 * sq + 6], Sv_[8 * sq + 7]); pf_[sq] = __builtin_bit_cast(bf16x8, w); } } while (0)
#define LD_V(hf_, kb_, vf_) do { _Pragma("unroll") for (int el = 0; el < 2; ++el) { const int e = ((hf_) * 2 + el) * 32 + r, ex = (e >> 1) & 7; \
        _Pragma("unroll") for (int sq = 0; sq < 2; ++sq) vf_[el][sq] = *(const LAS bf16x8*)(Vb + e * 128 + ((((kb_) * 4 + sq * 2 + h2) ^ ex) << 4)); } } while (0)
#define MM_PV(hf_, vf_) do { _Pragma("unroll") for (int el = 0; el < 2; ++el) _Pragma("unroll") for (int sq = 0; sq < 2; ++sq) { \
        O[0][(hf_) * 2 + el] = __builtin_amdgcn_mfma_f32_32x32x16_bf16(vf_[el][sq], pf0[sq], O[0][(hf_) * 2 + el], 0, 0, 0); \
        O[1][(hf_) * 2 + el] = __builtin_amdgcn_mfma_f32_32x32x16_bf16(vf_[el][sq], pf1[sq], O[1][(hf_) * 2 + el], 0, 0, 0); } } while (0)
    for (int t = 0; t < nt; ++t) {
        const bool more = (t + 1 < nt);
        if (more) ATT_STAGE(t + 1, ((t + 1) & 1) * 32768);
        const LAS unsigned char* Kb = lds + (t & 1) * 32768;
        const LAS unsigned char* Vb = Kb + 16384;
        bf16x8 kfa[4], qfa[4], va[2][2], pf0[2], pf1[2];
        f32x16 S0, S1;
#pragma unroll 1
        for (int kb = 0; kb < 2; ++kb) {
            LD_QK(0, kb, kfa, qfa);
            SB(); MM_S(S0, kfa, qfa);
            SB(); LD_QK(1, kb, kfa, qfa);
            SB(); MM_S(S1, kfa, qfa); EXP_P(S0, ls0, pf0);
            SB(); LD_V(0, kb, va); EXP_P(S1, ls1, pf1);
            SB(); MM_PV(0, va); LD_V(1, kb, va);
            SB(); MM_PV(1, va);
        }
        SB();
        asm volatile("s_waitcnt vmcnt(0)" ::: "memory");
        __syncthreads();
    }
#undef SB
#undef LD_QK
#undef MM_S
#undef EXP_P
#undef LD_V
#undef MM_PV
    const int tid2 = fresh_tid(), lane2 = tid2 & 63, wave2 = tid2 >> 6, r2 = lane2 & 31, h2b = lane2 >> 5;
    ls0 += shx(ls0, 32, lane2); ls1 += shx(ls1, 32, lane2);
    const float inv1 = 1.0f / ls0, inv2 = lam / ls1;
    float ss = 0.f;
#pragma unroll
    for (int et = 0; et < 4; ++et)
#pragma unroll
        for (int j = 0; j < 16; ++j) { const float o = O[0][et][j] * inv1 - O[1][et][j] * inv2; O[0][et][j] = o; ss += o * o; }
    ss += shx(ss, 32, lane2);
    float li_ = post_scale; asm volatile("" : "+s"(li_));
    const float rstd = rsqrtf(ss * (1.0f / 128.0f) + 1e-6f) * (1.0f - li_);
    bf16_t* op = MIX + (size_t)(qrow0 + wave2 * 32 + r2) * 1024 + h * 128 + 4 * h2b;
#pragma unroll
    for (int et = 0; et < 4; ++et)
#pragma unroll
        for (int g4 = 0; g4 < 4; ++g4) {
            const int e0 = 32 * et + 8 * g4;
            const f32x4 w4 = *(const f32x4*)(subw + e0 + 4 * h2b);
            u32x2 w; w.x = cvt_pk_bf16(O[0][et][4 * g4 + 0] * rstd * w4[0], O[0][et][4 * g4 + 1] * rstd * w4[1]);
            w.y = cvt_pk_bf16(O[0][et][4 * g4 + 2] * rstd * w4[2], O[0][et][4 * g4 + 3] * rstd * w4[3]);
            *(u32x2*)(op + e0) = w;
        }
}

template <int H>
__device__ __forceinline__ void pool_task(const bf16_t* er, bf16_t* outp, int t, int L) {
    u32x4 v[2 * H];
    int cnt = 0;
#pragma unroll
    for (int i = 0; i < 2 * H; ++i) { const int tt = t + i - H; const bool ok = (tt >= 0) && (tt < L); cnt += ok ? 1 : 0; v[i] = *(const u32x4*)(er + (ok ? (i - H) : 0) * 1024); if (!ok) v[i] = (u32x4){0u, 0u, 0u, 0u}; }
    const u32x4 sv = *(const u32x4*)(er);
    float sm[8];
#pragma unroll
    for (int j = 0; j < 8; ++j) sm[j] = 0.f;
#pragma unroll
    for (int i = 0; i < 2 * H; ++i) {
        sm[0] += bf_lo(v[i].x); sm[1] += bf_hi(v[i].x); sm[2] += bf_lo(v[i].y); sm[3] += bf_hi(v[i].y);
        sm[4] += bf_lo(v[i].z); sm[5] += bf_hi(v[i].z); sm[6] += bf_lo(v[i].w); sm[7] += bf_hi(v[i].w);
    }
    const float ic = 1.0f / (float)cnt;
    u32x4 w;
    w.x = cvt_pk_bf16(sm[0] * ic - bf_lo(sv.x), sm[1] * ic - bf_hi(sv.x)); w.y = cvt_pk_bf16(sm[2] * ic - bf_lo(sv.y), sm[3] * ic - bf_hi(sv.y));
    w.z = cvt_pk_bf16(sm[4] * ic - bf_lo(sv.z), sm[5] * ic - bf_hi(sv.z)); w.w = cvt_pk_bf16(sm[6] * ic - bf_lo(sv.w), sm[7] * ic - bf_hi(sv.w));
    *(u32x4*)outp = w;
}

__device__ __forceinline__ void ew_rows(const bf16_t* EW, bf16_t* MIX, const float* convw, int row0, int nrows) {
    const int tid = fresh_tid();
    for (int task = tid; task < nrows * 32; task += 512) {
        const int row = row0 + (task >> 5), c0 = (task & 31) * 8;
        int t, L; if (row < NLAT) { t = row & (SEQ - 1); L = SEQ; } else { t = (row - NLAT) & (LCTX - 1); L = LCTX; }
        const bf16_t* er = EW + (size_t)row * 1024;
        u32x4 cc[3], cx[3]; f32x4 wa[3], wb[3];
#pragma unroll
        for (int i = 0; i < 3; ++i) {
            const int dt = i - 1; const bool ok = (t + dt >= 0) && (t + dt < L);
            const bf16_t* rp = er + (ok ? dt : 0) * 1024;
            cc[i] = *(const u32x4*)(rp + 256 + c0); cx[i] = *(const u32x4*)(rp + 512 + c0);
            const float m = ok ? 1.0f : 0.0f;
            wa[i] = *(const f32x4*)(convw + i * 256 + c0) * m; wb[i] = *(const f32x4*)(convw + i * 256 + c0 + 4) * m;
        }
        const u32x4 cb = *(const u32x4*)(er + c0);
        float accv[8];
#pragma unroll
        for (int j = 0; j < 8; ++j) accv[j] = 0.f;
#pragma unroll
        for (int i = 0; i < 3; ++i) {
            accv[0] += bf_lo(cc[i].x) * bf_lo(cx[i].x) * wa[i][0]; accv[1] += bf_hi(cc[i].x) * bf_hi(cx[i].x) * wa[i][1];
            accv[2] += bf_lo(cc[i].y) * bf_lo(cx[i].y) * wa[i][2]; accv[3] += bf_hi(cc[i].y) * bf_hi(cx[i].y) * wa[i][3];
            accv[4] += bf_lo(cc[i].z) * bf_lo(cx[i].z) * wb[i][0]; accv[5] += bf_hi(cc[i].z) * bf_hi(cx[i].z) * wb[i][1];
            accv[6] += bf_lo(cc[i].w) * bf_lo(cx[i].w) * wb[i][2]; accv[7] += bf_hi(cc[i].w) * bf_hi(cx[i].w) * wb[i][3];
        }
        u32x4 w;
        w.x = cvt_pk_bf16(bf_lo(cb.x) * accv[0], bf_hi(cb.x) * accv[1]); w.y = cvt_pk_bf16(bf_lo(cb.y) * accv[2], bf_hi(cb.y) * accv[3]);
        w.z = cvt_pk_bf16(bf_lo(cb.z) * accv[4], bf_hi(cb.z) * accv[5]); w.w = cvt_pk_bf16(bf_lo(cb.w) * accv[6], bf_hi(cb.w) * accv[7]);
        *(u32x4*)(MIX + (size_t)row * 1024 + 512 + c0) = w;
    }
    for (int task = tid; task < nrows * 32; task += 512) {
        const int s8 = task & 7, q3 = task >> 3, g = q3 / nrows, row = row0 + (q3 - g * nrows), c0 = (g * 8 + s8) * 8;
        int t, L; if (row < NLAT) { t = row & (SEQ - 1); L = SEQ; } else { t = (row - NLAT) & (LCTX - 1); L = LCTX; }
        const bf16_t* er = EW + (size_t)row * 1024 + 768 + c0;
        const int gu = __builtin_amdgcn_readfirstlane(g);
        if (gu == 0) pool_task<1>(er, MIX + (size_t)row * 1024 + 768 + c0, t, L);
        else if (gu == 1) pool_task<2>(er, MIX + (size_t)row * 1024 + 768 + c0, t, L);
        else if (gu == 2) pool_task<4>(er, MIX + (size_t)row * 1024 + 768 + c0, t, L);
        else pool_task<8>(er, MIX + (size_t)row * 1024 + 768 + c0, t, L);
    }
}


#define XB_TMO      128
#define XB_XCNT(j)  (256  + 64 * (j))
#define XB_XSUB(j)  (1280 + 64 * (j))
#define XB_XGEN(j)  (2304 + 64 * (j))
#define XB_TOP      3328
#define XB_TOPGEN   3392
#define XCD_BAR_WORDS 3456
#define XB_SPIN_CAP (1u << 22)
__device__ __forceinline__ unsigned xb_ld(unsigned* p)              { return __hip_atomic_load(p, __ATOMIC_RELAXED, __HIP_MEMORY_SCOPE_AGENT); }
__device__ __forceinline__ unsigned xb_add(unsigned* p, unsigned v) { return __hip_atomic_fetch_add(p, v, __ATOMIC_RELAXED, __HIP_MEMORY_SCOPE_AGENT); }
__device__ __forceinline__ unsigned xb_xcc_id() { return (unsigned)__builtin_amdgcn_s_getreg((3 << 11) | 20) & 0xFu; }
#define XB_SPIN(cond, bar) do { unsigned _sp = 0; while (cond) { __builtin_amdgcn_s_sleep(1); \
    if ((++_sp & 255u) == 0u) { if (xb_ld(&(bar)[XB_TMO])) break; if (_sp > XB_SPIN_CAP) { atomicAdd(&(bar)[XB_TMO], 1u); break; } } } } while (0)
struct XcdBarrier { unsigned* bar; unsigned x; volatile LAS unsigned* st; };
__device__ __forceinline__ XcdBarrier xcd_barrier_post(unsigned* bar, volatile LAS unsigned* st) {
    XcdBarrier b; b.bar = bar; b.x = xb_xcc_id(); b.st = st;
    if (threadIdx.x == 0) (void)xb_add(&bar[XB_XCNT(b.x)], 1u);
    return b;
}
__device__ __forceinline__ void xcd_barrier_complete(unsigned* bar, unsigned x, unsigned& nloc, unsigned& nx) {
    const unsigned G = gridDim.x * gridDim.y * gridDim.z;
    unsigned sum, cnt, mine, sp = 0u;
    for (;;) {
        sum = 0u; cnt = 0u; mine = 0u;
#pragma unroll
        for (unsigned j = 0; j < 16; ++j) { const unsigned c = xb_ld(&bar[XB_XCNT(j)]); sum += c; cnt += (c > 0u) ? 1u : 0u; mine = (j == x) ? c : mine; }
        if (sum == G) break;
        __builtin_amdgcn_s_sleep(1);
        if ((++sp & 255u) == 0u) { if (xb_ld(&bar[XB_TMO])) break; if (sp > XB_SPIN_CAP) { atomicAdd(&bar[XB_TMO], 1u); break; } }
    }
    nloc = mine > 0u ? mine : 1u; nx = cnt > 0u ? cnt : 1u;
}
__device__ __forceinline__ void xcd_barrier(const XcdBarrier& b) {
    asm volatile("s_waitcnt vmcnt(0)" ::: "memory");
    __syncthreads();
    if (threadIdx.x == 0) {
        unsigned* bar = b.bar;
        __builtin_amdgcn_s_waitcnt(0);
        unsigned nloc = b.st[0], nx = b.st[1];
        if (nloc == 0u) { xcd_barrier_complete(bar, b.x, nloc, nx); b.st[0] = nloc; b.st[1] = nx; }
        const unsigned old = xb_add(&bar[XB_XSUB(b.x)], 1u);
        const unsigned gen = old / nloc;
        if (old + 1u == (gen + 1u) * nloc) {
            __builtin_amdgcn_fence(__ATOMIC_RELEASE, "agent");
            asm volatile("s_waitcnt vmcnt(0)" ::: "memory");
            const unsigned og = xb_add(&bar[XB_TOP], 1u);
            const unsigned tg = og / nx;
            if (og + 1u == (tg + 1u) * nx) xb_add(&bar[XB_TOPGEN], 1u);
            else XB_SPIN(xb_ld(&bar[XB_TOPGEN]) == tg, bar);
            __builtin_amdgcn_fence(__ATOMIC_ACQUIRE, "agent");
            xb_add(&bar[XB_XGEN(b.x)], 1u);
            asm volatile("s_waitcnt vmcnt(0)" ::: "memory");
        } else {
            XB_SPIN(xb_ld(&bar[XB_XGEN(b.x)]) == gen, bar);
            __builtin_amdgcn_fence(__ATOMIC_ACQUIRE, "agent");
            asm volatile("s_waitcnt vmcnt(0)" ::: "memory");
        }
    }
    __syncthreads();
}

__global__ void __launch_bounds__(512, 2) hymba_mega(Params p_unused) {
    extern __shared__ __attribute__((aligned(16))) unsigned char lds_raw[];
    LAS unsigned char* lds = (LAS unsigned char*)lds_raw;
    cg::grid_group grid = cg::this_grid();
    const int G = gridDim.x, bid = blockIdx.x;
#define WSP(T, off) ((T*)(q->ws + (off)))
    volatile LAS unsigned* xst = (volatile LAS unsigned*)(lds + 131072 + 8192);
    if (threadIdx.x < 4) xst[threadIdx.x] = 0u;
    __syncthreads();
    const XcdBarrier xbar = xcd_barrier_post((unsigned*)(kargs()->ws + OFF_BAR), xst);

    for (int rep = 0; rep < REP_P0; ++rep)
    for (int item = bid; item < 288 + 5120 + 1; item += G) {
        if (item < 288) mod_item(lds, item);
        else if (item < 288 + 5120) conv_tile(lds, item - 288);
        else rope_item();
    }
    grid.sync();

#pragma unroll 1
    for (int l = 0; l < DEPTH; ++l) {
        const bool lastl = (l == DEPTH - 1);
        { const KArgP q = kargs();
          if (l == 0) prep_phase(q->x, q->ctx, nullptr, nullptr, nullptr, nullptr, false, WSP(bf16_t, OFF_A), q->norm_w, WSP(float, OFF_MOD), 0, 1, true);
          else prep_phase(q->out, WSP(float, OFF_HC), nullptr, WSP(float, OFF_HC), nullptr, WSP(bf16_t, OFF_YC), true, WSP(bf16_t, OFF_A), q->norm_w + (l * 3 + 0) * D, WSP(float, OFF_MOD) + (size_t)l * 17 * NMODC, 0, 1, true); }
        GRID_SYNC();
        { const KArgP q = kargs();
          Sched1 S{144, 22, G, bid, (const char*)WSP(bf16_t, OFF_A), (const char*)(WSP(bf16_t, OFF_WGU) + (size_t)(l * 2 + 0) * NGU * D), (size_t)256 * D * 2, 16}; EpiSwiGLU E{WSP(bf16_t, OFF_HID)};
          gemm_phase(lds, D, S, E, stagger_ticks(S.nM * 22, bid, 16)); }
        GRID_SYNC();
        { const KArgP q = kargs();
          SchedR S{bid, true, (const char*)WSP(bf16_t, OFF_HID), (const char*)(WSP(bf16_t, OFF_WDN) + (size_t)(l * 2 + 0) * D * DFF), (size_t)256 * DFF * 2, 44};
          EpiResid E{(l == 0) ? q->x : q->out, (l == 0) ? q->ctx : WSP(float, OFF_HC), q->out, WSP(float, OFF_HC), WSP(float, OFF_MOD) + (size_t)l * 17 * NMODC + 2 * D, 0.5f, WSP(bf16_t, OFF_YC)};
          gemm_phase(lds, DFF, S, E, 0); }
        GRID_SYNC();
        { const KArgP q = kargs();
          prep_phase(q->out, WSP(float, OFF_HC), nullptr, WSP(float, OFF_HC), nullptr, WSP(bf16_t, OFF_YC), true,
                     WSP(bf16_t, OFF_A), q->norm_w + (l * 3 + 1) * D, WSP(float, OFF_MOD) + (size_t)l * 17 * NMODC, 3, 4, true); }
        GRID_SYNC();
        { const KArgP q = kargs();
          SchedIn S{G, bid, (const char*)WSP(bf16_t, OFF_A), (const char*)(WSP(bf16_t, OFF_WIN) + (size_t)l * INC * D), (size_t)256 * D * 2};
          { const int t = fresh_tid(); *(LAS f32x4*)(lds + 131072 + t * 16) = *(const f32x4*)(WSP(float, OFF_ROPE) + t * 4); __syncthreads(); }
          EpiIn E{WSP(bf16_t, OFF_Q), WSP(bf16_t, OFF_KB), WSP(bf16_t, OFF_VT), WSP(bf16_t, OFF_EW), q->q_norm_w + l * 64, q->k_norm_w + l * 64, (const LAS float*)(lds + 131072)};
          gemm_phase(lds, D, S, E, stagger_ticks(1440, bid, 16)); }
        GRID_SYNC();
        {
            const KArgP q = kargs();
            const float lam_init = 0.8f - 0.6f * __expf(-0.3f * (float)l);
            const float* lq = q->lambda_qk + l * 256; const int lane = fresh_tid() & 63;
            const float sa = wave_sum(lq[lane] * lq[64 + lane], lane), sb = wave_sum(lq[128 + lane] * lq[192 + lane], lane);
            const float lam = uniformf(__expf(sa) - __expf(sb) + lam_init);
            const float mq = wave_max(fabsf(q->q_norm_w[l * 64 + lane]), lane), mk = wave_max(fabsf(q->k_norm_w[l * 64 + lane]), lane);
            const float negM = uniformf(-(8.0f * LOG2E * mq * mk));
            const float post_scale = uniformf(lam_init);
            const int n_ctx = lastl ? 0 : 64;
            const int n_items = 512 + n_ctx;
            { const int rpw = lastl ? (NLAT / 256) : (NROWS / 256); ew_rows(WSP(bf16_t, OFF_EW), WSP(bf16_t, OFF_A), q->conv_w + l * 768, bid * rpw, rpw); }
            for (int rep = 0; rep < REP_MIX; ++rep)
            for (int item = bid; item < n_items; item += G) {
                if (item < 512 + n_ctx) {
                    int b, h, qrow0, key0, nkeys;
                    if (item < 512) { const int u = ((item & 7) << 6) + ((item >> 8) << 5) + ((item & 255) >> 3);
                        b = u >> 5; h = (u >> 3) & 3; qrow0 = b * SEQ + (u & 7) * 256; key0 = 0; nkeys = NKEYS; }
                    else { const int it = item - 512; b = it >> 2; h = it & 3; qrow0 = NLAT + b * LCTX; key0 = SEQ; nkeys = LCTX; }
                    attn_item(lds, WSP(bf16_t, OFF_Q), WSP(bf16_t, OFF_KB), WSP(bf16_t, OFF_VT), WSP(bf16_t, OFF_A), b, h, qrow0, key0, nkeys, lam, negM, q->subln_w + l * 128, post_scale);
                }
            }
        }
        GRID_SYNC();
        const int nMr = lastl ? 128 : 144;
        { const KArgP q = kargs();
          SchedR S{bid, !lastl, (const char*)WSP(bf16_t, OFF_A), (const char*)(WSP(bf16_t, OFF_WOUT) + (size_t)l * D * D), (size_t)256 * D * 2, 16};
          EpiResid E{q->out, WSP(float, OFF_HC), q->out, WSP(float, OFF_HC), WSP(float, OFF_MOD) + (size_t)l * 17 * NMODC + 5 * D, 1.0f, WSP(bf16_t, OFF_YC)};
          gemm_phase(lds, D, S, E, 0); }
        GRID_SYNC();
        { const KArgP q = kargs();
          prep_phase(q->out, WSP(float, OFF_HC), nullptr, WSP(float, OFF_HC), nullptr, WSP(bf16_t, OFF_YC), !lastl,
                     WSP(bf16_t, OFF_A), q->norm_w + (l * 3 + 2) * D, WSP(float, OFF_MOD) + (size_t)l * 17 * NMODC, 6, 7, !lastl); }
        GRID_SYNC();
        { const KArgP q = kargs();
          Sched1 S{nMr, 22, G, bid, (const char*)WSP(bf16_t, OFF_A), (const char*)(WSP(bf16_t, OFF_WGU) + (size_t)(l * 2 + 1) * NGU * D), (size_t)256 * D * 2, 16}; EpiSwiGLU E{WSP(bf16_t, OFF_HID)};
          gemm_phase(lds, D, S, E, stagger_ticks(S.nM * 22, bid, 16)); }
        GRID_SYNC();
        if (!lastl) {
          const KArgP q = kargs();
          SchedR S{bid, true, (const char*)WSP(bf16_t, OFF_HID), (const char*)(WSP(bf16_t, OFF_WDN) + (size_t)(l * 2 + 1) * D * DFF), (size_t)256 * DFF * 2, 44};
          EpiResid E{q->out, WSP(float, OFF_HC), q->out, WSP(float, OFF_HC), WSP(float, OFF_MOD) + (size_t)l * 17 * NMODC + 8 * D, 0.5f, WSP(bf16_t, OFF_YC)};
          gemm_phase(lds, DFF, S, E, 0);
          GRID_SYNC();
        } else {
          const KArgP q = kargs();
          Sched1 S{128, 4, G, bid, (const char*)WSP(bf16_t, OFF_HID), (const char*)(WSP(bf16_t, OFF_WDN) + (size_t)(l * 2 + 1) * D * DFF), (size_t)256 * DFF * 2, 44};
          EpiResid E{q->out, WSP(float, OFF_HC), q->out, WSP(float, OFF_HC), WSP(float, OFF_MOD) + (size_t)l * 17 * NMODC + 8 * D, 0.5f, nullptr};
          gemm_phase(lds, DFF, S, E, 0);
        }
    }
#undef WSP
}

extern "C" void kernel_launch(void* const* d_in, const int* in_sizes, int n_in, void* d_out, int out_size, void* d_ws, size_t ws_size, hipStream_t stream) {
    static int grid_blocks = 0;
    if (!grid_blocks) {
        int dev = 0, cus = 0, per_cu = 0;
        hipGetDevice(&dev);
        hipDeviceGetAttribute(&cus, hipDeviceAttributeMultiprocessorCount, dev);
        hipFuncSetAttribute((const void*)hymba_mega, hipFuncAttributeMaxDynamicSharedMemorySize, LDS_BYTES);
        hipOccupancyMaxActiveBlocksPerMultiprocessor(&per_cu, (const void*)hymba_mega, 512, LDS_BYTES);
        if (per_cu < 1) per_cu = 1;
        if (per_cu > 1) per_cu = 1;
        grid_blocks = 256;
        if (ws_size < WS_END) fprintf(stderr, "kernel_launch: workspace too small: %zu < %zu\n", ws_size, (size_t)WS_END);
    }
    Params p{};
    p.x = (const float*)d_in[0]; p.c = (const float*)d_in[1]; p.ctx = (const float*)d_in[2]; p.c_ctx = (const float*)d_in[3];
    p.norm_w = (const float*)d_in[4]; p.w_mod = (const float*)d_in[5]; p.b_mod = (const float*)d_in[6];
    p.w_gu1 = (const float*)d_in[7]; p.w_dn1 = (const float*)d_in[8]; p.w_gu2 = (const float*)d_in[9]; p.w_dn2 = (const float*)d_in[10];
    p.w_in = (const float*)d_in[11]; p.w_out = (const float*)d_in[12]; p.q_norm_w = (const float*)d_in[13]; p.k_norm_w = (const float*)d_in[14];
    p.lambda_qk = (const float*)d_in[15]; p.subln_w = (const float*)d_in[16]; p.conv_w = (const float*)d_in[17]; p.pool_w = (const float*)d_in[18]; p.pool_scale = (const float*)d_in[19];
    p.out = (float*)d_out; p.ws = (unsigned char*)d_ws;
    (void)hipMemsetAsync((unsigned char*)d_ws + OFF_BAR, 0, 16384, stream);
    void* args[] = {&p};
    hipError_t e = hipLaunchCooperativeKernel((const void*)hymba_mega, dim3(grid_blocks), dim3(512), args, LDS_BYTES, stream);
    if (e != hipSuccess) fprintf(stderr, "cooperative launch failed: %s (grid %d)\n", hipGetErrorString(e), grid_blocks);
}
```

```cpp
#include <hip/hip_runtime.h>
#include <hip/hip_cooperative_groups.h>
#include <cstdio>
namespace cg = cooperative_groups;

#define LAS __attribute__((address_space(3)))
typedef unsigned short bf16_t;
typedef short bf16x8 __attribute__((ext_vector_type(8)));
typedef float f32x4 __attribute__((ext_vector_type(4)));
typedef float f32x16 __attribute__((ext_vector_type(16)));
typedef unsigned u32x4 __attribute__((ext_vector_type(4)));
typedef unsigned u32x2 __attribute__((ext_vector_type(2)));

constexpr int D = 1024, NB = 16, SEQ = 2048, LCTX = 256, NLAT = NB * SEQ, NCTX = NB * LCTX, NROWS = NLAT + NCTX;
constexpr int DFF = 2816, NGU = 2 * DFF, INC = 2560, NKEYS = SEQ + LCTX, DEPTH = 4, NMODC = 9 * D;
constexpr int LDS_BYTES = 131072 + 8192 + 16;
constexpr float LOG2E = 1.4426950408889634f;
#ifndef REP_SYNC
#define REP_SYNC 1
#endif
#ifndef REP_PREP
#define REP_PREP 1
#endif
#ifndef REP_MIX
#define REP_MIX 1
#endif
#ifndef REP_P0
#define REP_P0 1
#endif
#define GRID_SYNC() do { for (int _r = 0; _r < REP_SYNC; ++_r) xcd_barrier(xbar); } while (0)

constexpr size_t OFF_WGU = 0;
constexpr size_t OFF_WDN = OFF_WGU + (size_t)8 * NGU * D * 2;
constexpr size_t OFF_WIN = OFF_WDN + (size_t)8 * D * DFF * 2;
constexpr size_t OFF_WOUT = OFF_WIN + (size_t)4 * INC * D * 2;
constexpr size_t OFF_MOD = OFF_WOUT + (size_t)4 * D * D * 2;
constexpr size_t OFF_ROPE = OFF_MOD + (size_t)4 * 17 * NMODC * 4;
constexpr size_t OFF_HC = OFF_ROPE + 8192;
constexpr size_t OFF_A = OFF_HC + (size_t)NCTX * D * 4;
constexpr size_t OFF_HID = OFF_A + (size_t)NROWS * D * 2;
constexpr size_t OFF_Q = OFF_HID;
constexpr size_t OFF_KB = OFF_Q + (size_t)NROWS * 512 * 2;
constexpr size_t OFF_VT = OFF_KB + (size_t)NROWS * 512 * 2;
constexpr size_t OFF_EW = OFF_VT + (size_t)NROWS * 512 * 2;
constexpr size_t OFF_Y0 = OFF_HID + (size_t)NROWS * DFF * 2;
constexpr size_t OFF_YC = OFF_Y0;
constexpr size_t OFF_BAR = OFF_YC + (size_t)3 * NCTX * D * 2;
constexpr size_t WS_END = OFF_BAR + 16384;
static_assert(OFF_EW + (size_t)NROWS * 1024 * 2 <= OFF_BAR, "alias region");

struct Params {
    const float *x, *c, *ctx, *c_ctx, *norm_w, *w_mod, *b_mod, *w_gu1, *w_dn1, *w_gu2, *w_dn2, *w_in, *w_out, *q_norm_w, *k_norm_w, *lambda_qk, *subln_w, *conv_w, *pool_w, *pool_scale;
    float* out; unsigned char* ws;
};

typedef const Params __attribute__((address_space(4)))* KArgP;
__device__ __forceinline__ KArgP kargs() { KArgP q = (KArgP)__builtin_amdgcn_kernarg_segment_ptr(); asm volatile("" : "+s"(q)); return q; }
__device__ __forceinline__ unsigned cvt_pk_bf16(float lo, float hi) { unsigned r; asm volatile("v_cvt_pk_bf16_f32 %0, %1, %2" : "=v"(r) : "v"(lo), "v"(hi)); return r; }
__device__ __forceinline__ int fresh_tid() { int t = threadIdx.x; asm volatile("" : "+v"(t)); return t; }
__device__ __forceinline__ float uniformf(float v) { return __int_as_float(__builtin_amdgcn_readfirstlane(__float_as_int(v))); }
__device__ __forceinline__ float bf_lo(unsigned w) { return __uint_as_float(w << 16); }
__device__ __forceinline__ float bf_hi(unsigned w) { return __uint_as_float(w & 0xffff0000u); }
__device__ __forceinline__ float shx(float v, int mask, int lane) { return __int_as_float(__builtin_amdgcn_ds_bpermute((lane ^ mask) << 2, __float_as_int(v))); }
__device__ __forceinline__ float wave_sum(float v, int lane) {
#pragma unroll
    for (int o = 32; o >= 1; o >>= 1) v += shx(v, o, lane);
    return v;
}
__device__ __forceinline__ float wave_max(float v, int lane) {
#pragma unroll
    for (int o = 32; o >= 1; o >>= 1) v = fmaxf(v, shx(v, o, lane));
    return v;
}

constexpr int BM = 256, BK = 64, HALF = 128, HTB = HALF * BK * 2;
__device__ __forceinline__ int lds_byte(int r, int c) { const int st = (r >> 4) * 2 + (c >> 5), rr = r & 15, cc = c & 31, ob = rr * 64 + cc * 2; return st * 1024 + (ob ^ (((ob >> 9) & 1) << 5)); }
__device__ __forceinline__ void stage_rc(int b, int& R, int& C) { const int st = b / 1024, sb = b % 1024, swz = sb ^ (((sb >> 9) & 1) << 5); R = (st >> 1) * 16 + swz / 64; C = (st & 1) * 32 + (swz % 64) / 2; }

struct GUnit { int pm, pn, kind, nt; const char* a; const char* b; };

__device__ __forceinline__ int unit_index(int i, int c_, int U) {
    int c = c_; asm volatile("" : "+s"(c));
    const int x = c & 7, off = c >> 3;
    const int R = (U + 255) >> 8, nx = (U - ((R - 1) << 8)) >> 5;
    const int start = (x < nx) ? x * R * 32 : nx * R * 32 + (x - nx) * (R - 1) * 32;
    const int mine = (x < nx) ? R : R - 1;
    return (i < mine) ? start + i * 32 + off : -1;
}
__device__ __forceinline__ void tile_of(int wgid, int nM, int nN, int& pm, int& pn) {
    const int nig = 8 * nN, gid = wgid / nig, fm = gid * 8, gsz = (nM - fm) < 8 ? (nM - fm) : 8;
    pm = fm + ((wgid % nig) % gsz); pn = (wgid % nig) / gsz;
}
__device__ __forceinline__ int stagger_ticks(int total_units, int c_, int nt) {
    int c = c_; asm volatile("" : "+s"(c));
    const int x = c & 7;
    const int R = (total_units + 255) >> 8, nx = (total_units - ((R - 1) << 8)) >> 5;
    if (x < nx || nx == 8) return 0;
    return (int)((float)(x - nx + 1) * (float)(nt * 140) * __builtin_amdgcn_rcpf((float)(8 - nx + 1)));
}
__device__ __forceinline__ void stagger_wait(int ticks) {
    if (ticks <= 0) return;
    const unsigned long long t0 = __builtin_amdgcn_s_memrealtime();
    while ((long long)(__builtin_amdgcn_s_memrealtime() - t0) < (long long)ticks) __builtin_amdgcn_s_sleep(16);
}
struct Sched1 {
    int nM, nN, G, c; const char* A; const char* Bt; size_t tstep; int nt;
    __device__ __forceinline__ bool next(int i, GUnit& u) const {
        const int L = unit_index(i, c, nM * nN); if (L < 0) return false;
        tile_of(L, nM, nN, u.pm, u.pn); u.kind = 0; u.nt = nt; u.a = A + (size_t)u.pm * tstep; u.b = Bt + (size_t)u.pn * tstep; return true;
    }
};
struct SchedIn {
    int G, c; const char* A; const char* Win; size_t tstep;
    __device__ __forceinline__ bool next(int i, GUnit& u) const {
        const int L = unit_index(i, c, 1440);
        if (L < 0) return false;
        u.nt = 16;
        if (L < 1152) { tile_of(L, 144, 8, u.pm, u.pn); u.kind = 0; u.a = A + (size_t)u.pm * tstep; u.b = Win + (size_t)u.pn * tstep; return true; }
        if (L < 1440) { tile_of(L - 1152, 2, 144, u.pm, u.pn); u.kind = 1; u.a = Win + (size_t)(8 + u.pm) * tstep; u.b = A + (size_t)u.pn * tstep; return true; }
        return false;
    }
};

struct SchedR {
    int c; bool has_ctx; const char* A; const char* Bt; size_t tstep; int NT;
    __device__ __forceinline__ bool next(int i, GUnit& u) const {
        if (i < 2) { const int L = unit_index(i, c, 512); tile_of(L, 128, 4, u.pm, u.pn); u.kind = 0; u.nt = NT; u.a = A + (size_t)u.pm * tstep; u.b = Bt + (size_t)u.pn * tstep; return true; }
        if (i == 2 && has_ctx) {
            int cc = c; asm volatile("" : "+s"(cc));
            const int Lc = (cc & 7) * 32 + (cc >> 3), ct = Lc >> 2, sp = Lc & 3;
            u.pm = 128 + (ct >> 2); u.pn = ct & 3; u.kind = sp;
            int ks;
            if (NT == 44) { ks = sp * 12 - (sp == 3 ? 2 : 0); u.nt = (sp < 2) ? 12 : 10; } else { ks = sp * (NT >> 2); u.nt = NT >> 2; }
            u.a = A + (size_t)u.pm * tstep + (size_t)ks * 128; u.b = Bt + (size_t)u.pn * tstep + (size_t)ks * 128; return true;
        }
        return false;
    }
};

struct EpiSwiGLU {
    bf16_t* hid;
    __device__ __forceinline__ void operator()(const f32x4 (&acc)[2][2][4][2], const GUnit& u, int wr, int wc, int fr, int fq) const {
        const int row0 = u.pm * BM + wr * 64 + fr;
        const int col0 = u.pn * 128 + wc * 32 + 8 * fq;
#pragma unroll
        for (int ai = 0; ai < 2; ++ai)
#pragma unroll
            for (int m = 0; m < 4; ++m) {
                float v[8];
#pragma unroll
                for (int n = 0; n < 2; ++n)
#pragma unroll
                    for (int j = 0; j < 4; ++j) {
                        const float g = acc[ai][0][m][n][j], uu = acc[ai][1][m][n][j];
                        const float sg = g * __builtin_amdgcn_rcpf(1.0f + __builtin_amdgcn_exp2f(-g * LOG2E));
                        v[n * 4 + j] = sg * uu;
                    }
                u32x4 w; w.x = cvt_pk_bf16(v[0], v[1]); w.y = cvt_pk_bf16(v[2], v[3]); w.z = cvt_pk_bf16(v[4], v[5]); w.w = cvt_pk_bf16(v[6], v[7]);
                *(u32x4*)(hid + (size_t)(row0 + ai * HALF + m * 16) * DFF + col0) = w;
            }
    }
};
struct EpiResid {
    const float* src_lat; const float* src_ctx; float* dst_lat; float* dst_ctx; const float* gate; float coef; bf16_t* Yc;
    __device__ __forceinline__ void operator()(const f32x4 (&acc)[2][2][4][2], const GUnit& u, int wr, int wc, int fr, int fq) const {
        if (u.kind != 0) {
            const int pmc = u.pm - 128; const int colc = u.pn * BM + wc * 32 + 4 * fq;
            bf16_t* yb = Yc + ((size_t)(u.kind - 1) * NCTX + (size_t)pmc * 256) * D;
            f32x4 gq[2][2];
#pragma unroll
            for (int bj = 0; bj < 2; ++bj)
#pragma unroll
                for (int n = 0; n < 2; ++n) gq[bj][n] = *(const f32x4*)(gate + (size_t)16 * NMODC + colc + bj * HALF + n * 16) * coef;
#pragma unroll
            for (int ai = 0; ai < 2; ++ai)
#pragma unroll
                for (int m = 0; m < 4; ++m) {
                    bf16_t* rowp = yb + (size_t)(wr * 64 + fr + ai * HALF + m * 16) * D + colc;
#pragma unroll
                    for (int bj = 0; bj < 2; ++bj)
#pragma unroll
                        for (int n = 0; n < 2; ++n) {
                            const f32x4 a = gq[bj][n] * acc[ai][bj][m][n]; u32x2 w; w.x = cvt_pk_bf16(a[0], a[1]); w.y = cvt_pk_bf16(a[2], a[3]);
                            *(u32x2*)(rowp + bj * HALF + n * 16) = w;
                        }
                }
            return;
        }
        const int pm = u.pm; const bool lat = pm < 128;
        const float* sp = lat ? src_lat + (size_t)pm * 256 * D : src_ctx + (size_t)(pm - 128) * 256 * D;
        float* dp = lat ? dst_lat + (size_t)pm * 256 * D : dst_ctx + (size_t)(pm - 128) * 256 * D;
        const int modrow = lat ? (pm >> 3) : 16;
        const int col0 = u.pn * BM + wc * 32 + 4 * fq;
        f32x4 gv[2][2];
#pragma unroll
        for (int bj = 0; bj < 2; ++bj)
#pragma unroll
            for (int n = 0; n < 2; ++n) gv[bj][n] = *(const f32x4*)(gate + (size_t)modrow * NMODC + col0 + bj * HALF + n * 16) * coef;
#pragma unroll
        for (int ai = 0; ai < 2; ++ai)
#pragma unroll
            for (int mp = 0; mp < 2; ++mp) {
                f32x4 rv[2][2][2];
#pragma unroll
                for (int mm = 0; mm < 2; ++mm)
#pragma unroll
                    for (int bj = 0; bj < 2; ++bj)
#pragma unroll
                        for (int n = 0; n < 2; ++n)
                            rv[mm][bj][n] = *(const f32x4*)(sp + (size_t)(wr * 64 + fr + ai * HALF + (mp * 2 + mm) * 16) * D + col0 + bj * HALF + n * 16);
#pragma unroll
                for (int mm = 0; mm < 2; ++mm)
#pragma unroll
                    for (int bj = 0; bj < 2; ++bj)
#pragma unroll
                        for (int n = 0; n < 2; ++n)
                            *(f32x4*)(dp + (size_t)(wr * 64 + fr + ai * HALF + (mp * 2 + mm) * 16) * D + col0 + bj * HALF + n * 16) = rv[mm][bj][n] + gv[bj][n] * acc[ai][bj][mp * 2 + mm][n];
            }
    }
};
struct EpiY {
    bf16_t* Y0; bf16_t* Yc; const float* gate; float coef;
    __device__ __forceinline__ void operator()(const f32x4 (&acc)[2][2][4][2], const GUnit& u, int wr, int wc, int fr_, int fq_) const {
        int fr = fr_, fq = fq_; asm volatile("" : "+v"(fr), "+v"(fq));
        const int pm = u.pm; const int modrow = (pm < 128) ? (pm >> 3) : 16;
        const int col0 = u.pn * BM + wc * 32 + 4 * fq;
        bf16_t* yb = (u.kind == 0) ? Y0 + (size_t)pm * 256 * D : Yc + ((size_t)(u.kind - 1) * NCTX + (size_t)(pm - 128) * 256) * D;
        f32x4 gv[2][2];
#pragma unroll
        for (int bj = 0; bj < 2; ++bj)
#pragma unroll
            for (int n = 0; n < 2; ++n) gv[bj][n] = *(const f32x4*)(gate + (size_t)modrow * NMODC + col0 + bj * HALF + n * 16) * coef;
#pragma unroll
        for (int ai = 0; ai < 2; ++ai)
#pragma unroll
            for (int m = 0; m < 4; ++m) {
                bf16_t* rowp = yb + (size_t)(wr * 64 + fr + ai * HALF + m * 16) * D + col0;
#pragma unroll
                for (int bj = 0; bj < 2; ++bj)
#pragma unroll
                    for (int n = 0; n < 2; ++n) {
                        const f32x4 a = gv[bj][n] * acc[ai][bj][m][n]; u32x2 w; w.x = cvt_pk_bf16(a[0], a[1]); w.y = cvt_pk_bf16(a[2], a[3]);
                        *(u32x2*)(rowp + bj * HALF + n * 16) = w;
                    }
            }
    }
};
struct EpiIn {
    bf16_t *Q, *KB, *VT, *EW; const float *qw, *kw; const LAS float* ropeL;
    __device__ __forceinline__ void operator()(const f32x4 (&acc)[2][2][4][2], const GUnit& u, int wr, int wc, int fr, int fq) const {
        const int pm = u.pm, pn = u.pn;
        if (u.kind == 1) {
            int b, key0; if (pn < 128) { b = pn >> 3; key0 = (pn & 7) * 256; } else { b = pn - 128; key0 = SEQ; }
#pragma unroll
            for (int ai = 0; ai < 2; ++ai)
#pragma unroll
                for (int m = 0; m < 4; ++m) {
                    const int vcol = pm * 256 + ai * HALF + wr * 64 + m * 16 + fr;
                    bf16_t* rowp = VT + (size_t)(b * 512 + vcol) * NKEYS + key0 + wc * 32 + 4 * fq;
#pragma unroll
                    for (int bj = 0; bj < 2; ++bj)
#pragma unroll
                        for (int n = 0; n < 2; ++n) {
                            const f32x4 a = acc[ai][bj][m][n]; u32x2 w; w.x = cvt_pk_bf16(a[0], a[1]); w.y = cvt_pk_bf16(a[2], a[3]);
                            *(u32x2*)(rowp + bj * HALF + n * 16) = w;
                        }
                }
            return;
        }
        const bool lat = pm < 128;
        const int rl0 = wr * 64 + fr;
        if (pn >= 4) {
#pragma unroll
            for (int ai = 0; ai < 2; ++ai)
#pragma unroll
                for (int m = 0; m < 4; ++m) {
                    bf16_t* rowp = EW + (size_t)(pm * 256 + rl0 + ai * HALF + m * 16) * 1024 + (pn - 4) * 256 + wc * 64 + 4 * fq;
#pragma unroll
                    for (int bj = 0; bj < 2; ++bj)
#pragma unroll
                        for (int n = 0; n < 2; ++n) {
                            const f32x4 a = acc[ai][bj][m][n]; u32x2 w; w.x = cvt_pk_bf16(a[0], a[1]); w.y = cvt_pk_bf16(a[2], a[3]);
                            *(u32x2*)(rowp + bj * 32 + n * 16) = w;
                        }
                }
            return;
        }
        const bool isq = pn < 2;
        const float* w = isq ? qw : kw;
        f32x4 wv[2][2];
#pragma unroll
        for (int bj = 0; bj < 2; ++bj)
#pragma unroll
            for (int n = 0; n < 2; ++n) wv[bj][n] = *(const f32x4*)(w + bj * 32 + n * 16 + 4 * fq);
        const float osc = isq ? 0.125f * LOG2E : 1.0f;
        bf16_t* dst; size_t drow0;
        if (isq) { dst = Q; drow0 = (size_t)pm * 256; }
        else { dst = KB; drow0 = lat ? (size_t)(pm >> 3) * NKEYS + (size_t)(pm & 7) * 256 : (size_t)(pm - 128) * NKEYS + SEQ; }
        const int colb = (pn & 1) * 256 + wc * 64 + 8 * fq;
#pragma unroll
        for (int ai = 0; ai < 2; ++ai)
#pragma unroll
            for (int m = 0; m < 4; ++m) {
                const int rl = rl0 + ai * HALF + m * 16;
                float ss = 0.f;
#pragma unroll
                for (int bj = 0; bj < 2; ++bj)
#pragma unroll
                    for (int n = 0; n < 2; ++n) { const f32x4 a = acc[ai][bj][m][n]; ss += a[0] * a[0] + a[1] * a[1] + a[2] * a[2] + a[3] * a[3]; }
                ss += shx(ss, 16, fq * 16 + fr); ss += shx(ss, 32, fq * 16 + fr);
                const float rs = rsqrtf(ss * (1.0f / 64.0f) + 1e-6f) * osc;
                f32x4 y[2][2];
#pragma unroll
                for (int bj = 0; bj < 2; ++bj)
#pragma unroll
                    for (int n = 0; n < 2; ++n) y[bj][n] = acc[ai][bj][m][n] * rs * wv[bj][n];
                if (lat) {
                    const int s = (pm & 7) * 256 + rl;
#pragma unroll
                    for (int bj = 0; bj < 2; ++bj) {
                        const int pos = bj ? (s & 63) : (s >> 6);
                        const f32x4 c4 = *(const LAS f32x4*)(ropeL + pos * 16 + 4 * fq), s4 = *(const LAS f32x4*)(ropeL + 1024 + pos * 16 + 4 * fq);
                        const f32x4 x1 = y[bj][0], x2 = y[bj][1];
                        y[bj][0] = x1 * c4 - x2 * s4; y[bj][1] = x1 * s4 + x2 * c4;
                    }
                }
                bf16_t* rowp = dst + (drow0 + rl) * 512 + colb;
#pragma unroll
                for (int bj = 0; bj < 2; ++bj) {
                    const f32x4 a = y[bj][0], b2 = y[bj][1]; u32x4 ww;
                    ww.x = cvt_pk_bf16(a[0], a[1]); ww.y = cvt_pk_bf16(a[2], a[3]); ww.z = cvt_pk_bf16(b2[0], b2[1]); ww.w = cvt_pk_bf16(b2[2], b2[3]);
                    *(u32x4*)(rowp + bj * 32) = ww;
                }
            }
    }
};

template <class Sched, class Epi>
__device__ __forceinline__ void gemm_phase(LAS unsigned char* lds, const int K, const Sched& S, const Epi& E, const int delay_ticks) {
    const int tid = fresh_tid(), wid = __builtin_amdgcn_readfirstlane(tid >> 6), lane = tid & 63, wr = wid >> 2, wc = wid & 3, fr = lane & 15, fq = lane >> 4;
    unsigned voff[2];
#pragma unroll
    for (int i = 0; i < 2; ++i) { int R, C; stage_rc(tid * 16 + i * 8192, R, C); voff[i] = (unsigned)(R * K + C) * 2u; }
    const size_t kstep = (size_t)(BK * 2);
    const size_t hstep = (size_t)HALF * K * 2;
    const unsigned ldsw = (unsigned)wid * 1024u;
    const int aoff = lds_byte(wr * 64 + fr, fq * 8), boff = lds_byte(wc * 32 + fr, fq * 8);
#define PG8_SA(b, h) (((b) * 2 + (h)) * HTB)
#define PG8_SB(b, h) ((4 + (b) * 2 + (h)) * HTB)
#define PG8_STAGE(bufoff, gbase) do { _Pragma("unroll") for (int _i = 0; _i < 2; ++_i) \
        __builtin_amdgcn_global_load_lds((const unsigned*)((const char*)(gbase) + voff[_i]), (LAS unsigned*)(lds + (bufoff) + ldsw + _i * 8192), 16, 0, 0); } while (0)
#define PG8_LDA(dst, b, h) do { _Pragma("unroll") for (int m = 0; m < 4; ++m) _Pragma("unroll") for (int k = 0; k < 2; ++k) dst[m][k] = *(const LAS bf16x8*)(lds + PG8_SA(b, h) + aoff + m * 2048 + k * 1024); } while (0)
#define PG8_LDB(dst, b, h) do { _Pragma("unroll") for (int n = 0; n < 2; ++n) _Pragma("unroll") for (int k = 0; k < 2; ++k) dst[n][k] = *(const LAS bf16x8*)(lds + PG8_SB(b, h) + boff + n * 2048 + k * 1024); } while (0)
#define PG8_MMA(ai, bj, At, Bt) do { __builtin_amdgcn_s_setprio(1); _Pragma("unroll") for (int m = 0; m < 4; ++m) _Pragma("unroll") for (int n = 0; n < 2; ++n) _Pragma("unroll") for (int k = 0; k < 2; ++k) \
        acc[ai][bj][m][n] = __builtin_amdgcn_mfma_f32_16x16x32_bf16(Bt[n][k], At[m][k], acc[ai][bj][m][n], 0, 0, 0); __builtin_amdgcn_s_setprio(0); } while (0)
#define PG8_WAIT_V(n) asm volatile("s_waitcnt vmcnt(" #n ")" ::: "memory")
#define PG8_WAIT_L(n) asm volatile("s_waitcnt lgkmcnt(" #n ")" ::: "memory")
#define PG8_BAR __builtin_amdgcn_s_barrier()
#define PG8_SCHED __builtin_amdgcn_sched_barrier(0)
    GUnit cur, nxt; int ui = 0;
    if (!S.next(0, cur)) return;
    (void)delay_ticks;
    f32x4 acc[2][2][4][2];
#pragma unroll
    for (int a = 0; a < 2; ++a)
#pragma unroll
        for (int b = 0; b < 2; ++b)
#pragma unroll
            for (int m = 0; m < 4; ++m)
#pragma unroll
                for (int n = 0; n < 2; ++n) acc[a][b][m][n] = (f32x4){0.f, 0.f, 0.f, 0.f};
    bf16x8 At[4][2], B0[2][2], B1[2][2];
    const char* cA = cur.a; const char* cB = cur.b;
    PG8_STAGE(PG8_SB(0, 0), cB); PG8_STAGE(PG8_SA(0, 0), cA); PG8_STAGE(PG8_SB(0, 1), cB + hstep); PG8_STAGE(PG8_SA(0, 1), cA + hstep);
    if (wr == 1) PG8_BAR;
    PG8_WAIT_V(4); PG8_BAR;
    PG8_STAGE(PG8_SB(1, 0), cB + kstep); PG8_STAGE(PG8_SA(1, 0), cA + kstep); PG8_STAGE(PG8_SB(1, 1), cB + hstep + kstep);
    PG8_WAIT_V(6); PG8_BAR;
    for (;;) {
        const bool has_next = S.next(ui + 1, nxt);
        const char* nA = has_next ? nxt.a : cA; const char* nB = has_next ? nxt.b : cB;
        const int cnt = cur.nt;
        for (int t = 0; t < cnt; t += 2) {
            const bool last = (t == cnt - 2);
            const char* a1 = cA + (size_t)(t + 1) * kstep;
            const char* a2 = last ? nA : cA + (size_t)(t + 2) * kstep; const char* b2 = last ? nB : cB + (size_t)(t + 2) * kstep;
            const char* a3 = a2 + kstep; const char* b3 = b2 + kstep;
            PG8_LDB(B0, 0, 0); PG8_SCHED; PG8_LDA(At, 0, 0); PG8_STAGE(PG8_SA(1, 1), a1 + hstep);
            PG8_WAIT_L(8); PG8_BAR; PG8_WAIT_L(0); PG8_MMA(0, 0, At, B0); PG8_BAR; PG8_SCHED;
            PG8_LDB(B1, 0, 1); PG8_STAGE(PG8_SB(0, 0), b2);
            PG8_BAR; PG8_WAIT_L(0); PG8_MMA(0, 1, At, B1); PG8_BAR;
            PG8_LDA(At, 0, 1); PG8_STAGE(PG8_SA(0, 0), a2);
            PG8_BAR; PG8_WAIT_L(0); PG8_MMA(1, 0, At, B0); PG8_BAR; PG8_SCHED;
            PG8_STAGE(PG8_SB(0, 1), b2 + hstep);
            PG8_WAIT_V(6); PG8_BAR; PG8_MMA(1, 1, At, B1); PG8_BAR;
            PG8_LDB(B0, 1, 0); PG8_SCHED; PG8_LDA(At, 1, 0); PG8_STAGE(PG8_SA(0, 1), a2 + hstep);
            PG8_WAIT_L(8); PG8_BAR; PG8_WAIT_L(0); PG8_MMA(0, 0, At, B0); PG8_BAR; PG8_SCHED;
            PG8_LDB(B1, 1, 1); PG8_STAGE(PG8_SB(1, 0), b3);
            PG8_BAR; PG8_WAIT_L(0); PG8_MMA(0, 1, At, B1); PG8_BAR;
            PG8_LDA(At, 1, 1); PG8_STAGE(PG8_SA(1, 0), a3);
            PG8_BAR; PG8_WAIT_L(0); PG8_MMA(1, 0, At, B0); PG8_BAR; PG8_SCHED;
            PG8_STAGE(PG8_SB(1, 1), b3 + hstep);
            PG8_WAIT_V(6); PG8_BAR; PG8_MMA(1, 1, At, B1); PG8_BAR;
        }
        E(acc, cur, wr, wc, fr, fq);
        if (!has_next) break;
#pragma unroll
        for (int a = 0; a < 2; ++a)
#pragma unroll
            for (int b = 0; b < 2; ++b)
#pragma unroll
                for (int m = 0; m < 4; ++m)
#pragma unroll
                    for (int n = 0; n < 2; ++n) acc[a][b][m][n] = (f32x4){0.f, 0.f, 0.f, 0.f};
        cur = nxt; cA = nA; cB = nB; ++ui;
    }
    PG8_WAIT_V(0);
    if (wr == 0) PG8_BAR;
    PG8_BAR;
#undef PG8_SA
#undef PG8_SB
#undef PG8_STAGE
#undef PG8_LDA
#undef PG8_LDB
#undef PG8_MMA
#undef PG8_WAIT_V
#undef PG8_WAIT_L
#undef PG8_BAR
#undef PG8_SCHED
}

__device__ __forceinline__ void mod_item(LAS unsigned char* lds, int item) {
    const KArgP pp = kargs(); const float* p_c = pp->c; const float* p_cctx = pp->c_ctx; const float* p_wmod = pp->w_mod; const float* p_bmod = pp->b_mod; unsigned char* p_ws = pp->ws;
    const int tid = fresh_tid(), lane = tid & 63, wave = tid >> 6;
    const int l = item / 72, n0 = (item % 72) * 128;
    LAS float* sil = (LAS float*)lds;
    __syncthreads();
    for (int idx = tid; idx < 17 * 1024; idx += 512) {
        const int r = idx >> 10, k = idx & 1023;
        const float v = (r < 16) ? p_c[r * 1024 + k] : p_cctx[k];
        sil[k * 20 + r] = v / (1.0f + __expf(-v));
    }
    __syncthreads();
    const int cgp = tid & 31, ksl = tid >> 5;
    f32x4 acc[17];
#pragma unroll
    for (int r = 0; r < 17; ++r) acc[r] = (f32x4){0.f, 0.f, 0.f, 0.f};
    const float* wp = p_wmod + ((size_t)l * 1024 + (size_t)ksl * 64) * NMODC + n0 + 4 * cgp;
#pragma unroll 4
    for (int kk = 0; kk < 64; ++kk) {
        const f32x4 w = *(const f32x4*)(wp + (size_t)kk * NMODC);
        const LAS float* sp = sil + (ksl * 64 + kk) * 20;
        const f32x4 s0 = *(const LAS f32x4*)(sp), s1 = *(const LAS f32x4*)(sp + 4), s2 = *(const LAS f32x4*)(sp + 8), s3 = *(const LAS f32x4*)(sp + 12);
        const float s16 = sp[16];
#pragma unroll
        for (int j = 0; j < 4; ++j) { acc[j] += w * s0[j]; acc[4 + j] += w * s1[j]; acc[8 + j] += w * s2[j]; acc[12 + j] += w * s3[j]; }
        acc[16] += w * s16;
    }
#pragma unroll
    for (int r = 0; r < 17; ++r)
#pragma unroll
        for (int j = 0; j < 4; ++j) acc[r][j] += shx(acc[r][j], 32, lane);
    __syncthreads();
    LAS float* red = (LAS float*)lds;
    if (lane < 32) {
#pragma unroll
        for (int r = 0; r < 17; ++r) *(LAS f32x4*)(red + (wave * 17 + r) * 128 + 4 * cgp) = acc[r];
    }
    __syncthreads();
    float* modp = (float*)(p_ws + OFF_MOD);
    for (int o = tid; o < 17 * 128; o += 512) {
        const int r = o >> 7, cc = o & 127;
        float s = p_bmod[l * NMODC + n0 + cc];
#pragma unroll
        for (int w = 0; w < 8; ++w) s += red[(w * 17 + r) * 128 + cc];
        modp[((size_t)l * 17 + r) * NMODC + n0 + cc] = s;
    }
    __syncthreads();
}

__device__ __forceinline__ void conv_tile(LAS unsigned char* lds, int idx) {
    const KArgP p = kargs();
    const int tid = fresh_tid();
    const float* src; bf16_t* dst; int Nsrc, K, ntile, kg, type, l;
    if (idx < 2816) { const int mat = idx / 352, rem = idx % 352; ntile = rem >> 2; kg = rem & 3; l = mat >> 1; type = 0;
        src = ((mat & 1) ? p->w_gu2 : p->w_gu1) + (size_t)l * D * NGU; Nsrc = NGU; K = D; dst = (bf16_t*)(p->ws + OFF_WGU) + (size_t)mat * NGU * D; }
    else if (idx < 2816 + 1408) { const int i2 = idx - 2816; const int mat = i2 / 176, rem = i2 % 176; ntile = rem / 11; kg = rem % 11; l = mat >> 1; type = 1;
        src = ((mat & 1) ? p->w_dn2 : p->w_dn1) + (size_t)l * DFF * D; Nsrc = D; K = DFF; dst = (bf16_t*)(p->ws + OFF_WDN) + (size_t)mat * D * DFF; }
    else if (idx < 2816 + 1408 + 640) { const int i2 = idx - 4224; l = i2 / 160; const int rem = i2 % 160; ntile = rem >> 2; kg = rem & 3; type = 2;
        src = p->w_in + (size_t)l * D * INC; Nsrc = INC; K = D; dst = (bf16_t*)(p->ws + OFF_WIN) + (size_t)l * INC * D; }
    else { const int i2 = idx - 4864; l = i2 >> 6; const int rem = i2 & 63; ntile = rem >> 2; kg = rem & 3; type = 3;
        src = p->w_out + (size_t)l * D * D; Nsrc = D; K = D; dst = (bf16_t*)(p->ws + OFF_WOUT) + (size_t)l * D * D; }
    const int n0 = ntile * 64, k0 = kg * 256;
    LAS float* tile = (LAS float*)lds;
    const int c4 = tid & 15, kk = tid >> 4;
    const int np = n0 + 4 * c4;
    int fcol;
    if (type == 0) { const int s = np & 255; fcol = (s >> 7) * DFF + 128 * (np >> 8) + 32 * ((s >> 5) & 3) + 8 * ((s >> 2) & 3) + 4 * ((s >> 4) & 1); }
    else if (type == 2) {
        if (np < 2048) { const int t8 = np >> 8, s = np & 255, R = s & 127; const int colbase = (t8 < 4) ? t8 * 256 : 1536 + (t8 - 4) * 256; fcol = colbase + 64 * (R >> 5) + 32 * (s >> 7) + (R & 31); }
        else fcol = 1024 + (np - 2048);
    } else fcol = np;
    __syncthreads();
    if (type == 3 && k0 >= 768) {
#pragma unroll 1
        for (int g = 0; g < 4; ++g)
#pragma unroll
            for (int hlf = 0; hlf < 2; ++hlf) {
                const int k = kk + 32 * hlf;
                const float* pw = p->pool_w + ((size_t)(l * 4 + g) * 64 + k) * 64;
                const float* sc = p->pool_scale + l * 256 + g * 64;
                const float* ws = src + (size_t)(768 + g * 64) * D + fcol;
                f32x4 v = (f32x4){0.f, 0.f, 0.f, 0.f};
                for (int d = 0; d < 64; ++d) v += *(const f32x4*)(ws + (size_t)d * D) * (pw[d] * sc[d]);
                LAS float* tp = tile + g * 4160 + k * 65 + 4 * c4;
                tp[0] = v[0]; tp[1] = v[1]; tp[2] = v[2]; tp[3] = v[3];
            }
    } else {
        f32x4 v[8];
#pragma unroll
        for (int q = 0; q < 8; ++q) v[q] = *(const f32x4*)(src + (size_t)(k0 + kk + 32 * q) * Nsrc + fcol);
#pragma unroll
        for (int q = 0; q < 8; ++q) {
            LAS float* tp = tile + (q >> 1) * 4160 + (kk + 32 * (q & 1)) * 65 + 4 * c4;
            tp[0] = v[q][0]; tp[1] = v[q][1]; tp[2] = v[q][2]; tp[3] = v[q][3];
        }
    }
    __syncthreads();
    const int n = tid >> 3, kseg = (tid & 7) * 8;
#pragma unroll
    for (int g = 0; g < 4; ++g) {
        float f[8];
#pragma unroll
        for (int i = 0; i < 8; ++i) f[i] = tile[g * 4160 + (kseg + i) * 65 + n];
        u32x4 w; w.x = cvt_pk_bf16(f[0], f[1]); w.y = cvt_pk_bf16(f[2], f[3]); w.z = cvt_pk_bf16(f[4], f[5]); w.w = cvt_pk_bf16(f[6], f[7]);
        *(u32x4*)(dst + (size_t)(n0 + n) * K + k0 + g * 64 + kseg) = w;
    }
}

__device__ __forceinline__ void rope_item() {
    float* cosT = (float*)(kargs()->ws + OFF_ROPE); float* sinT = cosT + 1024;
    for (int idx = threadIdx.x; idx < 1024; idx += 512) {
        const int pos = idx >> 4, f = idx & 15, fm = f & 3, fqd = f >> 2;
        double inv = (fm == 0) ? 1.0 : (fm == 1) ? 0.5623413251903491 : (fm == 2) ? 0.31622776601683794 : 0.1778279410038923;
        inv *= (fqd == 0) ? 1.0 : (fqd == 1) ? 0.1 : (fqd == 2) ? 0.01 : 0.001;
        const double a = (double)((float)pos * (float)inv);
        const double twopi = 6.283185307179586476925;
        const double nrev = __builtin_rint(a / twopi);
        const double x = a - nrev * twopi, x2 = x * x;
        double sn = 0.0, cs = 0.0, ts = x, tc = 1.0;
#pragma unroll 1
        for (int i = 0; i < 16; ++i) { cs += tc; sn += ts; tc = -tc * x2 / (double)((2 * i + 1) * (2 * i + 2)); ts = -ts * x2 / (double)((2 * i + 2) * (2 * i + 3)); }
        cosT[idx] = (float)cs; sinT[idx] = (float)sn;
    }
}

__device__ __forceinline__ void prep_rows(const float* xp, float* dp, const bf16_t* y0, const bf16_t* yc, bf16_t* ap, int n, const f32x4 (&nwv)[4], const f32x4 (&sc)[4], const f32x4 (&sh)[4], int lane) {
    for (int i = 0; i < n; ++i) {
        f32x4 x[4]; float ss = 0.f;
#pragma unroll
        for (int q = 0; q < 4; ++q) x[q] = *(const f32x4*)(xp + (size_t)i * D + 4 * lane + 256 * q);
        if (y0) {
#pragma unroll
            for (int q = 0; q < 4; ++q) { const u32x2 w = *(const u32x2*)(y0 + (size_t)i * D + 4 * lane + 256 * q); x[q] += (f32x4){bf_lo(w.x), bf_hi(w.x), bf_lo(w.y), bf_hi(w.y)}; }
        }
        if (yc) {
#pragma unroll
            for (int sp = 0; sp < 3; ++sp)
#pragma unroll
                for (int q = 0; q < 4; ++q) { const u32x2 w = *(const u32x2*)(yc + (size_t)sp * NCTX * D + (size_t)i * D + 4 * lane + 256 * q); x[q] += (f32x4){bf_lo(w.x), bf_hi(w.x), bf_lo(w.y), bf_hi(w.y)}; }
        }
#pragma unroll
        for (int q = 0; q < 4; ++q) ss += x[q][0] * x[q][0] + x[q][1] * x[q][1] + x[q][2] * x[q][2] + x[q][3] * x[q][3];
        if (dp) {
#pragma unroll
            for (int q = 0; q < 4; ++q) *(f32x4*)(dp + (size_t)i * D + 4 * lane + 256 * q) = x[q];
        }
        ss = wave_sum(ss, lane);
        const float rstd = rsqrtf(ss * (1.0f / 1024.0f) + 1e-6f);
#pragma unroll
        for (int q = 0; q < 4; ++q) {
            const f32x4 y = (x[q] * rstd * nwv[q]) * sc[q] + sh[q];
            u32x2 w; w.x = cvt_pk_bf16(y[0], y[1]); w.y = cvt_pk_bf16(y[2], y[3]);
            *(u32x2*)(ap + (size_t)i * D + 4 * lane + 256 * q) = w;
        }
    }
}
__device__ __forceinline__ void prep_phase(const float* src_lat, const float* src_ctx, float* dst_lat, float* dst_ctx, const bf16_t* Y0, const bf16_t* Yc, bool ctx_split,
                                           bf16_t* A, const float* nw, const float* modl, int shift_i, int scale_i, bool with_ctx) {
    const int tid = fresh_tid();
    const int lane = tid & 63, gw = blockIdx.x * 8 + (tid >> 6);
    f32x4 nwv[4], sc[4], sh[4];
#pragma unroll
    for (int q = 0; q < 4; ++q) nwv[q] = *(const f32x4*)(nw + 4 * lane + 256 * q);
    {
        const int row0 = gw * 16, mr = row0 >> 11;
#pragma unroll
        for (int q = 0; q < 4; ++q) {
            sc[q] = *(const f32x4*)(modl + (size_t)mr * NMODC + scale_i * 1024 + 4 * lane + 256 * q) + 1.0f;
            sh[q] = *(const f32x4*)(modl + (size_t)mr * NMODC + shift_i * 1024 + 4 * lane + 256 * q);
        }
        prep_rows(src_lat + (size_t)row0 * D, nullptr, nullptr, nullptr, A + (size_t)row0 * D, 16, nwv, sc, sh, lane);
    }
    if (with_ctx) {
        const int crow0 = gw * 2;
#pragma unroll
        for (int q = 0; q < 4; ++q) {
            sc[q] = *(const f32x4*)(modl + (size_t)16 * NMODC + scale_i * 1024 + 4 * lane + 256 * q) + 1.0f;
            sh[q] = *(const f32x4*)(modl + (size_t)16 * NMODC + shift_i * 1024 + 4 * lane + 256 * q);
        }
        prep_rows(src_ctx + (size_t)crow0 * D, ctx_split ? dst_ctx + (size_t)crow0 * D : nullptr, nullptr, ctx_split ? Yc + (size_t)crow0 * D : nullptr,
                  A + (size_t)(NLAT + crow0) * D, 2, nwv, sc, sh, lane);
    }
}

__device__ __forceinline__ void attn_item(LAS unsigned char* lds, const bf16_t* Q, const bf16_t* KB, const bf16_t* VT, bf16_t* MIX,
                                          int b, int h, int qrow0, int key0, int nkeys, float lam, float negM, const float* subw, float post_scale) {
    const int tid = fresh_tid(), lane = tid & 63, wave = tid >> 6, r = lane & 31, h2 = lane >> 5;
    f32x16 O[2][4];
#pragma unroll
    for (int i = 0; i < 2; ++i)
#pragma unroll
        for (int et = 0; et < 4; ++et)
#pragma unroll
            for (int j = 0; j < 16; ++j) O[i][et][j] = 0.f;
    float ls0 = 0.f, ls1 = 0.f;
    const char* kg = (const char*)(KB + ((size_t)(b * NKEYS + key0)) * 512 + h * 128);
    const char* vg = (const char*)(VT + ((size_t)(b * 512 + h * 128)) * NKEYS + key0);
    const int wu = __builtin_amdgcn_readfirstlane(wave);
    const int nt = nkeys >> 6;
#define ATT_STAGE(t_, bufo_) do { int ln = lane; asm volatile("" : "+v"(ln)); _Pragma("unroll") for (int _i = 0; _i < 2; ++_i) { const int pc = wu + 8 * _i; \
        const int key = pc * 4 + (ln >> 4), c = (ln & 15) ^ (key & 15); const unsigned kgo = (unsigned)(key * 1024 + c * 16); \
        const int e = pc * 8 + (ln >> 3), cv = (ln & 7) ^ ((e >> 1) & 7); const unsigned vgo = (unsigned)(e * (NKEYS * 2) + cv * 16); \
        __builtin_amdgcn_global_load_lds((const unsigned*)(kg + (size_t)(t_) * 65536 + kgo), (LAS unsigned*)(lds + (bufo_) + pc * 1024), 16, 0, 0); \
        __builtin_amdgcn_global_load_lds((const unsigned*)(vg + (size_t)(t_) * 128 + vgo), (LAS unsigned*)(lds + (bufo_) + 16384 + pc * 1024), 16, 0, 0); } } while (0)
    __syncthreads();
    {
        const char* qg = (const char*)(Q + (size_t)qrow0 * 512 + h * 128);
#pragma unroll
        for (int i = 0; i < 8; ++i) {
            const int pq = wu * 8 + i, row = pq * 4 + (lane >> 4), c = (lane & 15) ^ (row & 15);
            __builtin_amdgcn_global_load_lds((const unsigned*)(qg + (size_t)row * 1024 + c * 16), (LAS unsigned*)(lds + 65536 + pq * 1024), 16, 0, 0);
        }
    }
    ATT_STAGE(0, 0);
    asm volatile("s_waitcnt vmcnt(0)" ::: "memory");
    __syncthreads();
    const int rs = (r & 0x13) | ((r & 4) << 1) | ((r & 8) >> 1);
    const int qrow = wave * 32 + r, qx = qrow & 15;
    const int kx = rs & 15;
    const LAS unsigned char* qbase = lds + 65536 + qrow * 256;
#define SB() __builtin_amdgcn_sched_barrier(0)
#define LD_QK(i_, kb_, kf_, qf_) do { _Pragma("unroll") for (int ks = 0; ks < 4; ++ks) { \
        kf_[ks] = *(const LAS bf16x8*)(Kb + ((kb_) * 32 + rs) * 256 + ((((i_) * 8 + ks * 2 + h2) ^ kx) << 4)); \
        qf_[ks] = *(const LAS bf16x8*)(qbase + ((((i_) * 8 + ks * 2 + h2) ^ qx) << 4)); } } while (0)
#define MM_S(Sv_, kf_, qf_) do { _Pragma("unroll") for (int j = 0; j < 16; ++j) Sv_[j] = negM; \
        _Pragma("unroll") for (int ks = 0; ks < 4; ++ks) Sv_ = __builtin_amdgcn_mfma_f32_32x32x16_bf16(kf_[ks], qf_[ks], Sv_, 0, 0, 0); } while (0)
#define EXP_P(Sv_, ls_, pf_) do { float psum = 0.f; _Pragma("unroll") for (int j = 0; j < 16; ++j) { Sv_[j] = __builtin_amdgcn_exp2f(Sv_[j]); psum += Sv_[j]; } ls_ += psum; \
        _Pragma("unroll") for (int sq = 0; sq < 2; ++sq) { u32x4 w; w.x = cvt_pk_bf16(Sv_[8 * sq + 0], Sv_[8 * sq + 1]); w.y = cvt_pk_bf16(Sv_[8 * sq + 2], Sv_[8 * sq + 3]); \
            w.z = cvt_pk_bf16(Sv_[8 * sq + 4], Sv_[8 * sq + 5]); w.w = cvt_pk_bf16(Sv_[8 * sq + 6], Sv_[8 * sq + 7]); pf_[sq] = __builtin_bit_cast(bf16x8, w); } } while (0)
#define LD_V(hf_, kb_, vf_) do { _Pragma("unroll") for (int el = 0; el < 2; ++el) { const int e = ((hf_) * 2 + el) * 32 + r, ex = (e >> 1) & 7; \
        _Pragma("unroll") for (int sq = 0; sq < 2; ++sq) vf_[el][sq] = *(const LAS bf16x8*)(Vb + e * 128 + ((((kb_) * 4 + sq * 2 + h2) ^ ex) << 4)); } } while (0)
#define MM_PV(hf_, vf_) do { _Pragma("unroll") for (int el = 0; el < 2; ++el) _Pragma("unroll") for (int sq = 0; sq < 2; ++sq) { \
        O[0][(hf_) * 2 + el] = __builtin_amdgcn_mfma_f32_32x32x16_bf16(vf_[el][sq], pf0[sq], O[0][(hf_) * 2 + el], 0, 0, 0); \
        O[1][(hf_) * 2 + el] = __builtin_amdgcn_mfma_f32_32x32x16_bf16(vf_[el][sq], pf1[sq], O[1][(hf_) * 2 + el], 0, 0, 0); } } while (0)
    for (int t = 0; t < nt; ++t) {
        const bool more = (t + 1 < nt);
        if (more) ATT_STAGE(t + 1, ((t + 1) & 1) * 32768);
        const LAS unsigned char* Kb = lds + (t & 1) * 32768;
        const LAS unsigned char* Vb = Kb + 16384;
        bf16x8 kfa[4], qfa[4], va[2][2], pf0[2], pf1[2];
        f32x16 S0, S1;
#pragma unroll 1
        for (int kb = 0; kb < 2; ++kb) {
            LD_QK(0, kb, kfa, qfa);
            SB(); MM_S(S0, kfa, qfa);
            SB(); LD_QK(1, kb, kfa, qfa);
            SB(); MM_S(S1, kfa, qfa); EXP_P(S0, ls0, pf0);
            SB(); LD_V(0, kb, va); EXP_P(S1, ls1, pf1);
            SB(); MM_PV(0, va); LD_V(1, kb, va);
            SB(); MM_PV(1, va);
        }
        SB();
        asm volatile("s_waitcnt vmcnt(0)" ::: "memory");
        __syncthreads();
    }
#undef SB
#undef LD_QK
#undef MM_S
#undef EXP_P
#undef LD_V
#undef MM_PV
    const int tid2 = fresh_tid(), lane2 = tid2 & 63, wave2 = tid2 >> 6, r2 = lane2 & 31, h2b = lane2 >> 5;
    ls0 += shx(ls0, 32, lane2); ls1 += shx(ls1, 32, lane2);
    const float inv1 = 1.0f / ls0, inv2 = lam / ls1;
    float ss = 0.f;
#pragma unroll
    for (int et = 0; et < 4; ++et)
#pragma unroll
        for (int j = 0; j < 16; ++j) { const float o = O[0][et][j] * inv1 - O[1][et][j] * inv2; O[0][et][j] = o; ss += o * o; }
    ss += shx(ss, 32, lane2);
    float li_ = post_scale; asm volatile("" : "+s"(li_));
    const float rstd = rsqrtf(ss * (1.0f / 128.0f) + 1e-6f) * (1.0f - li_);
    bf16_t* op = MIX + (size_t)(qrow0 + wave2 * 32 + r2) * 1024 + h * 128 + 4 * h2b;
#pragma unroll
    for (int et = 0; et < 4; ++et)
#pragma unroll
        for (int g4 = 0; g4 < 4; ++g4) {
            const int e0 = 32 * et + 8 * g4;
            const f32x4 w4 = *(const f32x4*)(subw + e0 + 4 * h2b);
            u32x2 w; w.x = cvt_pk_bf16(O[0][et][4 * g4 + 0] * rstd * w4[0], O[0][et][4 * g4 + 1] * rstd * w4[1]);
            w.y = cvt_pk_bf16(O[0][et][4 * g4 + 2] * rstd * w4[2], O[0][et][4 * g4 + 3] * rstd * w4[3]);
            *(u32x2*)(op + e0) = w;
        }
}

template <int H>
__device__ __forceinline__ void pool_task(const bf16_t* er, bf16_t* outp, int t, int L) {
    u32x4 v[2 * H];
    int cnt = 0;
#pragma unroll
    for (int i = 0; i < 2 * H; ++i) { const int tt = t + i - H; const bool ok = (tt >= 0) && (tt < L); cnt += ok ? 1 : 0; v[i] = *(const u32x4*)(er + (ok ? (i - H) : 0) * 1024); if (!ok) v[i] = (u32x4){0u, 0u, 0u, 0u}; }
    const u32x4 sv = *(const u32x4*)(er);
    float sm[8];
#pragma unroll
    for (int j = 0; j < 8; ++j) sm[j] = 0.f;
#pragma unroll
    for (int i = 0; i < 2 * H; ++i) {
        sm[0] += bf_lo(v[i].x); sm[1] += bf_hi(v[i].x); sm[2] += bf_lo(v[i].y); sm[3] += bf_hi(v[i].y);
        sm[4] += bf_lo(v[i].z); sm[5] += bf_hi(v[i].z); sm[6] += bf_lo(v[i].w); sm[7] += bf_hi(v[i].w);
    }
    const float ic = 1.0f / (float)cnt;
    u32x4 w;
    w.x = cvt_pk_bf16(sm[0] * ic - bf_lo(sv.x), sm[1] * ic - bf_hi(sv.x)); w.y = cvt_pk_bf16(sm[2] * ic - bf_lo(sv.y), sm[3] * ic - bf_hi(sv.y));
    w.z = cvt_pk_bf16(sm[4] * ic - bf_lo(sv.z), sm[5] * ic - bf_hi(sv.z)); w.w = cvt_pk_bf16(sm[6] * ic - bf_lo(sv.w), sm[7] * ic - bf_hi(sv.w));
    *(u32x4*)outp = w;
}

__device__ __forceinline__ void ew_rows(const bf16_t* EW, bf16_t* MIX, const float* convw, int row0, int nrows) {
    const int tid = fresh_tid();
    for (int task = tid; task < nrows * 32; task += 512) {
        const int row = row0 + (task >> 5), c0 = (task & 31) * 8;
        int t, L; if (row < NLAT) { t = row & (SEQ - 1); L = SEQ; } else { t = (row - NLAT) & (LCTX - 1); L = LCTX; }
        const bf16_t* er = EW + (size_t)row * 1024;
        u32x4 cc[3], cx[3]; f32x4 wa[3], wb[3];
#pragma unroll
        for (int i = 0; i < 3; ++i) {
            const int dt = i - 1; const bool ok = (t + dt >= 0) && (t + dt < L);
            const bf16_t* rp = er + (ok ? dt : 0) * 1024;
            cc[i] = *(const u32x4*)(rp + 256 + c0); cx[i] = *(const u32x4*)(rp + 512 + c0);
            const float m = ok ? 1.0f : 0.0f;
            wa[i] = *(const f32x4*)(convw + i * 256 + c0) * m; wb[i] = *(const f32x4*)(convw + i * 256 + c0 + 4) * m;
        }
        const u32x4 cb = *(const u32x4*)(er + c0);
        float accv[8];
#pragma unroll
        for (int j = 0; j < 8; ++j) accv[j] = 0.f;
#pragma unroll
        for (int i = 0; i < 3; ++i) {
            accv[0] += bf_lo(cc[i].x) * bf_lo(cx[i].x) * wa[i][0]; accv[1] += bf_hi(cc[i].x) * bf_hi(cx[i].x) * wa[i][1];
            accv[2] += bf_lo(cc[i].y) * bf_lo(cx[i].y) * wa[i][2]; accv[3] += bf_hi(cc[i].y) * bf_hi(cx[i].y) * wa[i][3];
            accv[4] += bf_lo(cc[i].z) * bf_lo(cx[i].z) * wb[i][0]; accv[5] += bf_hi(cc[i].z) * bf_hi(cx[i].z) * wb[i][1];
            accv[6] += bf_lo(cc[i].w) * bf_lo(cx[i].w) * wb[i][2]; accv[7] += bf_hi(cc[i].w) * bf_hi(cx[i].w) * wb[i][3];
        }
        u32x4 w;
        w.x = cvt_pk_bf16(bf_lo(cb.x) * accv[0], bf_hi(cb.x) * accv[1]); w.y = cvt_pk_bf16(bf_lo(cb.y) * accv[2], bf_hi(cb.y) * accv[3]);
        w.z = cvt_pk_bf16(bf_lo(cb.z) * accv[4], bf_hi(cb.z) * accv[5]); w.w = cvt_pk_bf16(bf_lo(cb.w) * accv[6], bf_hi(cb.w) * accv[7]);
        *(u32x4*)(MIX + (size_t)row * 1024 + 512 + c0) = w;
    }
    for (int task = tid; task < nrows * 32; task += 512) {
        const int s8 = task & 7, q3 = task >> 3, g = q3 / nrows, row = row0 + (q3 - g * nrows), c0 = (g * 8 + s8) * 8;
        int t, L; if (row < NLAT) { t = row & (SEQ - 1); L = SEQ; } else { t = (row - NLAT) & (LCTX - 1); L = LCTX; }
        const bf16_t* er = EW + (size_t)row * 1024 + 768 + c0;
        const int gu = __builtin_amdgcn_readfirstlane(g);
        if (gu == 0) pool_task<1>(er, MIX + (size_t)row * 1024 + 768 + c0, t, L);
        else if (gu == 1) pool_task<2>(er, MIX + (size_t)row * 1024 + 768 + c0, t, L);
        else if (gu == 2) pool_task<4>(er, MIX + (size_t)row * 1024 + 768 + c0, t, L);
        else pool_task<8>(er, MIX + (size_t)row * 1024 + 768 + c0, t, L);
    }
}


#define XB_TMO      128
#define XB_XCNT(j)  (256  + 64 * (j))
#define XB_XSUB(j)  (1280 + 64 * (j))
#define XB_XGEN(j)  (2304 + 64 * (j))
#define XB_TOP      3328
#define XB_TOPGEN   3392
#define XCD_BAR_WORDS 3456
#define XB_SPIN_CAP (1u << 22)
__device__ __forceinline__ unsigned xb_ld(unsigned* p)              { return __hip_atomic_load(p, __ATOMIC_RELAXED, __HIP_MEMORY_SCOPE_AGENT); }
__device__ __forceinline__ unsigned xb_add(unsigned* p, unsigned v) { return __hip_atomic_fetch_add(p, v, __ATOMIC_RELAXED, __HIP_MEMORY_SCOPE_AGENT); }
__device__ __forceinline__ unsigned xb_xcc_id() { return (unsigned)__builtin_amdgcn_s_getreg((3 << 11) | 20) & 0xFu; }
#define XB_SPIN(cond, bar) do { unsigned _sp = 0; while (cond) { __builtin_amdgcn_s_sleep(1); \
    if ((++_sp & 255u) == 0u) { if (xb_ld(&(bar)[XB_TMO])) break; if (_sp > XB_SPIN_CAP) { atomicAdd(&(bar)[XB_TMO], 1u); break; } } } } while (0)
struct XcdBarrier { unsigned* bar; unsigned x; volatile LAS unsigned* st; };
__device__ __forceinline__ XcdBarrier xcd_barrier_post(unsigned* bar, volatile LAS unsigned* st) {
    XcdBarrier b; b.bar = bar; b.x = xb_xcc_id(); b.st = st;
    if (threadIdx.x == 0) (void)xb_add(&bar[XB_XCNT(b.x)], 1u);
    return b;
}
__device__ __forceinline__ void xcd_barrier_complete(unsigned* bar, unsigned x, unsigned& nloc, unsigned& nx) {
    const unsigned G = gridDim.x * gridDim.y * gridDim.z;
    unsigned sum, cnt, mine, sp = 0u;
    for (;;) {
        sum = 0u; cnt = 0u; mine = 0u;
#pragma unroll
        for (unsigned j = 0; j < 16; ++j) { const unsigned c = xb_ld(&bar[XB_XCNT(j)]); sum += c; cnt += (c > 0u) ? 1u : 0u; mine = (j == x) ? c : mine; }
        if (sum == G) break;
        __builtin_amdgcn_s_sleep(1);
        if ((++sp & 255u) == 0u) { if (xb_ld(&bar[XB_TMO])) break; if (sp > XB_SPIN_CAP) { atomicAdd(&bar[XB_TMO], 1u); break; } }
    }
    nloc = mine > 0u ? mine : 1u; nx = cnt > 0u ? cnt : 1u;
}
__device__ __forceinline__ void xcd_barrier(const XcdBarrier& b) {
    asm volatile("s_waitcnt vmcnt(0)" ::: "memory");
    __syncthreads();
    if (threadIdx.x == 0) {
        unsigned* bar = b.bar;
        __builtin_amdgcn_s_waitcnt(0);
        unsigned nloc = b.st[0], nx = b.st[1];
        if (nloc == 0u) { xcd_barrier_complete(bar, b.x, nloc, nx); b.st[0] = nloc; b.st[1] = nx; }
        const unsigned old = xb_add(&bar[XB_XSUB(b.x)], 1u);
        const unsigned gen = old / nloc;
        if (old + 1u == (gen + 1u) * nloc) {
            __builtin_amdgcn_fence(__ATOMIC_RELEASE, "agent");
            asm volatile("s_waitcnt vmcnt(0)" ::: "memory");
            const unsigned og = xb_add(&bar[XB_TOP], 1u);
            const unsigned tg = og / nx;
            if (og + 1u == (tg + 1u) * nx) xb_add(&bar[XB_TOPGEN], 1u);
            else XB_SPIN(xb_ld(&bar[XB_TOPGEN]) == tg, bar);
            __builtin_amdgcn_fence(__ATOMIC_ACQUIRE, "agent");
            xb_add(&bar[XB_XGEN(b.x)], 1u);
            asm volatile("s_waitcnt vmcnt(0)" ::: "memory");
        } else {
            XB_SPIN(xb_ld(&bar[XB_XGEN(b.x)]) == gen, bar);
            __builtin_amdgcn_fence(__ATOMIC_ACQUIRE, "agent");
            asm volatile("s_waitcnt vmcnt(0)" ::: "memory");
        }
    }
    __syncthreads();
}

__global__ void __launch_bounds__(512, 2) hymba_mega(Params p_unused) {
    extern __shared__ __attribute__((aligned(16))) unsigned char lds_raw[];
    LAS unsigned char* lds = (LAS unsigned char*)lds_raw;
    cg::grid_group grid = cg::this_grid();
    const int G = gridDim.x, bid = blockIdx.x;
#define WSP(T, off) ((T*)(q->ws + (off)))
    volatile LAS unsigned* xst = (volatile LAS unsigned*)(lds + 131072 + 8192);
    if (threadIdx.x < 4) xst[threadIdx.x] = 0u;
    __syncthreads();
    const XcdBarrier xbar = xcd_barrier_post((unsigned*)(kargs()->ws + OFF_BAR), xst);

    for (int rep = 0; rep < REP_P0; ++rep)
    for (int item = bid; item < 288 + 5120 + 1; item += G) {
        if (item < 288) mod_item(lds, item);
        else if (item < 288 + 5120) conv_tile(lds, item - 288);
        else rope_item();
    }
    grid.sync();

#pragma unroll 1
    for (int l = 0; l < DEPTH; ++l) {
        const bool lastl = (l == DEPTH - 1);
        { const KArgP q = kargs();
          if (l == 0) prep_phase(q->x, q->ctx, nullptr, nullptr, nullptr, nullptr, false, WSP(bf16_t, OFF_A), q->norm_w, WSP(float, OFF_MOD), 0, 1, true);
          else prep_phase(q->out, WSP(float, OFF_HC), nullptr, WSP(float, OFF_HC), nullptr, WSP(bf16_t, OFF_YC), true, WSP(bf16_t, OFF_A), q->norm_w + (l * 3 + 0) * D, WSP(float, OFF_MOD) + (size_t)l * 17 * NMODC, 0, 1, true); }
        GRID_SYNC();
        { const KArgP q = kargs();
          Sched1 S{144, 22, G, bid, (const char*)WSP(bf16_t, OFF_A), (const char*)(WSP(bf16_t, OFF_WGU) + (size_t)(l * 2 + 0) * NGU * D), (size_t)256 * D * 2, 16}; EpiSwiGLU E{WSP(bf16_t, OFF_HID)};
          gemm_phase(lds, D, S, E, stagger_ticks(S.nM * 22, bid, 16)); }
        GRID_SYNC();
        { const KArgP q = kargs();
          SchedR S{bid, true, (const char*)WSP(bf16_t, OFF_HID), (const char*)(WSP(bf16_t, OFF_WDN) + (size_t)(l * 2 + 0) * D * DFF), (size_t)256 * DFF * 2, 44};
          EpiResid E{(l == 0) ? q->x : q->out, (l == 0) ? q->ctx : WSP(float, OFF_HC), q->out, WSP(float, OFF_HC), WSP(float, OFF_MOD) + (size_t)l * 17 * NMODC + 2 * D, 0.5f, WSP(bf16_t, OFF_YC)};
          gemm_phase(lds, DFF, S, E, 0); }
        GRID_SYNC();
        { const KArgP q = kargs();
          prep_phase(q->out, WSP(float, OFF_HC), nullptr, WSP(float, OFF_HC), nullptr, WSP(bf16_t, OFF_YC), true,
                     WSP(bf16_t, OFF_A), q->norm_w + (l * 3 + 1) * D, WSP(float, OFF_MOD) + (size_t)l * 17 * NMODC, 3, 4, true); }
        GRID_SYNC();
        { const KArgP q = kargs();
          SchedIn S{G, bid, (const char*)WSP(bf16_t, OFF_A), (const char*)(WSP(bf16_t, OFF_WIN) + (size_t)l * INC * D), (size_t)256 * D * 2};
          { const int t = fresh_tid(); *(LAS f32x4*)(lds + 131072 + t * 16) = *(const f32x4*)(WSP(float, OFF_ROPE) + t * 4); __syncthreads(); }
          EpiIn E{WSP(bf16_t, OFF_Q), WSP(bf16_t, OFF_KB), WSP(bf16_t, OFF_VT), WSP(bf16_t, OFF_EW), q->q_norm_w + l * 64, q->k_norm_w + l * 64, (const LAS float*)(lds + 131072)};
          gemm_phase(lds, D, S, E, stagger_ticks(1440, bid, 16)); }
        GRID_SYNC();
        {
            const KArgP q = kargs();
            const float lam_init = 0.8f - 0.6f * __expf(-0.3f * (float)l);
            const float* lq = q->lambda_qk + l * 256; const int lane = fresh_tid() & 63;
            const float sa = wave_sum(lq[lane] * lq[64 + lane], lane), sb = wave_sum(lq[128 + lane] * lq[192 + lane], lane);
            const float lam = uniformf(__expf(sa) - __expf(sb) + lam_init);
            const float mq = wave_max(fabsf(q->q_norm_w[l * 64 + lane]), lane), mk = wave_max(fabsf(q->k_norm_w[l * 64 + lane]), lane);
            const float negM = uniformf(-(8.0f * LOG2E * mq * mk));
            const float post_scale = uniformf(lam_init);
            const int n_ctx = lastl ? 0 : 64;
            const int n_items = 512 + n_ctx;
            { const int rpw = lastl ? (NLAT / 256) : (NROWS / 256); ew_rows(WSP(bf16_t, OFF_EW), WSP(bf16_t, OFF_A), q->conv_w + l * 768, bid * rpw, rpw); }
            for (int rep = 0; rep < REP_MIX; ++rep)
            for (int item = bid; item < n_items; item += G) {
                if (item < 512 + n_ctx) {
                    int b, h, qrow0, key0, nkeys;
                    if (item < 512) { const int u = ((item & 7) << 6) + ((item >> 8) << 5) + ((item & 255) >> 3);
                        b = u >> 5; h = (u >> 3) & 3; qrow0 = b * SEQ + (u & 7) * 256; key0 = 0; nkeys = NKEYS; }
                    else { const int it = item - 512; b = it >> 2; h = it & 3; qrow0 = NLAT + b * LCTX; key0 = SEQ; nkeys = LCTX; }
                    attn_item(lds, WSP(bf16_t, OFF_Q), WSP(bf16_t, OFF_KB), WSP(bf16_t, OFF_VT), WSP(bf16_t, OFF_A), b, h, qrow0, key0, nkeys, lam, negM, q->subln_w + l * 128, post_scale);
                }
            }
        }
        GRID_SYNC();
        const int nMr = lastl ? 128 : 144;
        { const KArgP q = kargs();
          SchedR S{bid, !lastl, (const char*)WSP(bf16_t, OFF_A), (const char*)(WSP(bf16_t, OFF_WOUT) + (size_t)l * D * D), (size_t)256 * D * 2, 16};
          EpiResid E{q->out, WSP(float, OFF_HC), q->out, WSP(float, OFF_HC), WSP(float, OFF_MOD) + (size_t)l * 17 * NMODC + 5 * D, 1.0f, WSP(bf16_t, OFF_YC)};
          gemm_phase(lds, D, S, E, 0); }
        GRID_SYNC();
        { const KArgP q = kargs();
          prep_phase(q->out, WSP(float, OFF_HC), nullptr, WSP(float, OFF_HC), nullptr, WSP(bf16_t, OFF_YC), !lastl,
                     WSP(bf16_t, OFF_A), q->norm_w + (l * 3 + 2) * D, WSP(float, OFF_MOD) + (size_t)l * 17 * NMODC, 6, 7, !lastl); }
        GRID_SYNC();
        { const KArgP q = kargs();
          Sched1 S{nMr, 22, G, bid, (const char*)WSP(bf16_t, OFF_A), (const char*)(WSP(bf16_t, OFF_WGU) + (size_t)(l * 2 + 1) * NGU * D), (size_t)256 * D * 2, 16}; EpiSwiGLU E{WSP(bf16_t, OFF_HID)};
          gemm_phase(lds, D, S, E, stagger_ticks(S.nM * 22, bid, 16)); }
        GRID_SYNC();
        if (!lastl) {
          const KArgP q = kargs();
          SchedR S{bid, true, (const char*)WSP(bf16_t, OFF_HID), (const char*)(WSP(bf16_t, OFF_WDN) + (size_t)(l * 2 + 1) * D * DFF), (size_t)256 * DFF * 2, 44};
          EpiResid E{q->out, WSP(float, OFF_HC), q->out, WSP(float, OFF_HC), WSP(float, OFF_MOD) + (size_t)l * 17 * NMODC + 8 * D, 0.5f, WSP(bf16_t, OFF_YC)};
          gemm_phase(lds, DFF, S, E, 0);
          GRID_SYNC();
        } else {
          const KArgP q = kargs();
          Sched1 S{128, 4, G, bid, (const char*)WSP(bf16_t, OFF_HID), (const char*)(WSP(bf16_t, OFF_WDN) + (size_t)(l * 2 + 1) * D * DFF), (size_t)256 * DFF * 2, 44};
          EpiResid E{q->out, WSP(float, OFF_HC), q->out, WSP(float, OFF_HC), WSP(float, OFF_MOD) + (size_t)l * 17 * NMODC + 8 * D, 0.5f, nullptr};
          gemm_phase(lds, DFF, S, E, 0);
        }
    }
#undef WSP
}

extern "C" void kernel_launch(void* const* d_in, const int* in_sizes, int n_in, void* d_out, int out_size, void* d_ws, size_t ws_size, hipStream_t stream) {
    static int grid_blocks = 0;
    if (!grid_blocks) {
        int dev = 0, cus = 0, per_cu = 0;
        hipGetDevice(&dev);
        hipDeviceGetAttribute(&cus, hipDeviceAttributeMultiprocessorCount, dev);
        hipFuncSetAttribute((const void*)hymba_mega, hipFuncAttributeMaxDynamicSharedMemorySize, LDS_BYTES);
        hipOccupancyMaxActiveBlocksPerMultiprocessor(&per_cu, (const void*)hymba_mega, 512, LDS_BYTES);
        if (per_cu < 1) per_cu = 1;
        if (per_cu > 1) per_cu = 1;
        grid_blocks = 256;
        if (ws_size < WS_END) fprintf(stderr, "kernel_launch: workspace too small: %zu < %zu\n", ws_size, (size_t)WS_END);
    }
    Params p{};
    p.x = (const float*)d_in[0]; p.c = (const float*)d_in[1]; p.ctx = (const float*)d_in[2]; p.c_ctx = (const float*)d_in[3];
    p.norm_w = (const float*)d_in[4]; p.w_mod = (const float*)d_in[5]; p.b_mod = (const float*)d_in[6];
    p.w_gu1 = (const float*)d_in[7]; p.w_dn1 = (const float*)d_in[8]; p.w_gu2 = (const float*)d_in[9]; p.w_dn2 = (const float*)d_in[10];
    p.w_in = (const float*)d_in[11]; p.w_out = (const float*)d_in[12]; p.q_norm_w = (const float*)d_in[13]; p.k_norm_w = (const float*)d_in[14];
    p.lambda_qk = (const float*)d_in[15]; p.subln_w = (const float*)d_in[16]; p.conv_w = (const float*)d_in[17]; p.pool_w = (const float*)d_in[18]; p.pool_scale = (const float*)d_in[19];
    p.out = (float*)d_out; p.ws = (unsigned char*)d_ws;
    (void)hipMemsetAsync((unsigned char*)d_ws + OFF_BAR, 0, 16384, stream);
    void* args[] = {&p};
    hipError_t e = hipLaunchCooperativeKernel((const void*)hymba_mega, dim3(grid_blocks), dim3(512), args, LDS_BYTES, stream);
    if (e != hipSuccess) fprintf(stderr, "cooperative launch failed: %s (grid %d)\n", hipGetErrorString(e), grid_blocks);
}
```
